# Optimizing an MI355X kernel written in HIP

```python
import jax, jax.numpy as jnp
from jax import lax
import numpy as np

D_MODEL = 4096
BATCH = 4
SEQ = 4096
DEPTH = 2

HEAD_DIM = 128
CHUNK = 128
WINDOW = 128
ROPE_THETA = 10000.0
NORM_EPS = 1e-5
NEG_INF = -1e30
D_FF = 4 * D_MODEL
MIX_WIDTH = D_MODEL
SGU_WIDTH = MIX_WIDTH // 4
RET_WIDTH = MIX_WIDTH // 4
ATT_WIDTH = MIX_WIDTH - SGU_WIDTH - RET_WIDTH
N_SGU_GROUPS = SGU_WIDTH // HEAD_DIM
N_RET_HEADS = RET_WIDTH // HEAD_DIM
N_Q_HEADS = ATT_WIDTH // HEAD_DIM
N_KV_HEADS = N_Q_HEADS // 4
KV_WIDTH = N_KV_HEADS * HEAD_DIM
IN_WIDTHS = (SGU_WIDTH, SGU_WIDTH, RET_WIDTH, RET_WIDTH, RET_WIDTH, RET_WIDTH,
             ATT_WIDTH, KV_WIDTH, KV_WIDTH)
IN_WIDTH = sum(IN_WIDTHS)

kernel_name = "hybrid_sgu_retention_swa_encoder"


def rms_norm(x, g):
    xf = x.astype(jnp.float32)
    y = xf * lax.rsqrt(jnp.mean(xf * xf, axis=-1, keepdims=True) + NORM_EPS)
    return (y * g.astype(jnp.float32)).astype(x.dtype)


def rope_tables(seq, dtype):
    pos = jnp.arange(seq, dtype=jnp.float32)
    inv = ROPE_THETA ** (-jnp.arange(0, HEAD_DIM, 2, dtype=jnp.float32) / HEAD_DIM)
    ang = pos[:, None] * inv[None, :]
    ang = jnp.concatenate([ang, ang], axis=-1)
    return jnp.cos(ang).astype(dtype), jnp.sin(ang).astype(dtype)


def apply_rope(t, cos, sin):
    t1, t2 = jnp.split(t, 2, axis=-1)
    rot = jnp.concatenate([-t2, t1], axis=-1)
    return t * cos[None, :, None, :] + rot * sin[None, :, None, :]


def spatial_gating(u, v, ln_g, ln_b, w_s, b_s):
    B, S, _ = u.shape
    u = jax.nn.gelu(u, approximate=False)
    v = jax.nn.gelu(v, approximate=False)
    vf = v.astype(jnp.float32)
    mu = jnp.mean(vf, axis=-1, keepdims=True)
    var = jnp.mean(jnp.square(vf - mu), axis=-1, keepdims=True)
    vn = ((vf - mu) * lax.rsqrt(var + NORM_EPS) * ln_g.astype(jnp.float32)
          + ln_b.astype(jnp.float32)).astype(v.dtype)
    vc = vn.reshape(B, S // CHUNK, CHUNK, N_SGU_GROUPS, HEAD_DIM)
    s = jnp.einsum('gij,bnjgd->bnigd', w_s, vc) + b_s.T[None, None, :, :, None]
    return u * s.reshape(B, S, SGU_WIDTH)


def retention_direction(q, k, v, log_gamma, include_diag):
    B, S, H, D = q.shape
    N = S // CHUNK
    dt = q.dtype
    qc = q.reshape(B, N, CHUNK, H, D)
    kc = k.reshape(B, N, CHUNK, H, D)
    vc = v.reshape(B, N, CHUNK, H, D)
    idx = jnp.arange(CHUNK, dtype=jnp.float32)
    delta = idx[:, None] - idx[None, :]
    mask = (delta >= 0) if include_diag else (delta > 0)
    decay_in = jnp.where(mask[None],
                         jnp.exp(log_gamma[:, None, None] * jnp.maximum(delta, 0.0)[None]),
                         0.0)
    scores = jnp.einsum('bnihd,bnjhd->bnhij', qc, kc) * decay_in.astype(dt)[None, None]
    inner = jnp.einsum('bnhij,bnjhd->bnihd', scores, vc)
    w_k = jnp.exp(log_gamma[None, :] * (CHUNK - 1 - idx)[:, None]).astype(dt)
    kv = jnp.einsum('bnjhd,bnjhe->nbhde', kc * w_k[None, None, :, :, None], vc)
    kv = kv.astype(jnp.float32)
    chunk_decay = jnp.exp(log_gamma * CHUNK)[None, :, None, None]

    def step(state, kv_n):
        return chunk_decay * state + kv_n, state

    _, prev = lax.scan(step, jnp.zeros((B, H, D, D), jnp.float32), kv)
    w_q = jnp.exp(log_gamma[None, :] * (idx + 1.0)[:, None]).astype(dt)
    cross = jnp.einsum('bnihd,nbhde->bnihe', qc * w_q[None, None, :, :, None], prev.astype(dt))
    return (inner + cross).reshape(B, S, H, D)


def retention_mixer(q, k, v, g, log_decay_raw, cos, sin):
    B, S, H, D = q.shape
    q = apply_rope(q, cos, sin)
    k = apply_rope(k, cos, sin) * (D ** -0.5)
    log_gamma = -jnp.exp(log_decay_raw.astype(jnp.float32))
    fwd = retention_direction(q, k, v, log_gamma[0], True)
    bwd = jnp.flip(retention_direction(jnp.flip(q, 1), jnp.flip(k, 1), jnp.flip(v, 1),
                                       log_gamma[1], False), 1)
    rf = (fwd + bwd).astype(jnp.float32)
    rn = rf * lax.rsqrt(jnp.mean(rf * rf, axis=-1, keepdims=True) + NORM_EPS)
    return jax.nn.silu(g) * rn.reshape(B, S, H * D).astype(g.dtype)


def window_attention(q, k, v, sink, cos, sin):
    B, S, _, D = q.shape
    N = S // CHUNK
    G = N_Q_HEADS // N_KV_HEADS
    q = apply_rope(q, cos, sin) * (D ** -0.5)
    k = apply_rope(k, cos, sin)
    qb = q.reshape(B, N, CHUNK, N_KV_HEADS, G, D)

    def neighbours(t):
        tp = jnp.pad(t, ((0, 0), (CHUNK, CHUNK), (0, 0), (0, 0)))
        tp = tp.reshape(B, N + 2, CHUNK, N_KV_HEADS, D)
        return jnp.concatenate([tp[:, :-2], tp[:, 1:-1], tp[:, 2:]], axis=2)

    kb, vb = neighbours(k), neighbours(v)
    s = jnp.einsum('bnikgd,bnjkd->bnkgij', qb, kb).astype(jnp.float32)
    qi = jnp.arange(CHUNK)
    kj = jnp.arange(3 * CHUNK)
    rel = kj[None, :] - CHUNK - qi[:, None]
    kpos = (jnp.arange(N)[:, None] - 1) * CHUNK + kj[None, :]
    valid = (jnp.abs(rel) <= WINDOW)[None] & ((kpos >= 0) & (kpos < S))[:, None, :]
    s = jnp.where(valid[None, :, None, None], s, NEG_INF)
    sink_f = sink.astype(jnp.float32).reshape(N_KV_HEADS, G)[None, None, :, :, None, None]
    m = jnp.maximum(jnp.max(s, axis=-1, keepdims=True), sink_f)
    p = jnp.exp(s - m)
    p = p / (jnp.sum(p, axis=-1, keepdims=True) + jnp.exp(sink_f - m))
    o = jnp.einsum('bnkgij,bnjkd->bnikgd', p.astype(v.dtype), vb)
    return o.reshape(B, S, ATT_WIDTH)


def hybrid_layer(x, ln_mix_g, w_in, sgu_ln_g, sgu_ln_b, sgu_w, sgu_b, ret_log_decay,
                 attn_sink, w_out, ln_mlp_g, w_up, w_down, cos, sin):
    B, S, _ = x.shape
    h = rms_norm(x, ln_mix_g)
    proj = h @ w_in
    splits = [int(o) for o in np.cumsum(IN_WIDTHS)[:-1]]
    u, v, rq, rk, rv, rg, aq, ak, av = jnp.split(proj, splits, axis=-1)
    a_out = spatial_gating(u, v, sgu_ln_g, sgu_ln_b, sgu_w, sgu_b)
    r_out = retention_mixer(rq.reshape(B, S, N_RET_HEADS, HEAD_DIM),
                            rk.reshape(B, S, N_RET_HEADS, HEAD_DIM),
                            rv.reshape(B, S, N_RET_HEADS, HEAD_DIM),
                            rg, ret_log_decay, cos, sin)
    c_out = window_attention(aq.reshape(B, S, N_Q_HEADS, HEAD_DIM),
                             ak.reshape(B, S, N_KV_HEADS, HEAD_DIM),
                             av.reshape(B, S, N_KV_HEADS, HEAD_DIM),
                             attn_sink, cos, sin)
    x = x + jnp.concatenate([a_out, r_out, c_out], axis=-1) @ w_out
    h = rms_norm(x, ln_mlp_g)
    x = x + jnp.square(jax.nn.relu(h @ w_up)) @ w_down
    return x


def setup_inputs(seed: int = 0) -> dict:
    key = jax.random.key(seed)
    ks = jax.random.split(key, 16)
    f32 = jnp.float32
    nrm = lambda k, shape: jax.random.normal(k, shape, dtype=f32)
    x = nrm(ks[0], (BATCH, SEQ, D_MODEL))
    ln_mix_g = 1.0 + 0.02 * nrm(ks[1], (DEPTH, D_MODEL))
    w_in = nrm(ks[2], (DEPTH, D_MODEL, IN_WIDTH)) * (D_MODEL ** -0.5)
    sgu_ln_g = 1.0 + 0.02 * nrm(ks[3], (DEPTH, SGU_WIDTH))
    sgu_ln_b = 0.02 * nrm(ks[4], (DEPTH, SGU_WIDTH))
    sgu_w = nrm(ks[5], (DEPTH, N_SGU_GROUPS, CHUNK, CHUNK)) * (CHUNK ** -0.5)
    sgu_b = 1.0 + 0.02 * nrm(ks[6], (DEPTH, N_SGU_GROUPS, CHUNK))
    p = 2.0 ** (-5.0 - jnp.arange(N_RET_HEADS, dtype=f32))
    base = jnp.log(-jnp.log1p(-p))
    ret_log_decay = base[None, None, :] + 0.1 * nrm(ks[7], (DEPTH, 2, N_RET_HEADS))
    attn_sink = nrm(ks[8], (DEPTH, N_Q_HEADS))
    w_out = nrm(ks[9], (DEPTH, MIX_WIDTH, D_MODEL)) * (MIX_WIDTH ** -0.5)
    ln_mlp_g = 1.0 + 0.02 * nrm(ks[10], (DEPTH, D_MODEL))
    w_up = nrm(ks[11], (DEPTH, D_MODEL, D_FF)) * (D_MODEL ** -0.5)
    w_down = nrm(ks[12], (DEPTH, D_FF, D_MODEL)) * (D_FF ** -0.5)
    final_norm_g = 1.0 + 0.02 * nrm(ks[13], (D_MODEL,))
    return {"x": x, "ln_mix_g": ln_mix_g, "w_in": w_in, "sgu_ln_g": sgu_ln_g,
            "sgu_ln_b": sgu_ln_b, "sgu_w": sgu_w, "sgu_b": sgu_b,
            "ret_log_decay": ret_log_decay, "attn_sink": attn_sink, "w_out": w_out,
            "ln_mlp_g": ln_mlp_g, "w_up": w_up, "w_down": w_down,
            "final_norm_g": final_norm_g}


def reference(x, ln_mix_g, w_in, sgu_ln_g, sgu_ln_b, sgu_w, sgu_b, ret_log_decay,
              attn_sink, w_out, ln_mlp_g, w_up, w_down, final_norm_g):
    cos, sin = rope_tables(x.shape[1], x.dtype)
    for l in range(DEPTH):
        x = hybrid_layer(x, ln_mix_g[l], w_in[l], sgu_ln_g[l], sgu_ln_b[l], sgu_w[l],
                         sgu_b[l], ret_log_decay[l], attn_sink[l], w_out[l],
                         ln_mlp_g[l], w_up[l], w_down[l], cos, sin)
    return rms_norm(x, final_norm_g)
```

```cpp
#include <hip/hip_runtime.h>
#include <cstdio>
#include <cstdint>
namespace pg8 {
#define PG8_LAS __attribute__((address_space(3)))
typedef unsigned short bf16_t;
typedef short bf16x8 __attribute__((ext_vector_type(8)));
typedef float f32x4 __attribute__((ext_vector_type(4)));
typedef unsigned u32x4 __attribute__((ext_vector_type(4)));
constexpr int BM = 256, BK = 64, HALF = 128, HTB = HALF * BK * 2  , STAGE_BYTES = 8 * HTB, NXCD = 8, WGM = 8;

__host__ __device__ __forceinline__ int lds_byte(int r, int c) { const int st = (r >> 4) * 2 + (c >> 5), rr = r & 15, cc = c & 31, ob = rr * 64 + cc * 2; return st * 1024 + (ob ^ (((ob >> 9) & 1) << 5)); }
__host__ __device__ __forceinline__ void stage_rc(int b, int& R, int& C) { const int st = b / 1024, sb = b % 1024, swz = sb ^ (((sb >> 9) & 1) << 5); R = (st >> 1) * 16 + swz / 64; C = (st & 1) * 32 + (swz % 64) / 2; }
__host__ __device__ __forceinline__ int perm32(int rho) { const int n = rho >> 4, i = rho & 15; return 8 * (i >> 2) + 4 * n + (i & 3); }

struct Unit { int pm, pn; };
struct Gemm { const bf16_t* A; const bf16_t* Bt; int M, N, K; };

struct StaticOrder {
    int nM, nN, nwg, G, c;
    __host__ __device__ void init(int M, int N, int G_, int c_) { nM = M / BM; nN = N / BM; nwg = nM * nN; G = G_; c = c_; }
    __host__ __device__ bool next(int i, Unit& u) const {
        const long L = (long)i * G + c; if (L >= nwg) return false;
        int wgid = (int)L; { const int q = nwg / NXCD, r = nwg % NXCD, xcd = wgid % NXCD, off = wgid / NXCD; wgid = (xcd < r ? xcd * (q + 1) : r * (q + 1) + (xcd - r) * q) + off; }
        const int nig = WGM * nN, gid = wgid / nig, fm = gid * WGM, gsz = (nM - fm) < WGM ? (nM - fm) : WGM;
        u.pm = fm + ((wgid % nig) % gsz); u.pn = (wgid % nig) / gsz; return true;
    }
    __device__ __forceinline__ void a_ready(const Unit&) const {}
    __device__ __forceinline__ void done(const Unit&) const {}
};

__device__ __forceinline__ unsigned cvt_pk_bf16(float lo, float hi) { unsigned r; asm volatile("v_cvt_pk_bf16_f32 %0, %1, %2" : "=v"(r) : "v"(lo), "v"(hi)); return r; }
typedef float f32x2 __attribute__((ext_vector_type(2)));
__device__ __forceinline__ f32x2 gelu_pk(f32x2 v) {
    const f32x2 av = __builtin_elementwise_abs(v), d = av * 0.2316418882f + 1.0f;
    f32x2 t; t.x = __builtin_amdgcn_rcpf(d.x); t.y = __builtin_amdgcn_rcpf(d.y);
    f32x2 q = t * 0.5307027145f + (-0.7265760135f); q = q * t + 0.7107068705f; q = q * t + (-0.142248368f); q = q * t + 0.127414796f; q = q * t;
    const f32x2 s = (v * v) * (-0.72134752044f);
    f32x2 e; e.x = __builtin_amdgcn_exp2f(s.x); e.y = __builtin_amdgcn_exp2f(s.y);
    const f32x2 m = v * (q * e), r = v - m;
    f32x2 o; o.x = v.x < 0.f ? m.x : r.x; o.y = v.y < 0.f ? m.y : r.y; return o;
}

struct EpiIn {
    static constexpr bool PERM = true, AFTER_DRAIN = false;
    bf16_t* O; int ldc; int gelu_tiles;
    __device__ __forceinline__ void operator()(const f32x4 (&acc)[2][2][4][2], const Unit& u, int wr, int wc, int fr, int fq) const {
        const int row0 = u.pm * BM + wr * 64 + fr, col0 = u.pn * BM + wc * 32 + 8 * fq;
        const bool act = u.pn < gelu_tiles;
#pragma unroll
        for (int ai = 0; ai < 2; ++ai)
#pragma unroll
            for (int m = 0; m < 4; ++m) { bf16_t* rowp = O + (size_t)(row0 + ai * HALF + m * 16) * ldc + col0;
#pragma unroll
                for (int bj = 0; bj < 2; ++bj) { f32x4 v0 = acc[ai][bj][m][0], v1 = acc[ai][bj][m][1];
                    if (act) { f32x2 a = gelu_pk((f32x2){v0[0], v0[1]}), b = gelu_pk((f32x2){v0[2], v0[3]}), c = gelu_pk((f32x2){v1[0], v1[1]}), d = gelu_pk((f32x2){v1[2], v1[3]});
                        v0 = (f32x4){a.x, a.y, b.x, b.y}; v1 = (f32x4){c.x, c.y, d.x, d.y}; }
                    u32x4 w; w.x = cvt_pk_bf16(v0[0], v0[1]); w.y = cvt_pk_bf16(v0[2], v0[3]); w.z = cvt_pk_bf16(v1[0], v1[1]); w.w = cvt_pk_bf16(v1[2], v1[3]);
                    *(u32x4*)(rowp + bj * HALF) = w; } }
    }
};
struct EpiRelu2 {
    static constexpr bool PERM = true, AFTER_DRAIN = false;
    bf16_t* O; int ldc;
    __device__ __forceinline__ void operator()(const f32x4 (&acc)[2][2][4][2], const Unit& u, int wr, int wc, int fr, int fq) const {
        const int row0 = u.pm * BM + wr * 64 + fr, col0 = u.pn * BM + wc * 32 + 8 * fq;
#pragma unroll
        for (int ai = 0; ai < 2; ++ai)
#pragma unroll
            for (int m = 0; m < 4; ++m) { bf16_t* rowp = O + (size_t)(row0 + ai * HALF + m * 16) * ldc + col0;
#pragma unroll
                for (int bj = 0; bj < 2; ++bj) { f32x4 v0 = acc[ai][bj][m][0], v1 = acc[ai][bj][m][1];
                    v0 = __builtin_elementwise_max(v0, (f32x4){0.f, 0.f, 0.f, 0.f}); v1 = __builtin_elementwise_max(v1, (f32x4){0.f, 0.f, 0.f, 0.f}); v0 = v0 * v0; v1 = v1 * v1;
                    u32x4 w; w.x = cvt_pk_bf16(v0[0], v0[1]); w.y = cvt_pk_bf16(v0[2], v0[3]); w.z = cvt_pk_bf16(v1[0], v1[1]); w.w = cvt_pk_bf16(v1[2], v1[3]);
                    *(u32x4*)(rowp + bj * HALF) = w; } }
    }
};
struct EpiRes {
    static constexpr bool PERM = false, AFTER_DRAIN = false;
    const float* base; float* C; int ldc;
    __device__ __forceinline__ void operator()(const f32x4 (&acc)[2][2][4][2], const Unit& u, int wr, int wc, int fr, int fq) const {
        const int row0 = u.pm * BM + wr * 64 + fr, col0 = u.pn * BM + wc * 32 + 4 * fq;
#pragma unroll
        for (int ai = 0; ai < 2; ++ai)
#pragma unroll
            for (int m = 0; m < 4; ++m) { const size_t off = (size_t)(row0 + ai * HALF + m * 16) * ldc + col0;
                f32x4 bs[2][2];
#pragma unroll
                for (int bj = 0; bj < 2; ++bj)
#pragma unroll
                    for (int n = 0; n < 2; ++n) bs[bj][n] = *(const f32x4*)(base + off + bj * HALF + n * 16);
#pragma unroll
                for (int bj = 0; bj < 2; ++bj)
#pragma unroll
                    for (int n = 0; n < 2; ++n) *(f32x4*)(C + off + bj * HALF + n * 16) = acc[ai][bj][m][n] + bs[bj][n];
                asm volatile("" ::: "memory"); }
    }
};
template <class Epi, class Sched, bool ALIGN_EPI = false, bool SP2 = false>
__device__ __forceinline__ void gemm_phase(PG8_LAS unsigned char* lds, const Gemm g, const Sched& S, const Epi& E) {
    int tid = threadIdx.x; asm volatile("" : "+v"(tid));
    const int wid = __builtin_amdgcn_readfirstlane(tid >> 6), lane = tid & 63, wr = wid >> 2, wc = wid & 3, fr = lane & 15, fq = lane >> 4;
    const int K = g.K, nt = K / BK;
    unsigned voffA[2], voffB[2];
#pragma unroll
    for (int i = 0; i < 2; ++i) { int R, C; stage_rc(tid * 16 + i * 8192, R, C); const int Rb = Epi::PERM ? ((R & ~31) + perm32(R & 31)) : R;
        voffA[i] = (unsigned)(R * K + C) * 2u; voffB[i] = (unsigned)(Rb * K + C) * 2u; }
    const size_t kstep = (size_t)(BK * 2);
    const size_t hstep = (size_t)HALF * K * 2;
    const size_t tstep = 2 * hstep;
    const unsigned ldsw = (unsigned)wid * 1024u;
    const int aoff = lds_byte(wr * 64 + fr, fq * 8), boff = lds_byte(wc * 32 + fr, fq * 8);
#define PG8_SA(b, h) (((b) * 2 + (h)) * HTB)
#define PG8_SB(b, h) ((4 + (b) * 2 + (h)) * HTB)
#define PG8_STAGE(bufoff, gbase, voff) do { _Pragma("unroll") for (int _i = 0; _i < 2; ++_i) \
        __builtin_amdgcn_global_load_lds((const unsigned*)((const char*)(gbase) + (voff)[_i]), (PG8_LAS unsigned*)(lds + (bufoff) + ldsw + _i * 8192), 16, 0, 0); } while (0)
#define PG8_LDA(dst, b, h) do { _Pragma("unroll") for (int m = 0; m < 4; ++m) _Pragma("unroll") for (int k = 0; k < 2; ++k) dst[m][k] = *(const PG8_LAS bf16x8*)(lds + PG8_SA(b, h) + aoff + m * 2048 + k * 1024); } while (0)
#define PG8_LDB(dst, b, h) do { _Pragma("unroll") for (int n = 0; n < 2; ++n) _Pragma("unroll") for (int k = 0; k < 2; ++k) dst[n][k] = *(const PG8_LAS bf16x8*)(lds + PG8_SB(b, h) + boff + n * 2048 + k * 1024); } while (0)
#define PG8_MMA(ai, bj, At, Bt) do { __builtin_amdgcn_s_setprio(1); _Pragma("unroll") for (int m = 0; m < 4; ++m) _Pragma("unroll") for (int n = 0; n < 2; ++n) _Pragma("unroll") for (int k = 0; k < 2; ++k) \
        acc[ai][bj][m][n] = __builtin_amdgcn_mfma_f32_16x16x32_bf16(Bt[n][k], At[m][k], acc[ai][bj][m][n], 0, 0, 0); __builtin_amdgcn_s_setprio(0); } while (0)
#define PG8_WAIT_V(n) asm volatile("s_waitcnt vmcnt(" #n ")" ::: "memory")
#define PG8_WAIT_L(n) asm volatile("s_waitcnt lgkmcnt(" #n ")" ::: "memory")
#define PG8_BAR __builtin_amdgcn_s_barrier()
#define PG8_SCHED __builtin_amdgcn_sched_barrier(0)
    Unit cur, nxt; int ui = 0;
    if (!S.next(0, cur)) return;
    f32x4 acc[2][2][4][2];
#pragma unroll
    for (int a = 0; a < 2; ++a)
#pragma unroll
        for (int b = 0; b < 2; ++b)
#pragma unroll
            for (int m = 0; m < 4; ++m)
#pragma unroll
                for (int n = 0; n < 2; ++n) acc[a][b][m][n] = (f32x4){0.f, 0.f, 0.f, 0.f};
    bf16x8 At[4][2], B0[2][2], B1[2][2];
    const char* cA = (const char*)g.A + (size_t)cur.pm * tstep; const char* cB = (const char*)g.Bt + (size_t)cur.pn * tstep;
    S.a_ready(cur);
    if constexpr (SP2) {
        PG8_STAGE(PG8_SB(0, 0), cB, voffB); PG8_STAGE(PG8_SB(0, 1), cB + hstep, voffB); PG8_STAGE(PG8_SA(0, 0), cA, voffA); PG8_STAGE(PG8_SA(0, 1), cA + hstep, voffA);
        if (wr == 1) PG8_BAR;
        PG8_WAIT_V(2); PG8_BAR;
        PG8_STAGE(PG8_SB(1, 0), cB + kstep, voffB); PG8_STAGE(PG8_SA(1, 0), cA + kstep, voffA); PG8_STAGE(PG8_SB(1, 1), cB + hstep + kstep, voffB);
        PG8_WAIT_V(6); PG8_BAR;
    } else {
        PG8_STAGE(PG8_SB(0, 0), cB, voffB); PG8_STAGE(PG8_SA(0, 0), cA, voffA); PG8_STAGE(PG8_SB(0, 1), cB + hstep, voffB); PG8_STAGE(PG8_SA(0, 1), cA + hstep, voffA);
        if (wr == 1) PG8_BAR;
        PG8_WAIT_V(4); PG8_BAR;
        PG8_STAGE(PG8_SB(1, 0), cB + kstep, voffB); PG8_STAGE(PG8_SA(1, 0), cA + kstep, voffA); PG8_STAGE(PG8_SB(1, 1), cB + hstep + kstep, voffB);
        PG8_WAIT_V(6); PG8_BAR;
    }
    for (;;) {
        const bool has_next = S.next(ui + 1, nxt);
        const char* nA = has_next ? (const char*)g.A + (size_t)nxt.pm * tstep : cA; const char* nB = has_next ? (const char*)g.Bt + (size_t)nxt.pn * tstep : cB;
        for (int t = 0; t < nt; t += 2) {
            const bool last = (t == nt - 2);
            const char* a1 = cA + (size_t)(t + 1) * kstep;
            const char* a2 = last ? nA : cA + (size_t)(t + 2) * kstep; const char* b2 = last ? nB : cB + (size_t)(t + 2) * kstep;
            const char* a3 = a2 + kstep; const char* b3 = b2 + kstep;
            if (last && has_next) S.a_ready(nxt);
            if constexpr (SP2) {
            PG8_LDB(B0, 0, 0); PG8_LDB(B1, 0, 1); PG8_SCHED; PG8_LDA(At, 0, 0); PG8_STAGE(PG8_SA(1, 1), a1 + hstep, voffA);
            PG8_WAIT_V(8); PG8_WAIT_L(0); PG8_BAR; PG8_MMA(0, 0, At, B0); PG8_MMA(0, 1, At, B1); PG8_BAR; PG8_SCHED;
            PG8_LDA(At, 0, 1); PG8_STAGE(PG8_SB(0, 0), b2, voffB); PG8_STAGE(PG8_SB(0, 1), b2 + hstep, voffB); PG8_STAGE(PG8_SA(0, 0), a2, voffA);
            PG8_WAIT_V(8); PG8_WAIT_L(0); PG8_BAR; PG8_MMA(1, 0, At, B0); PG8_MMA(1, 1, At, B1); PG8_BAR; PG8_SCHED;
            PG8_LDB(B0, 1, 0); PG8_LDB(B1, 1, 1); PG8_SCHED; PG8_LDA(At, 1, 0); PG8_STAGE(PG8_SA(0, 1), a2 + hstep, voffA);
            PG8_WAIT_V(8); PG8_WAIT_L(0); PG8_BAR; PG8_MMA(0, 0, At, B0); PG8_MMA(0, 1, At, B1); PG8_BAR; PG8_SCHED;
            PG8_LDA(At, 1, 1); PG8_STAGE(PG8_SB(1, 0), b3, voffB); PG8_STAGE(PG8_SB(1, 1), b3 + hstep, voffB); PG8_STAGE(PG8_SA(1, 0), a3, voffA);
            PG8_WAIT_V(8); PG8_WAIT_L(0); PG8_BAR; PG8_MMA(1, 0, At, B0); PG8_MMA(1, 1, At, B1); PG8_BAR; PG8_SCHED;
            } else {
            PG8_LDB(B0, 0, 0); PG8_SCHED; PG8_LDA(At, 0, 0); PG8_STAGE(PG8_SA(1, 1), a1 + hstep, voffA);
            PG8_WAIT_L(8); PG8_BAR; PG8_WAIT_L(0); PG8_MMA(0, 0, At, B0); PG8_BAR; PG8_SCHED;
            PG8_LDB(B1, 0, 1); PG8_STAGE(PG8_SB(0, 0), b2, voffB);
            PG8_BAR; PG8_WAIT_L(0); PG8_MMA(0, 1, At, B1); PG8_BAR;
            PG8_LDA(At, 0, 1); PG8_STAGE(PG8_SA(0, 0), a2, voffA);
            PG8_BAR; PG8_WAIT_L(0); PG8_MMA(1, 0, At, B0); PG8_BAR; PG8_SCHED;
            PG8_STAGE(PG8_SB(0, 1), b2 + hstep, voffB);
            PG8_WAIT_V(6); PG8_BAR; PG8_MMA(1, 1, At, B1); PG8_BAR;
            PG8_LDB(B0, 1, 0); PG8_SCHED; PG8_LDA(At, 1, 0); PG8_STAGE(PG8_SA(0, 1), a2 + hstep, voffA);
            PG8_WAIT_L(8); PG8_BAR; PG8_WAIT_L(0); PG8_MMA(0, 0, At, B0); PG8_BAR; PG8_SCHED;
            PG8_LDB(B1, 1, 1); PG8_STAGE(PG8_SB(1, 0), b3, voffB);
            PG8_BAR; PG8_WAIT_L(0); PG8_MMA(0, 1, At, B1); PG8_BAR;
            PG8_LDA(At, 1, 1); PG8_STAGE(PG8_SA(1, 0), a3, voffA);
            PG8_BAR; PG8_WAIT_L(0); PG8_MMA(1, 0, At, B0); PG8_BAR; PG8_SCHED;
            PG8_STAGE(PG8_SB(1, 1), b3 + hstep, voffB);
            PG8_WAIT_V(6); PG8_BAR; PG8_MMA(1, 1, At, B1); PG8_BAR;
            }
        }
        if constexpr (ALIGN_EPI) { if (wr == 0) PG8_BAR; }
        if constexpr (!Epi::AFTER_DRAIN) { E(acc, cur, wr, wc, fr, fq); S.done(cur); }
        if (!has_next) break;
#pragma unroll
        for (int a = 0; a < 2; ++a)
#pragma unroll
            for (int b = 0; b < 2; ++b)
#pragma unroll
                for (int m = 0; m < 4; ++m)
#pragma unroll
                    for (int n = 0; n < 2; ++n) acc[a][b][m][n] = (f32x4){0.f, 0.f, 0.f, 0.f};
        cur = nxt; cA = nA; cB = nB; ++ui;
        if constexpr (ALIGN_EPI) { if (wr == 1) PG8_BAR; }
    }
    PG8_WAIT_V(0);
    if constexpr (!ALIGN_EPI) { if (wr == 0) PG8_BAR; }
    PG8_BAR;
    if constexpr (Epi::AFTER_DRAIN) { E.fused(acc, cur, wr, wc, fr, fq, lds, wid, lane); S.done(cur); }
#undef PG8_SA
#undef PG8_SB
#undef PG8_STAGE
#undef PG8_LDA
#undef PG8_LDB
#undef PG8_MMA
#undef PG8_WAIT_V
#undef PG8_WAIT_L
#undef PG8_BAR
#undef PG8_SCHED
}
}
constexpr int BATCH = 4, SEQ = 4096, DM = 4096, DEPTH = 2, HDIM = 128, CHUNK = 128, NCH = SEQ / CHUNK;
constexpr int M = BATCH * SEQ;
constexpr int DFF = 4 * DM;
constexpr int INW = 9216;
constexpr int C_U = 0, C_V = 1024, C_RQ = 2048, C_RK = 3072, C_RV = 4096, C_RG = 5120, C_AQ = 6144, C_AK = 8192, C_AV = 8704;
constexpr int MIX_A = 0, MIX_R = 1024, MIX_C = 2048;
constexpr int NRH = 8, NQH = 16, NSG = 8;
constexpr float NORM_EPS = 1e-5f;
constexpr float QK_SCALE = 0.08838834764831845f;
constexpr float LOG2E = 1.4426950408889634f;

constexpr size_t MiB = 1u << 20;
constexpr size_t WS_CTL = 0, CTL_ZERO_BYTES = 1 * MiB;
constexpr size_t WS_COS = 1 * MiB, WS_SIN = 2 * MiB;
constexpr size_t WS_WIN = 4 * MiB;
constexpr size_t WS_WOUT = WS_WIN + 144 * MiB;
constexpr size_t WS_WUP = WS_WOUT + 64 * MiB;
constexpr size_t WS_WDN = WS_WUP + 256 * MiB;
constexpr size_t WS_H = WS_WDN + 256 * MiB;
constexpr size_t WS_PROJ = WS_H + 128 * MiB;
constexpr size_t WS_MIX = WS_PROJ + 288 * MiB;
constexpr size_t WS_HID = WS_MIX + 128 * MiB;
constexpr size_t WS_KV = WS_HID;
constexpr size_t WS_ST = WS_HID + 128 * MiB;
constexpr size_t WS_END = WS_HID + 512 * MiB;
static_assert(WS_END == 1780 * MiB, "ws map");
constexpr int CW_BAR = 4096;

constexpr int RING_BYTES = 139264;
constexpr int LDSCTL_OFF = RING_BYTES, MISC_OFF = LDSCTL_OFF + 320;
constexpr int LDS_BYTES = 147456;
constexpr int NWAVES = 8;

#define GAS __attribute__((address_space(1)))
#define LAS __attribute__((address_space(3)))
typedef unsigned short bf16;
typedef unsigned v4u __attribute__((ext_vector_type(4)));
typedef unsigned v2u __attribute__((ext_vector_type(2)));
typedef float f32x4 __attribute__((ext_vector_type(4)));
typedef short bf16x8 __attribute__((ext_vector_type(8)));
typedef short s16x4 __attribute__((ext_vector_type(4)));
typedef LAS unsigned char* ldsp;
#define LDS_WAIT() asm volatile("s_waitcnt lgkmcnt(0)" ::: "memory")
#define VM_WAIT() asm volatile("s_waitcnt vmcnt(0)" ::: "memory")
using pg8::cvt_pk_bf16;
__device__ __forceinline__ float bf_lo(unsigned w) { return __uint_as_float(w << 16); }
__device__ __forceinline__ float bf_hi(unsigned w) { return __uint_as_float(w & 0xffff0000u); }

#define XB_TMO      128
#define XB_XCNT(j)  (256  + 64 * (j))
#define XB_XSUB(j)  (1280 + 64 * (j))
#define XB_XGEN(j)  (2304 + 64 * (j))
#define XB_TOP      3328
#define XB_TOPGEN   3392
#define XCD_BAR_WORDS 3456
#define XB_SPIN_CAP (1u << 18)

__device__ __forceinline__ unsigned xb_ld(unsigned* p)              { return __hip_atomic_load(p, __ATOMIC_RELAXED, __HIP_MEMORY_SCOPE_AGENT); }
__device__ __forceinline__ unsigned xb_add(unsigned* p, unsigned v) { return __hip_atomic_fetch_add(p, v, __ATOMIC_RELAXED, __HIP_MEMORY_SCOPE_AGENT); }
__device__ __forceinline__ unsigned xb_xcc_id() { return (unsigned)__builtin_amdgcn_s_getreg((3 << 11) | 20) & 0xFu; }
#define XB_SPIN(cond, bar) do { unsigned _sp = 0; while (cond) { __builtin_amdgcn_s_sleep(1); \
    if ((++_sp & 255u) == 0u) { if (xb_ld(&(bar)[XB_TMO])) break; if (_sp > XB_SPIN_CAP) { atomicAdd(&(bar)[XB_TMO], 1u); break; } } } } while (0)

struct XcdBarrier {
    unsigned* bar; unsigned x;
    volatile LAS unsigned* st;
};

__device__ __forceinline__ XcdBarrier xcd_barrier_post(unsigned* bar, volatile LAS unsigned* st) {
    XcdBarrier b; b.bar = bar; b.x = xb_xcc_id(); b.st = st;
    if (threadIdx.x == 0) (void)xb_add(&bar[XB_XCNT(b.x)], 1u);
    return b;
}
__device__ __forceinline__ void xcd_barrier_complete(unsigned* bar, unsigned x, unsigned& nloc, unsigned& nx) {
    const unsigned G = gridDim.x * gridDim.y * gridDim.z;
    unsigned sum, cnt, mine, sp = 0u;
    for (;;) {
        sum = 0u; cnt = 0u; mine = 0u;
#pragma unroll
        for (unsigned j = 0; j < 16; ++j) { const unsigned c = xb_ld(&bar[XB_XCNT(j)]); sum += c; cnt += (c > 0u) ? 1u : 0u; mine = (j == x) ? c : mine; }
        if (sum == G) break;
        __builtin_amdgcn_s_sleep(1);
        if ((++sp & 255u) == 0u) { if (xb_ld(&bar[XB_TMO])) break; if (sp > XB_SPIN_CAP) { atomicAdd(&bar[XB_TMO], 1u); break; } }
    }
    nloc = mine > 0u ? mine : 1u; nx = cnt > 0u ? cnt : 1u;
}

__device__ __forceinline__ void xcd_barrier(const XcdBarrier& b) {
    asm volatile("s_waitcnt vmcnt(0)" ::: "memory");
    __syncthreads();
    if (threadIdx.x == 0) {
        unsigned* bar = b.bar;
        __builtin_amdgcn_s_waitcnt(0);
        unsigned nloc = b.st[0], nx = b.st[1];
        if (nloc == 0u) { xcd_barrier_complete(bar, b.x, nloc, nx); b.st[0] = nloc; b.st[1] = nx; }
        const unsigned old = xb_add(&bar[XB_XSUB(b.x)], 1u);
        const unsigned gen = old / nloc;
        if (old + 1u == (gen + 1u) * nloc) {
            __builtin_amdgcn_fence(__ATOMIC_RELEASE, "agent");
            asm volatile("s_waitcnt vmcnt(0)" ::: "memory");
            const unsigned og = xb_add(&bar[XB_TOP], 1u);
            const unsigned tg = og / nx;
            if (og + 1u == (tg + 1u) * nx) xb_add(&bar[XB_TOPGEN], 1u);
            else XB_SPIN(xb_ld(&bar[XB_TOPGEN]) == tg, bar);
            __builtin_amdgcn_fence(__ATOMIC_ACQUIRE, "agent");
            xb_add(&bar[XB_XGEN(b.x)], 1u);
            asm volatile("s_waitcnt vmcnt(0)" ::: "memory");
        } else {
            XB_SPIN(xb_ld(&bar[XB_XGEN(b.x)]) == gen, bar);
            __builtin_amdgcn_fence(__ATOMIC_ACQUIRE, "agent");
            asm volatile("s_waitcnt vmcnt(0)" ::: "memory");
        }
    }
    __syncthreads();
}
constexpr unsigned TP = 272u, TILE_BYTES = 128u * TP;
__device__ __forceinline__ unsigned offb(unsigned row, unsigned ch) { return TP * row + 16u * ch; }
__device__ __forceinline__ bf16x8 frag_row(ldsp rb, int idx, int ks) { return *(const LAS bf16x8*)(rb + 16u * TP * idx + 64u * ks); }
__device__ __forceinline__ bf16x8 frag_tr(ldsp tb, int idx, int ks) {
    const s16x4 lo = __builtin_bit_cast(s16x4, __builtin_amdgcn_ds_read_tr16_b64_v4i16((LAS s16x4*)(tb + 32u * TP * ks + 32u * idx)));
    const s16x4 hi = __builtin_bit_cast(s16x4, __builtin_amdgcn_ds_read_tr16_b64_v4i16((LAS s16x4*)(tb + 32u * TP * ks + 4u * TP + 32u * idx)));
    return (bf16x8){lo[0], lo[1], lo[2], lo[3], hi[0], hi[1], hi[2], hi[3]};
}
__device__ __forceinline__ ldsp row_base(ldsp T, int lane) { return T + TP * (unsigned)(lane & 15) + 16u * (unsigned)(lane >> 4); }
__device__ __forceinline__ ldsp tr_base(ldsp T, int lane) { return T + TP * (8u * (unsigned)(lane >> 4) + (((unsigned)lane & 15u) >> 2)) + 8u * ((unsigned)lane & 3u); }
template <bool A_TR, bool B_TR>
__device__ __forceinline__ void mm128(f32x4 (&acc)[8], ldsp TA, ldsp TB, int w, int lane) {
    const ldsp ab = A_TR ? tr_base(TA, lane) + 32u * w : row_base(TA, lane) + 16u * TP * w;
    const ldsp bb = B_TR ? tr_base(TB, lane) : row_base(TB, lane);
#pragma unroll
    for (int ks = 0; ks < 4; ++ks) {
        const bf16x8 a = A_TR ? frag_tr(ab, 0, ks) : frag_row(ab, 0, ks);
#pragma unroll
        for (int c = 0; c < 8; ++c) {
            const bf16x8 b = B_TR ? frag_tr(bb, c, ks) : frag_row(bb, c, ks);
            acc[c] = __builtin_amdgcn_mfma_f32_16x16x32_bf16(b, a, acc[c], 0, 0, 0);
        }
    }
}
__device__ __forceinline__ void zero8(f32x4 (&a)[8]) {
#pragma unroll
    for (int c = 0; c < 8; ++c) a[c] = (f32x4){0.f, 0.f, 0.f, 0.f};
}
__device__ __forceinline__ void load_tile(ldsp T, const bf16* src, size_t ld, int tid) {
#pragma unroll
    for (int i = 0; i < 4; ++i) { const int ck = tid + 512 * i, r = ck >> 4, ch = ck & 15;
        const v4u v = *(const v4u*)(src + (size_t)r * ld + 8 * ch);
        *(LAS v4u*)(T + offb(r, ch)) = v; }
}
template <bool TWO>
__device__ __forceinline__ void load_tile_rope(ldsp T0, ldsp T1, const bf16* src, size_t ld, int pos0, const float* cosT, const float* sinT, float scale,
                                               float l2_0, float a0_0, float a1_0, float l2_1, float a0_1, float a1_1, int tid) {
#pragma unroll
    for (int i = 0; i < 2; ++i) { const int pr = tid + 512 * i, r = pr >> 3, ch = pr & 7;
        const v4u lo = *(const v4u*)(src + (size_t)r * ld + 8 * ch), hi = *(const v4u*)(src + (size_t)r * ld + 64 + 8 * ch);
        const f32x4 c0 = *(const f32x4*)(cosT + (size_t)(pos0 + r) * 64 + 8 * ch), c1 = *(const f32x4*)(cosT + (size_t)(pos0 + r) * 64 + 8 * ch + 4);
        const f32x4 s0 = *(const f32x4*)(sinT + (size_t)(pos0 + r) * 64 + 8 * ch), s1 = *(const f32x4*)(sinT + (size_t)(pos0 + r) * 64 + 8 * ch + 4);
        const float cs[8] = {c0[0], c0[1], c0[2], c0[3], c1[0], c1[1], c1[2], c1[3]}, sn[8] = {s0[0], s0[1], s0[2], s0[3], s1[0], s1[1], s1[2], s1[3]};
        const unsigned lw[4] = {lo[0], lo[1], lo[2], lo[3]}, hw[4] = {hi[0], hi[1], hi[2], hi[3]};
        float ol[8], oh[8];
#pragma unroll
        for (int k = 0; k < 4; ++k) {
            const float l0 = bf_lo(lw[k]), l1 = bf_hi(lw[k]), h0 = bf_lo(hw[k]), h1 = bf_hi(hw[k]);
            ol[2 * k] = l0 * cs[2 * k] - h0 * sn[2 * k]; ol[2 * k + 1] = l1 * cs[2 * k + 1] - h1 * sn[2 * k + 1];
            oh[2 * k] = h0 * cs[2 * k] + l0 * sn[2 * k]; oh[2 * k + 1] = h1 * cs[2 * k + 1] + l1 * sn[2 * k + 1];
        }
        const float sc0 = scale * __builtin_amdgcn_exp2f(l2_0 * (a0_0 + a1_0 * (float)r));
        v4u wl, wh;
        wl[0] = cvt_pk_bf16(ol[0] * sc0, ol[1] * sc0); wl[1] = cvt_pk_bf16(ol[2] * sc0, ol[3] * sc0); wl[2] = cvt_pk_bf16(ol[4] * sc0, ol[5] * sc0); wl[3] = cvt_pk_bf16(ol[6] * sc0, ol[7] * sc0);
        wh[0] = cvt_pk_bf16(oh[0] * sc0, oh[1] * sc0); wh[1] = cvt_pk_bf16(oh[2] * sc0, oh[3] * sc0); wh[2] = cvt_pk_bf16(oh[4] * sc0, oh[5] * sc0); wh[3] = cvt_pk_bf16(oh[6] * sc0, oh[7] * sc0);
        *(LAS v4u*)(T0 + offb(r, ch)) = wl; *(LAS v4u*)(T0 + offb(r, ch + 8)) = wh;
        if (TWO) {
            const float sc1 = scale * __builtin_amdgcn_exp2f(l2_1 * (a0_1 + a1_1 * (float)r));
            wl[0] = cvt_pk_bf16(ol[0] * sc1, ol[1] * sc1); wl[1] = cvt_pk_bf16(ol[2] * sc1, ol[3] * sc1); wl[2] = cvt_pk_bf16(ol[4] * sc1, ol[5] * sc1); wl[3] = cvt_pk_bf16(ol[6] * sc1, ol[7] * sc1);
            wh[0] = cvt_pk_bf16(oh[0] * sc1, oh[1] * sc1); wh[1] = cvt_pk_bf16(oh[2] * sc1, oh[3] * sc1); wh[2] = cvt_pk_bf16(oh[4] * sc1, oh[5] * sc1); wh[3] = cvt_pk_bf16(oh[6] * sc1, oh[7] * sc1);
            *(LAS v4u*)(T1 + offb(r, ch)) = wl; *(LAS v4u*)(T1 + offb(r, ch + 8)) = wh;
        }
    }
}
__device__ __forceinline__ void store_acc_tile(ldsp T, const f32x4 (&a)[8], int w, int lane) {
    const unsigned fr = lane & 15, fq = lane >> 4, row = 16u * w + fr;
#pragma unroll
    for (int c = 0; c < 8; ++c) { v2u v; v[0] = cvt_pk_bf16(a[c][0], a[c][1]); v[1] = cvt_pk_bf16(a[c][2], a[c][3]);
        *(LAS v2u*)(T + offb(row, 2u * c + (fq >> 1)) + 8u * (fq & 1)) = v; }
}
__device__ __forceinline__ float wave_sum(float v) {
#pragma unroll
    for (int o = 1; o < 64; o <<= 1) v += __shfl_xor(v, o);
    return v;
}

__device__ __forceinline__ void attn_unit(ldsp lds, const bf16* proj, bf16* mix, const float* cosT, const float* sinT, const float* sink, int unit, int tid) {
    const int lane = tid & 63, w = __builtin_amdgcn_readfirstlane(tid >> 6), fr = lane & 15, fq = lane >> 4;
    const int hq = unit & 15, n = (unit >> 4) & 31, b = unit >> 9, kh = hq >> 2;
    const ldsp TQ = lds, TK = lds + TILE_BYTES, TV = lds + 2 * TILE_BYTES, TPp = lds + 3 * TILE_BYTES;
    const size_t row0 = (size_t)b * SEQ + (size_t)n * CHUNK;
    __syncthreads();
    load_tile_rope<false>(TQ, TQ, proj + row0 * INW + C_AQ + hq * HDIM, INW, n * CHUNK, cosT, sinT, QK_SCALE, 0.f, 0.f, 0.f, 0.f, 0.f, 0.f, tid);
    float mrun = sink[hq], lrun = 1.0f;
    f32x4 O[8]; zero8(O);
    const int i = 16 * w + fr;
    for (int rel = -1; rel <= 1; ++rel) {
        const int jb = n + rel;
        if (jb < 0 || jb >= NCH) continue;
        __syncthreads();
        const size_t krow0 = (size_t)b * SEQ + (size_t)jb * CHUNK;
        load_tile_rope<false>(TK, TK, proj + krow0 * INW + C_AK + kh * HDIM, INW, jb * CHUNK, cosT, sinT, 1.0f, 0.f, 0.f, 0.f, 0.f, 0.f, 0.f, tid);
        load_tile(TV, proj + krow0 * INW + C_AV + kh * HDIM, INW, tid);
        __syncthreads();
        f32x4 S[8]; zero8(S);
        mm128<false, false>(S, TQ, TK, w, lane);
        float mx = -1e30f;
#pragma unroll
        for (int c = 0; c < 8; ++c)
#pragma unroll
            for (int j = 0; j < 4; ++j) { const int col = 16 * c + 4 * fq + j;
                const bool valid = (rel == 0) || (rel < 0 ? (col >= i) : (col <= i));
                const float s = valid ? S[c][j] : -1e30f; S[c][j] = s; mx = fmaxf(mx, s); }
        mx = fmaxf(mx, __shfl_xor(mx, 16)); mx = fmaxf(mx, __shfl_xor(mx, 32));
        const float mnew = fmaxf(mrun, mx), alpha = __builtin_amdgcn_exp2f((mrun - mnew) * LOG2E);
        float rs = 0.f;
#pragma unroll
        for (int c = 0; c < 8; ++c)
#pragma unroll
            for (int j = 0; j < 4; ++j) { const float p = __builtin_amdgcn_exp2f((S[c][j] - mnew) * LOG2E); S[c][j] = p; rs += p; }
        rs += __shfl_xor(rs, 16); rs += __shfl_xor(rs, 32);
        lrun = lrun * alpha + rs; mrun = mnew;
#pragma unroll
        for (int c = 0; c < 8; ++c) O[c] = O[c] * alpha;
        store_acc_tile(TPp, S, w, lane);
        __syncthreads();
        mm128<false, true>(O, TPp, TV, w, lane);
    }
    const float inv = 1.0f / lrun;
    bf16* orow = mix + (row0 + i) * DM + MIX_C + hq * HDIM + 4 * fq;
#pragma unroll
    for (int c = 0; c < 8; ++c) { v2u v; v[0] = cvt_pk_bf16(O[c][0] * inv, O[c][1] * inv); v[1] = cvt_pk_bf16(O[c][2] * inv, O[c][3] * inv);
        *(v2u*)(orow + 16 * c) = v; }
}

__device__ __forceinline__ void sgu_unit(ldsp lds, const bf16* proj, bf16* mix, const float* ln_g, const float* ln_b, const float* w_s, const float* b_s, int unit, int tid) {
    const int lane = tid & 63, w = __builtin_amdgcn_readfirstlane(tid >> 6), fr = lane & 15, fq = lane >> 4;
    const int g = unit & 7, n = (unit >> 3) & 31, b = unit >> 8;
    const ldsp TA = lds, TB = lds + TILE_BYTES;
    LAS float* stat = (LAS float*)(lds + 3 * TILE_BYTES);
    const size_t row0 = (size_t)b * SEQ + (size_t)n * CHUNK;
    __syncthreads();
    for (int t = 0; t < 16; ++t) { const int tok = 16 * w + t;
        const bf16* vr = proj + (row0 + tok) * INW + C_V;
        const v4u a = *(const v4u*)(vr + 8 * lane), c = *(const v4u*)(vr + 512 + 8 * lane);
        float s = 0.f, ss = 0.f;
#pragma unroll
        for (int k = 0; k < 4; ++k) { const float x0 = bf_lo(a[k]), x1 = bf_hi(a[k]), y0 = bf_lo(c[k]), y1 = bf_hi(c[k]);
            s += (x0 + x1) + (y0 + y1); ss += (x0 * x0 + x1 * x1) + (y0 * y0 + y1 * y1); }
        s = wave_sum(s); ss = wave_sum(ss);
        const float mean = s * (1.f / 1024.f), var = fmaxf(ss * (1.f / 1024.f) - mean * mean, 0.f);
        if (lane == 0) { stat[2 * tok] = mean; stat[2 * tok + 1] = rsqrtf(var + NORM_EPS); }
    }
    const float* ws = w_s + (size_t)g * CHUNK * CHUNK;
#pragma unroll
    for (int i = 0; i < 4; ++i) { const int ck = tid + 512 * i, r = ck >> 4, ch = ck & 15;
        const f32x4 x = *(const f32x4*)(ws + r * 128 + 8 * ch), y = *(const f32x4*)(ws + r * 128 + 8 * ch + 4);
        v4u v; v[0] = cvt_pk_bf16(x[0], x[1]); v[1] = cvt_pk_bf16(x[2], x[3]); v[2] = cvt_pk_bf16(y[0], y[1]); v[3] = cvt_pk_bf16(y[2], y[3]);
        *(LAS v4u*)(TA + offb(r, ch)) = v; }
    __syncthreads();
#pragma unroll
    for (int i = 0; i < 4; ++i) { const int ck = tid + 512 * i, r = ck >> 4, ch = ck & 15;
        const v4u v = *(const v4u*)(proj + (row0 + r) * INW + C_V + g * HDIM + 8 * ch);
        const float mean = stat[2 * r], rstd = stat[2 * r + 1];
        const f32x4 g0 = *(const f32x4*)(ln_g + g * HDIM + 8 * ch), g1 = *(const f32x4*)(ln_g + g * HDIM + 8 * ch + 4);
        const f32x4 b0 = *(const f32x4*)(ln_b + g * HDIM + 8 * ch), b1 = *(const f32x4*)(ln_b + g * HDIM + 8 * ch + 4);
        v4u o;
        o[0] = cvt_pk_bf16((bf_lo(v[0]) - mean) * rstd * g0[0] + b0[0], (bf_hi(v[0]) - mean) * rstd * g0[1] + b0[1]);
        o[1] = cvt_pk_bf16((bf_lo(v[1]) - mean) * rstd * g0[2] + b0[2], (bf_hi(v[1]) - mean) * rstd * g0[3] + b0[3]);
        o[2] = cvt_pk_bf16((bf_lo(v[2]) - mean) * rstd * g1[0] + b1[0], (bf_hi(v[2]) - mean) * rstd * g1[1] + b1[1]);
        o[3] = cvt_pk_bf16((bf_lo(v[3]) - mean) * rstd * g1[2] + b1[2], (bf_hi(v[3]) - mean) * rstd * g1[3] + b1[3]);
        *(LAS v4u*)(TB + offb(r, ch)) = o; }
    __syncthreads();
    f32x4 acc[8]; zero8(acc);
    mm128<false, true>(acc, TA, TB, w, lane);
    const int i = 16 * w + fr;
    const float bs = b_s[g * CHUNK + i];
    const bf16* urow = proj + (row0 + i) * INW + C_U + g * HDIM + 4 * fq;
    bf16* orow = mix + (row0 + i) * DM + MIX_A + g * HDIM + 4 * fq;
#pragma unroll
    for (int c = 0; c < 8; ++c) { const v2u u = *(const v2u*)(urow + 16 * c);
        v2u v; v[0] = cvt_pk_bf16(bf_lo(u[0]) * (acc[c][0] + bs), bf_hi(u[0]) * (acc[c][1] + bs)); v[1] = cvt_pk_bf16(bf_lo(u[1]) * (acc[c][2] + bs), bf_hi(u[1]) * (acc[c][3] + bs));
        *(v2u*)(orow + 16 * c) = v; }
}

__device__ __forceinline__ void retkv_unit(ldsp lds, const bf16* proj, float* kv, const float* cosT, const float* sinT, const float* ldr, int unit, int tid) {
    const int lane = tid & 63, w = __builtin_amdgcn_readfirstlane(tid >> 6), fr = lane & 15, fq = lane >> 4;
    const int h = unit & 7, n = (unit >> 3) & 31, b = unit >> 8;
    const ldsp TV = lds, TKF = lds + TILE_BYTES, TKB = lds + 2 * TILE_BYTES;
    const size_t row0 = (size_t)b * SEQ + (size_t)n * CHUNK;
    const float l2f = -__expf(ldr[h]) * LOG2E, l2b = -__expf(ldr[NRH + h]) * LOG2E;
    __syncthreads();
    load_tile(TV, proj + row0 * INW + C_RV + h * HDIM, INW, tid);
    load_tile_rope<true>(TKF, TKB, proj + row0 * INW + C_RK + h * HDIM, INW, n * CHUNK, cosT, sinT, QK_SCALE, l2f, 127.f, -1.f, l2b, 0.f, 1.f, tid);
    __syncthreads();
    const int e = 16 * w + fr;
#pragma unroll
    for (int dir = 0; dir < 2; ++dir) {
        f32x4 acc[8]; zero8(acc);
        mm128<true, true>(acc, TV, dir ? TKB : TKF, w, lane);
        float* o = kv + ((((size_t)dir * BATCH + b) * NRH + h) * NCH + n) * (size_t)(HDIM * HDIM) + (size_t)e * HDIM + 4 * fq;
#pragma unroll
        for (int c = 0; c < 8; ++c) *(f32x4*)(o + 16 * c) = acc[c];
    }
}

__device__ __forceinline__ void ret_scan(const float* __restrict__ kv, bf16* __restrict__ st, const float* ldr, int gtid, int gthreads) {
    constexpr int NVEC = 2 * BATCH * NRH * (HDIM * HDIM / 4);
    for (int v = gtid; v < NVEC; v += gthreads) {
        const int el = v & 4095, bh = v >> 12, h = bh & 7, dir = bh >> 5;
        const float cd = __expf(-__expf(ldr[dir * NRH + h]) * (float)CHUNK);
        const size_t base = (size_t)bh * NCH * (HDIM * HDIM) + (size_t)el * 4;
        f32x4 s = (f32x4){0.f, 0.f, 0.f, 0.f};
#pragma unroll 8
        for (int t = 0; t < NCH; ++t) { const int n = dir ? (NCH - 1 - t) : t;
            const size_t o = base + (size_t)n * (HDIM * HDIM);
            const f32x4 x = *(const f32x4*)(kv + o);
            v2u ov; ov[0] = cvt_pk_bf16(s[0], s[1]); ov[1] = cvt_pk_bf16(s[2], s[3]);
            *(v2u*)(st + o) = ov;
            s = s * cd + x; }
    }
}

__device__ __forceinline__ void retout_unit(ldsp lds, const bf16* proj, const bf16* st, bf16* mix, const float* cosT, const float* sinT, const float* ldr, int unit, int tid) {
    const int lane = tid & 63, w = __builtin_amdgcn_readfirstlane(tid >> 6), fr = lane & 15, fq = lane >> 4;
    const int h = unit & 7, n = (unit >> 3) & 31, b = unit >> 8;
    const ldsp TQ = lds, TK = lds + TILE_BYTES, TV = lds + 2 * TILE_BYTES, TS = lds + 3 * TILE_BYTES;
    const size_t row0 = (size_t)b * SEQ + (size_t)n * CHUNK;
    const float l2f = -__expf(ldr[h]) * LOG2E, l2b = -__expf(ldr[NRH + h]) * LOG2E;
    const bf16* stf = st + ((((size_t)0 * BATCH + b) * NRH + h) * NCH + n) * (size_t)(HDIM * HDIM);
    const bf16* stb = st + ((((size_t)1 * BATCH + b) * NRH + h) * NCH + n) * (size_t)(HDIM * HDIM);
    __syncthreads();
    load_tile_rope<false>(TQ, TQ, proj + row0 * INW + C_RQ + h * HDIM, INW, n * CHUNK, cosT, sinT, 1.0f, 0.f, 0.f, 0.f, 0.f, 0.f, 0.f, tid);
    load_tile_rope<false>(TK, TK, proj + row0 * INW + C_RK + h * HDIM, INW, n * CHUNK, cosT, sinT, QK_SCALE, 0.f, 0.f, 0.f, 0.f, 0.f, 0.f, tid);
    load_tile(TV, proj + row0 * INW + C_RV + h * HDIM, INW, tid);
    load_tile(TS, stf, HDIM, tid);
    __syncthreads();
    const int i = 16 * w + fr;
    f32x4 P[8]; zero8(P);
    mm128<false, false>(P, TQ, TK, w, lane);
#pragma unroll
    for (int c = 0; c < 8; ++c)
#pragma unroll
        for (int j = 0; j < 4; ++j) { const int dl = i - (16 * c + 4 * fq + j);
            P[c][j] *= __builtin_amdgcn_exp2f(dl >= 0 ? l2f * (float)dl : l2b * (float)(-dl)); }
    f32x4 accF[8]; zero8(accF);
    mm128<false, false>(accF, TQ, TS, w, lane);
    __syncthreads();
    store_acc_tile(TK, P, w, lane);
    load_tile(TS, stb, HDIM, tid);
    __syncthreads();
    f32x4 acc[8]; zero8(acc);
    mm128<false, false>(acc, TQ, TS, w, lane);
    const float wf = __builtin_amdgcn_exp2f(l2f * (float)(i + 1)), wb = __builtin_amdgcn_exp2f(l2b * (float)(CHUNK - i));
#pragma unroll
    for (int c = 0; c < 8; ++c) acc[c] = acc[c] * wb + accF[c] * wf;
    mm128<false, true>(acc, TK, TV, w, lane);
    float ss = 0.f;
#pragma unroll
    for (int c = 0; c < 8; ++c) ss += (acc[c][0] * acc[c][0] + acc[c][1] * acc[c][1]) + (acc[c][2] * acc[c][2] + acc[c][3] * acc[c][3]);
    ss += __shfl_xor(ss, 16); ss += __shfl_xor(ss, 32);
    const float rn = rsqrtf(ss * (1.f / 128.f) + NORM_EPS);
    const bf16* grow = proj + (row0 + i) * INW + C_RG + h * HDIM + 4 * fq;
    bf16* orow = mix + (row0 + i) * DM + MIX_R + h * HDIM + 4 * fq;
#pragma unroll
    for (int c = 0; c < 8; ++c) { const v2u gw = *(const v2u*)(grow + 16 * c);
        const float g0 = bf_lo(gw[0]), g1 = bf_hi(gw[0]), g2 = bf_lo(gw[1]), g3 = bf_hi(gw[1]);
        const float s0 = g0 / (1.f + __expf(-g0)), s1 = g1 / (1.f + __expf(-g1)), s2 = g2 / (1.f + __expf(-g2)), s3 = g3 / (1.f + __expf(-g3));
        v2u v; v[0] = cvt_pk_bf16(s0 * acc[c][0] * rn, s1 * acc[c][1] * rn); v[1] = cvt_pk_bf16(s2 * acc[c][2] * rn, s3 * acc[c][3] * rn);
        *(v2u*)(orow + 16 * c) = v; }
}

__device__ __forceinline__ void rms_rows_bf16(const float* x, const float* g, bf16* out, int gw, int ngw, int lane) {
    for (int m = gw; m < M; m += ngw) {
        const f32x4* xr = (const f32x4*)(x + (size_t)m * DM) + lane;
        f32x4 v[16]; float ss = 0.f;
#pragma unroll
        for (int j = 0; j < 16; ++j) { v[j] = xr[64 * j]; ss += (v[j][0] * v[j][0] + v[j][1] * v[j][1]) + (v[j][2] * v[j][2] + v[j][3] * v[j][3]); }
        const float rstd = rsqrtf(wave_sum(ss) * (1.f / DM) + NORM_EPS);
        v2u* o = (v2u*)(out + (size_t)m * DM) + lane;
#pragma unroll
        for (int j = 0; j < 16; ++j) { const f32x4 gg = *((const f32x4*)g + 64 * j + lane);
            v2u ov; ov[0] = cvt_pk_bf16(v[j][0] * rstd * gg[0], v[j][1] * rstd * gg[1]); ov[1] = cvt_pk_bf16(v[j][2] * rstd * gg[2], v[j][3] * rstd * gg[3]);
            o[64 * j] = ov; }
    }
}
__device__ __forceinline__ void rms_rows_f32(float* x, const float* g, int gw, int ngw, int lane) {
    for (int m = gw; m < M; m += ngw) {
        f32x4* xr = (f32x4*)(x + (size_t)m * DM) + lane;
        f32x4 v[16]; float ss = 0.f;
#pragma unroll
        for (int j = 0; j < 16; ++j) { v[j] = xr[64 * j]; ss += (v[j][0] * v[j][0] + v[j][1] * v[j][1]) + (v[j][2] * v[j][2] + v[j][3] * v[j][3]); }
        const float rstd = rsqrtf(wave_sum(ss) * (1.f / DM) + NORM_EPS);
#pragma unroll
        for (int j = 0; j < 16; ++j) { const f32x4 gg = *((const f32x4*)g + 64 * j + lane); xr[64 * j] = v[j] * rstd * gg; }
    }
}
__device__ __forceinline__ void transpose_item(const float* W, int K, int N, bf16* WT, LAS float* scr, int item, int lane) {
    const int nblk = N / 32, kb = item / nblk, nb = item % nblk, k0 = 64 * kb, n0 = 32 * nb;
#pragma unroll 8
    for (int i = 0; i < 32; ++i) { const int kk = 2 * i + (lane >> 5); scr[kk * 33 + (lane & 31)] = W[(size_t)(k0 + kk) * N + n0 + (lane & 31)]; }
    LDS_WAIT(); asm volatile("" ::: "memory");
    const int c = lane & 7;
#pragma unroll
    for (int j = 0; j < 4; ++j) { const int n = (lane >> 3) + 8 * j; const LAS float* s = scr + (8 * c) * 33 + n;
        v4u o; o[0] = cvt_pk_bf16(s[0 * 33], s[1 * 33]); o[1] = cvt_pk_bf16(s[2 * 33], s[3 * 33]); o[2] = cvt_pk_bf16(s[4 * 33], s[5 * 33]); o[3] = cvt_pk_bf16(s[6 * 33], s[7 * 33]);
        *(v4u*)(WT + (size_t)(n0 + n) * K + k0 + 8 * c) = o; }
    LDS_WAIT(); asm volatile("" ::: "memory");
}
#ifndef MK_MULTI
#define MK_MULTI 0
#endif
constexpr int NPH = 1 + 9 * DEPTH;
struct Args { const float* in[14]; float* out; unsigned char* ws; int ph_lo, ph_hi; };
__global__ void __launch_bounds__(NWAVES * 64, 2) hybrid_fwd(Args args) {
    extern __shared__ __attribute__((aligned(16))) unsigned char lds_raw[];
    const ldsp lds = (ldsp)lds_raw;
    volatile LAS unsigned* MISC = (volatile LAS unsigned*)(lds + MISC_OFF);
    const int tid = threadIdx.x;
    const int G = gridDim.x, bx = blockIdx.x;
    const int ngw = G * NWAVES;
    unsigned char* ws = args.ws;
    unsigned* ctl = (unsigned*)(ws + WS_CTL);
    const float* x_in = args.in[0]; const float* ln_mix_g = args.in[1]; const float* w_in = args.in[2]; const float* sgu_ln_g = args.in[3]; const float* sgu_ln_b = args.in[4];
    const float* sgu_w = args.in[5]; const float* sgu_b = args.in[6]; const float* ret_ld = args.in[7]; const float* attn_sink = args.in[8]; const float* w_out = args.in[9];
    const float* ln_mlp_g = args.in[10]; const float* w_up = args.in[11]; const float* w_down = args.in[12]; const float* final_g = args.in[13];
    float* out = args.out;
    float* cosT = (float*)(ws + WS_COS); float* sinT = (float*)(ws + WS_SIN);
    bf16* WinT = (bf16*)(ws + WS_WIN); bf16* WoutT = (bf16*)(ws + WS_WOUT); bf16* WupT = (bf16*)(ws + WS_WUP); bf16* WdnT = (bf16*)(ws + WS_WDN);
    bf16* Hb = (bf16*)(ws + WS_H); bf16* PROJ = (bf16*)(ws + WS_PROJ); bf16* MIX = (bf16*)(ws + WS_MIX); bf16* HID = (bf16*)(ws + WS_HID);
    float* KV = (float*)(ws + WS_KV); bf16* ST = (bf16*)(ws + WS_ST);

    for (int u = tid; u < (LDS_BYTES - LDSCTL_OFF) / 4; u += NWAVES * 64) ((LAS unsigned*)(lds + LDSCTL_OFF))[u] = 0u;
    __syncthreads();
#if !MK_MULTI
    XcdBarrier bar = xcd_barrier_post(ctl + CW_BAR, MISC + 8);
#define GRID_BAR() xcd_barrier(bar)
#else
#define GRID_BAR() do {} while (0)
#endif
    const int lo = args.ph_lo, hi = args.ph_hi;
#ifndef MK_ONLY
#define MK_ONLY -1
#endif
#ifndef MK_SUB
#define MK_SUB -1
#endif
#define SUB(k) (MK_SUB < 0 || MK_SUB == (k))
#define SITE(k) (MK_ONLY < 0 || MK_ONLY == (k))
#define IN(k) (lo <= (k) && (k) < hi)
#define FRESH_TID() int tz = threadIdx.x; asm volatile("" : "+v"(tz)); const int lz = tz & 63, wz = __builtin_amdgcn_readfirstlane(tz >> 6), gwz = bx * NWAVES + wz; (void)lz; (void)gwz

    if (SITE(0) && IN(0)) {
        FRESH_TID();
        LAS float* scr = (LAS float*)(lds + wz * 16384);
        constexpr int I_IN = (DM / 64) * (INW / 32), I_OUT = (DM / 64) * (DM / 32), I_UP = (DM / 64) * (DFF / 32), I_DN = (DFF / 64) * (DM / 32);
        constexpr int I_LAYER = I_IN + I_OUT + I_UP + I_DN;
        for (int it = gwz; it < DEPTH * I_LAYER; it += ngw) {
            const int l = it / I_LAYER; int r = it - l * I_LAYER;
            if (r < I_IN) { transpose_item(w_in + (size_t)l * DM * INW, DM, INW, WinT + (size_t)l * INW * DM, scr, r, lz); continue; } r -= I_IN;
            if (r < I_OUT) { transpose_item(w_out + (size_t)l * DM * DM, DM, DM, WoutT + (size_t)l * DM * DM, scr, r, lz); continue; } r -= I_OUT;
            if (r < I_UP) { transpose_item(w_up + (size_t)l * DM * DFF, DM, DFF, WupT + (size_t)l * DFF * DM, scr, r, lz); continue; } r -= I_UP;
            transpose_item(w_down + (size_t)l * DFF * DM, DFF, DM, WdnT + (size_t)l * DM * DFF, scr, r, lz);
        }
        for (int e = bx * (NWAVES * 64) + tz; e < SEQ * 64; e += G * NWAVES * 64) { const int pos = e >> 6, i2 = e & 63;
            const float inv = powf(10000.0f, -(float)(2 * i2) / 128.0f), ang = (float)pos * inv;
            cosT[e] = cosf(ang); sinT[e] = sinf(ang); }
        rms_rows_bf16(x_in, ln_mix_g, Hb, gwz, ngw, lz);
        GRID_BAR();
    }
    for (int l = 0; l < DEPTH; ++l) {
        const int p0 = 1 + 9 * l;
        const float* xres = (l == 0) ? x_in : out;
        if (SITE(1) && IN(p0 + 0)) {
            pg8::Gemm g{Hb, WinT + (size_t)l * INW * DM, M, INW, DM}; pg8::StaticOrder S; S.init(M, INW, G, bx);
            pg8::EpiIn E{PROJ, INW, 8};
            pg8::gemm_phase<pg8::EpiIn, pg8::StaticOrder, true, true>(lds, g, S, E);
            GRID_BAR();
        }
        if (SITE(2) && IN(p0 + 1)) {
            FRESH_TID();
            if (SUB(0)) for (int u = bx; u < 1024; u += G) retkv_unit(lds, PROJ, KV, cosT, sinT, ret_ld + l * 2 * NRH, u, tz);
            if (SUB(1)) for (int u = bx; u < 2048; u += G) attn_unit(lds, PROJ, MIX, cosT, sinT, attn_sink + l * NQH, u, tz);
            if (SUB(2)) for (int u = bx; u < 1024; u += G) sgu_unit(lds, PROJ, MIX, sgu_ln_g + l * 1024, sgu_ln_b + l * 1024, sgu_w + (size_t)l * NSG * CHUNK * CHUNK, sgu_b + l * NSG * CHUNK, u, tz);
            GRID_BAR();
        }
        if (SITE(3) && IN(p0 + 2)) {
            FRESH_TID();
            ret_scan(KV, ST, ret_ld + l * 2 * NRH, bx * (NWAVES * 64) + tz, G * NWAVES * 64);
            GRID_BAR();
        }
        if (SITE(4) && IN(p0 + 3)) {
            FRESH_TID();
            for (int u = bx; u < 1024; u += G) retout_unit(lds, PROJ, ST, MIX, cosT, sinT, ret_ld + l * 2 * NRH, u, tz);
            __syncthreads();
            GRID_BAR();
        }
        if (SITE(5) && IN(p0 + 4)) {
            pg8::Gemm g{MIX, WoutT + (size_t)l * DM * DM, M, DM, DM}; pg8::StaticOrder S; S.init(M, DM, G, bx);
            pg8::EpiRes E{xres, out, DM};
            pg8::gemm_phase<pg8::EpiRes, pg8::StaticOrder, true, true>(lds, g, S, E);
            GRID_BAR();
        }
        if (SITE(6) && IN(p0 + 5)) {
            FRESH_TID();
            rms_rows_bf16(out, ln_mlp_g + l * DM, Hb, gwz, ngw, lz);
            GRID_BAR();
        }
        if (SITE(7) && IN(p0 + 6)) {
            pg8::Gemm g{Hb, WupT + (size_t)l * DFF * DM, M, DFF, DM}; pg8::StaticOrder S; S.init(M, DFF, G, bx);
            pg8::EpiRelu2 E{HID, DFF};
            pg8::gemm_phase<pg8::EpiRelu2, pg8::StaticOrder, true, true>(lds, g, S, E);
            GRID_BAR();
        }
        if (SITE(8) && IN(p0 + 7)) {
            pg8::Gemm g{HID, WdnT + (size_t)l * DM * DFF, M, DM, DFF}; pg8::StaticOrder S; S.init(M, DM, G, bx);
            pg8::EpiRes E{out, out, DM};
            pg8::gemm_phase<pg8::EpiRes, pg8::StaticOrder, true, true>(lds, g, S, E);
            GRID_BAR();
        }
        if (SITE(9) && IN(p0 + 8)) {
            FRESH_TID();
            if (l + 1 < DEPTH) { rms_rows_bf16(out, ln_mix_g + (l + 1) * DM, Hb, gwz, ngw, lz); GRID_BAR(); }
            else rms_rows_f32(out, final_g, gwz, ngw, lz);
        }
    }
#undef IN
}

extern "C" void kernel_launch(void* const* d_in, const int* in_sizes, int n_in, void* d_out, int out_size, void* d_ws, size_t ws_size, hipStream_t stream) {
    static int grid = 0;
    if (grid == 0) {
        if (n_in != 14 || in_sizes[0] != M * DM || out_size != M * DM || ws_size < WS_END) { fprintf(stderr, "kernel_launch: unexpected shapes (n_in %d, in0 %d, out %d, ws %zu < %zu); nothing launched\n", n_in, n_in > 0 ? in_sizes[0] : -1, out_size, ws_size, (size_t)WS_END); grid = -1; return; }
        int dev = 0, cus = 0, per_cu = 0;
        if (hipGetDevice(&dev) != hipSuccess || hipDeviceGetAttribute(&cus, hipDeviceAttributeMultiprocessorCount, dev) != hipSuccess) { grid = -1; return; }
        if (hipFuncSetAttribute((const void*)hybrid_fwd, hipFuncAttributeMaxDynamicSharedMemorySize, LDS_BYTES) != hipSuccess) { fprintf(stderr, "kernel_launch: hipFuncSetAttribute failed\n"); grid = -1; return; }
        if (hipOccupancyMaxActiveBlocksPerMultiprocessor(&per_cu, (const void*)hybrid_fwd, NWAVES * 64, LDS_BYTES) != hipSuccess || per_cu < 1)
            fprintf(stderr, "kernel_launch: note: occupancy query reports %d workgroups per CU\n", per_cu);
        (void)hipGetLastError();
        grid = cus;
    }
    if (grid < 0) return;
    if (hipMemsetAsync((char*)d_ws + WS_CTL, 0, CTL_ZERO_BYTES, stream) != hipSuccess) { fprintf(stderr, "kernel_launch: memset failed\n"); return; }
    Args a{};
    for (int i = 0; i < 14; ++i) a.in[i] = (const float*)d_in[i];
    a.out = (float*)d_out; a.ws = (unsigned char*)d_ws;
#if MK_MULTI
    for (int p = 0; p < NPH; ++p) { a.ph_lo = p; a.ph_hi = p + 1; hipLaunchKernelGGL(hybrid_fwd, dim3(grid), dim3(NWAVES * 64), LDS_BYTES, stream, a); }
#else
    a.ph_lo = 0; a.ph_hi = NPH;
    hipLaunchKernelGGL(hybrid_fwd, dim3(grid), dim3(NWAVES * 64), LDS_BYTES, stream, a);
#endif
    const hipError_t le = hipPeekAtLastError();
    if (le != hipSuccess) fprintf(stderr, "kernel_launch: launch failed: %s\n", hipGetErrorName(le));
}
```

```cpp
#define HW_TID 1
#define MM_PIPE 0
#define ATTN_PIPE 0
#define ATTN_VFIX 0
#define ATTN_BIAS 1
#define ATTN_PAIR 1
#define SGU_EARLY 1
#include <hip/hip_runtime.h>
#include <cstdio>
#include <cstdint>
namespace pg8 {
#define PG8_LAS __attribute__((address_space(3)))
typedef unsigned short bf16_t;
typedef short bf16x8 __attribute__((ext_vector_type(8)));
typedef float f32x4 __attribute__((ext_vector_type(4)));
typedef unsigned u32x4 __attribute__((ext_vector_type(4)));
constexpr int BM = 256, BK = 64, HALF = 128, HTB = HALF * BK * 2  , STAGE_BYTES = 8 * HTB, NXCD = 8, WGM = 8;

__host__ __device__ __forceinline__ int lds_byte(int r, int c) { const int st = (r >> 4) * 2 + (c >> 5), rr = r & 15, cc = c & 31, ob = rr * 64 + cc * 2; return st * 1024 + (ob ^ (((ob >> 9) & 1) << 5)); }
__host__ __device__ __forceinline__ void stage_rc(int b, int& R, int& C) { const int st = b / 1024, sb = b % 1024, swz = sb ^ (((sb >> 9) & 1) << 5); R = (st >> 1) * 16 + swz / 64; C = (st & 1) * 32 + (swz % 64) / 2; }
__host__ __device__ __forceinline__ int perm32(int rho) { const int n = rho >> 4, i = rho & 15; return 8 * (i >> 2) + 4 * n + (i & 3); }

struct Unit { int pm, pn; };
struct Gemm { const bf16_t* A; const bf16_t* Bt; int M, N, K, lda, ldb; };
__host__ __device__ __forceinline__ size_t blocked_off(int row, int col, int K) { return (((size_t)(row >> 8) * (K >> 6) + (col >> 6)) * 256 + (row & 255)) * 64 + (col & 63); }

#ifndef HW_TID
#define HW_TID 0
#endif
constexpr int HWTAB_OFF = 139264 + 320 + 256;
__device__ __forceinline__ unsigned hw_slot() { return (unsigned)__builtin_amdgcn_s_getreg((5 << 11) | 4) & 63u; }
__device__ __forceinline__ int hw_lane() { int l; asm volatile("v_mbcnt_lo_u32_b32 %0, -1, 0\n\tv_mbcnt_hi_u32_b32 %0, -1, %0" : "=v"(l)); return l; }
__device__ __forceinline__ int hw_tid(__attribute__((address_space(3))) unsigned char* lds) {
#if HW_TID
    const int wv = __builtin_amdgcn_readfirstlane(*(volatile __attribute__((address_space(3))) int*)(lds + HWTAB_OFF + 4u * hw_slot()));
    return 64 * wv + hw_lane();
#else
    (void)lds; return (int)threadIdx.x;
#endif
}
struct StaticOrder {
    int nM, nN, nwg, G, c;
    __host__ __device__ void init(int M, int N, int G_, int c_) { nM = M / BM; nN = N / BM; nwg = nM * nN; G = G_; c = c_; }
    __host__ __device__ bool next(int i, Unit& u) const {
        const long L = (long)i * G + c; if (L >= nwg) return false;
        int wgid = (int)L; { const int q = nwg / NXCD, r = nwg % NXCD, xcd = wgid % NXCD, off = wgid / NXCD; wgid = (xcd < r ? xcd * (q + 1) : r * (q + 1) + (xcd - r) * q) + off; }
        const int nig = WGM * nN, gid = wgid / nig, fm = gid * WGM, gsz = (nM - fm) < WGM ? (nM - fm) : WGM;
        u.pm = fm + ((wgid % nig) % gsz); u.pn = (wgid % nig) / gsz; return true;
    }
    __device__ __forceinline__ void a_ready(const Unit&) const {}
    __device__ __forceinline__ void done(const Unit&) const {}
};

typedef float f32x2c_t __attribute__((ext_vector_type(2))); typedef __bf16 bf16x2c_t __attribute__((ext_vector_type(2)));
__device__ __forceinline__ unsigned cvt_pk_bf16(float lo, float hi) { const f32x2c_t v = {lo, hi}; return __builtin_bit_cast(unsigned, __builtin_convertvector(v, bf16x2c_t)); }
__device__ __forceinline__ float quad_sum(float x) {
    auto r = __builtin_amdgcn_permlane16_swap(__builtin_bit_cast(unsigned, x), __builtin_bit_cast(unsigned, x), false, false);
    x = __builtin_bit_cast(float, (unsigned)r[0]) + __builtin_bit_cast(float, (unsigned)r[1]);
    auto q = __builtin_amdgcn_permlane32_swap(__builtin_bit_cast(unsigned, x), __builtin_bit_cast(unsigned, x), false, false);
    return __builtin_bit_cast(float, (unsigned)q[0]) + __builtin_bit_cast(float, (unsigned)q[1]);
}
__device__ __forceinline__ float quad_max(float x) {
    auto r = __builtin_amdgcn_permlane16_swap(__builtin_bit_cast(unsigned, x), __builtin_bit_cast(unsigned, x), false, false);
    x = __builtin_fmaxf(__builtin_bit_cast(float, (unsigned)r[0]), __builtin_bit_cast(float, (unsigned)r[1]));
    auto q = __builtin_amdgcn_permlane32_swap(__builtin_bit_cast(unsigned, x), __builtin_bit_cast(unsigned, x), false, false);
    return __builtin_fmaxf(__builtin_bit_cast(float, (unsigned)q[0]), __builtin_bit_cast(float, (unsigned)q[1]));
}
typedef float f32x2 __attribute__((ext_vector_type(2)));
__device__ __forceinline__ f32x2 gelu_pk(f32x2 v) {
    const f32x2 av = __builtin_elementwise_abs(v), d = av * 0.2316418882f + 1.0f;
    f32x2 t; t.x = __builtin_amdgcn_rcpf(d.x); t.y = __builtin_amdgcn_rcpf(d.y);
    f32x2 q = t * 0.5307027145f + (-0.7265760135f); q = q * t + 0.7107068705f; q = q * t + (-0.142248368f); q = q * t + 0.127414796f; q = q * t;
    const f32x2 s = (v * v) * (-0.72134752044f);
    f32x2 e; e.x = __builtin_amdgcn_exp2f(s.x); e.y = __builtin_amdgcn_exp2f(s.y);
    const f32x2 m = v * (q * e), r = v - m;
    f32x2 o; o.x = v.x < 0.f ? m.x : r.x; o.y = v.y < 0.f ? m.y : r.y; return o;
}

#ifndef EPI_NT
#define EPI_NT 0
#endif
#if EPI_NT
#define EPI_STORE16(p, v) __builtin_nontemporal_store((v), (u32x4*)(p))
#else
#define EPI_STORE16(p, v) (*(u32x4*)(p) = (v))
#endif
struct RowScale {
    const PG8_LAS float* tab;
    __device__ __forceinline__ float get(int pm, int rl) const { return tab[((pm >> 4) << 8) + rl]; }
};
struct EpiIn {
    static constexpr bool PERM = true, AFTER_DRAIN = false;
    bf16_t* O; int ldc; RowScale rs; const float* invrev; float* sgup; int seq;
    __device__ __forceinline__ void operator()(const f32x4 (&acc)[2][2][4][2], const Unit& u, int wr, int wc, int fr, int fq) const {
        const int pn = u.pn, row0 = u.pm * BM + wr * 64 + fr;
        const bool rope = (pn >= 8 && pn < 16) || (pn >= 24 && pn < 34);
        if (rope) {
            const float qs = (pn >= 24 && pn < 32) ? 0.08838834764831845f * 1.4426950408889634f : ((pn >= 12 && pn < 16) ? 0.08838834764831845f : 1.0f);
            const int dp = 32 * (wc & 1) + 8 * fq, colr = pn * BM + 128 * (wc >> 1) + dp;
            f32x4 fr0 = *(const f32x4*)(invrev + dp), fr1 = *(const f32x4*)(invrev + dp + 4);
#pragma unroll
            for (int gi = 0; gi < 8; ++gi) { const int ai = gi >> 2, m = gi & 3;
                const int row = row0 + ai * HALF + m * 16; bf16_t* rowp = O + (size_t)row * ldc + colr;
                const float pos = (float)(row & (seq - 1));
                f32x4 c0, c1, s0, s1;
#pragma unroll
                for (int e = 0; e < 4; ++e) { const float t0 = __builtin_amdgcn_fractf(pos * fr0[e]), t1 = __builtin_amdgcn_fractf(pos * fr1[e]);
                    c0[e] = __builtin_amdgcn_cosf(t0); s0[e] = __builtin_amdgcn_sinf(t0); c1[e] = __builtin_amdgcn_cosf(t1); s1[e] = __builtin_amdgcn_sinf(t1); }
                const float rsc = rs.get(u.pm, wr * 64 + fr + ai * HALF + m * 16) * qs;
                const f32x4 l0 = acc[ai][0][m][0] * rsc, l1 = acc[ai][0][m][1] * rsc, h0 = acc[ai][1][m][0] * rsc, h1 = acc[ai][1][m][1] * rsc;
                const f32x4 ol0 = l0 * c0 - h0 * s0, ol1 = l1 * c1 - h1 * s1, oh0 = h0 * c0 + l0 * s0, oh1 = h1 * c1 + l1 * s1;
                u32x4 wl, wh;
                wl.x = cvt_pk_bf16(ol0[0], ol0[1]); wl.y = cvt_pk_bf16(ol0[2], ol0[3]); wl.z = cvt_pk_bf16(ol1[0], ol1[1]); wl.w = cvt_pk_bf16(ol1[2], ol1[3]);
                wh.x = cvt_pk_bf16(oh0[0], oh0[1]); wh.y = cvt_pk_bf16(oh0[2], oh0[3]); wh.z = cvt_pk_bf16(oh1[0], oh1[1]); wh.w = cvt_pk_bf16(oh1[2], oh1[3]);
                EPI_STORE16(rowp, wl); EPI_STORE16(rowp + 64, wh); }
        } else {
            const int col0 = pn * BM + wc * 32 + 8 * fq;
            const bool act = pn < 8, stats = pn >= 4 && pn < 8;
#pragma unroll
            for (int ai = 0; ai < 2; ++ai)
#pragma unroll
                for (int m = 0; m < 4; ++m) { const int row = row0 + ai * HALF + m * 16; bf16_t* rowp = O + (size_t)row * ldc + col0;
                    const float rsc = rs.get(u.pm, wr * 64 + fr + ai * HALF + m * 16);
                    float s = 0.f, ss = 0.f;
#pragma unroll
                    for (int bj = 0; bj < 2; ++bj) { f32x4 v0 = acc[ai][bj][m][0] * rsc, v1 = acc[ai][bj][m][1] * rsc;
                        if (act) { f32x2 a = gelu_pk((f32x2){v0[0], v0[1]}), b = gelu_pk((f32x2){v0[2], v0[3]}), c = gelu_pk((f32x2){v1[0], v1[1]}), d = gelu_pk((f32x2){v1[2], v1[3]});
                            v0 = (f32x4){a.x, a.y, b.x, b.y}; v1 = (f32x4){c.x, c.y, d.x, d.y};
                            s += ((v0[0] + v0[1]) + (v0[2] + v0[3])) + ((v1[0] + v1[1]) + (v1[2] + v1[3]));
                            ss += ((v0[0] * v0[0] + v0[1] * v0[1]) + (v0[2] * v0[2] + v0[3] * v0[3])) + ((v1[0] * v1[0] + v1[1] * v1[1]) + (v1[2] * v1[2] + v1[3] * v1[3])); }
                        u32x4 w; w.x = cvt_pk_bf16(v0[0], v0[1]); w.y = cvt_pk_bf16(v0[2], v0[3]); w.z = cvt_pk_bf16(v1[0], v1[1]); w.w = cvt_pk_bf16(v1[2], v1[3]);
                        EPI_STORE16(rowp + bj * HALF, w); }
                    if (stats) { s += __shfl_xor(s, 16); ss += __shfl_xor(ss, 16); s += __shfl_xor(s, 32); ss += __shfl_xor(ss, 32);
                        if (fq == 0) *(f32x2*)(sgup + ((size_t)row * 16 + (pn - 4) * 4 + wc) * 2) = (f32x2){s, ss}; } }
        }
    }
};
struct EpiRelu2 {
    static constexpr bool PERM = true, AFTER_DRAIN = false;
    bf16_t* O; int K2; RowScale rs;
    __device__ __forceinline__ void operator()(const f32x4 (&acc)[2][2][4][2], const Unit& u, int wr, int wc, int fr, int fq) const {
        const int rl0 = wr * 64 + fr;
        bf16_t* base = O + ((size_t)u.pm * (K2 >> 6) + 4 * u.pn + (wc >> 1)) * 16384 + rl0 * 64 + 32 * (wc & 1) + 8 * fq;
#pragma unroll
        for (int ai = 0; ai < 2; ++ai)
#pragma unroll
            for (int m = 0; m < 4; ++m) { const int rl = rl0 + ai * HALF + m * 16;
                const float rsc = rs.get(u.pm, rl);
#pragma unroll
                for (int bj = 0; bj < 2; ++bj) { f32x4 v0 = acc[ai][bj][m][0] * rsc, v1 = acc[ai][bj][m][1] * rsc;
                    v0 = __builtin_elementwise_max(v0, (f32x4){0.f, 0.f, 0.f, 0.f}); v1 = __builtin_elementwise_max(v1, (f32x4){0.f, 0.f, 0.f, 0.f}); v0 = v0 * v0; v1 = v1 * v1;
                    u32x4 w; w.x = cvt_pk_bf16(v0[0], v0[1]); w.y = cvt_pk_bf16(v0[2], v0[3]); w.z = cvt_pk_bf16(v1[0], v1[1]); w.w = cvt_pk_bf16(v1[2], v1[3]);
                    EPI_STORE16(base + 64 * (ai * HALF + m * 16) + 32768 * bj, w); } }
    }
};
struct EpiResB {
    static constexpr bool PERM = true, AFTER_DRAIN = false;
    bf16_t* X; int ldc; float* part;
    __device__ __forceinline__ void operator()(const f32x4 (&acc)[2][2][4][2], const Unit& u, int wr, int wc, int fr, int fq) const {
        const int row0 = u.pm * BM + wr * 64 + fr, col0 = u.pn * BM + wc * 32 + 8 * fq;
        u32x4 nb[2];
        { const bf16_t* rp = X + (size_t)row0 * ldc + col0; nb[0] = *(const u32x4*)(rp); nb[1] = *(const u32x4*)(rp + HALF); }
#pragma unroll
        for (int gi = 0; gi < 8; ++gi) { const int ai = gi >> 2, m = gi & 3;
            const int row = row0 + ai * HALF + m * 16; bf16_t* rowp = X + (size_t)row * ldc + col0;
            u32x4 b[2]; b[0] = nb[0]; b[1] = nb[1];
            if (gi < 7) { const bf16_t* rp = X + (size_t)(row0 + ((gi + 1) >> 2) * HALF + ((gi + 1) & 3) * 16) * ldc + col0; nb[0] = *(const u32x4*)(rp); nb[1] = *(const u32x4*)(rp + HALF); }
            float ss = 0.f;
#pragma unroll
            for (int bj = 0; bj < 2; ++bj) {
                f32x4 v0 = acc[ai][bj][m][0], v1 = acc[ai][bj][m][1];
                v0[0] += __uint_as_float(b[bj].x << 16); v0[1] += __uint_as_float(b[bj].x & 0xffff0000u); v0[2] += __uint_as_float(b[bj].y << 16); v0[3] += __uint_as_float(b[bj].y & 0xffff0000u);
                v1[0] += __uint_as_float(b[bj].z << 16); v1[1] += __uint_as_float(b[bj].z & 0xffff0000u); v1[2] += __uint_as_float(b[bj].w << 16); v1[3] += __uint_as_float(b[bj].w & 0xffff0000u);
                ss += ((v0[0] * v0[0] + v0[1] * v0[1]) + (v0[2] * v0[2] + v0[3] * v0[3])) + ((v1[0] * v1[0] + v1[1] * v1[1]) + (v1[2] * v1[2] + v1[3] * v1[3]));
                u32x4 w; w.x = cvt_pk_bf16(v0[0], v0[1]); w.y = cvt_pk_bf16(v0[2], v0[3]); w.z = cvt_pk_bf16(v1[0], v1[1]); w.w = cvt_pk_bf16(v1[2], v1[3]);
                *(u32x4*)(rowp + bj * HALF) = w; }
            ss += __shfl_xor(ss, 16); ss += __shfl_xor(ss, 32);
            if (fq == 0) part[(size_t)row * 64 + u.pn * 4 + wc] = ss; }
    }
};
struct EpiNone {
    static constexpr bool PERM = true, AFTER_DRAIN = false;
    float* sink;
    __device__ __forceinline__ void operator()(const f32x4 (&acc)[2][2][4][2], const Unit& u, int wr, int wc, int fr, int fq) const {
        f32x4 s = (f32x4){0.f, 0.f, 0.f, 0.f};
#pragma unroll
        for (int ai = 0; ai < 2; ++ai)
#pragma unroll
            for (int bj = 0; bj < 2; ++bj)
#pragma unroll
                for (int m = 0; m < 4; ++m)
#pragma unroll
                    for (int n = 0; n < 2; ++n) s += acc[ai][bj][m][n];
        if (u.pm < 0) sink[threadIdx.x] = (s[0] + s[1]) + (s[2] + s[3]);
    }
};
struct SameTileOrder : StaticOrder {
    __host__ __device__ bool next(int i, Unit& u) const { Unit t; const bool ok = StaticOrder::next(i, t);
#if defined(PROBE_G) && PROBE_G == 4
        u.pm = 0; u.pn = t.pn;
#elif defined(PROBE_G) && PROBE_G == 5
        u.pm = t.pm; u.pn = 0;
#else
        u.pm = 0; u.pn = 0;
#endif
        return ok; }
};
struct BlockOrder {
    int nN, nU, c;
    __host__ __device__ void init(int M, int N, int, int c_) { nN = N / BM; nU = (M / BM) * nN; c = c_; }
    __host__ __device__ int rp0() const { return 4 * ((c & 7) >> 1) + ((c >> 3) & 3); }
    __host__ __device__ bool next(int i, Unit& u) const {
        const int xcd = c & 7, j = c >> 3, L = 256 * i + (8 * (xcd & 1) + (j >> 2)) * 16 + 4 * (xcd >> 1) + (j & 3);
        if (L >= nU) return false;
        const int rb = L / (16 * nN), rem = L - rb * 16 * nN;
        u.pm = 16 * rb + (rem & 15); u.pn = rem >> 4; return true;
    }
    __device__ __forceinline__ void a_ready(const Unit&) const {}
    __device__ __forceinline__ void done(const Unit&) const {}
};
template <int MODE> struct EpiProbe {
    static constexpr bool PERM = true, AFTER_DRAIN = false;
    bf16_t* O; int ldc; RowScale rs;
    __device__ __forceinline__ void operator()(const f32x4 (&acc)[2][2][4][2], const Unit& u, int wr, int wc, int fr, int fq) const {
        const int row0 = u.pm * BM + wr * 64 + fr, col0 = u.pn * BM + wc * 32 + 8 * fq;
        bf16_t* cbase = O + ((size_t)(u.pm * 32 + u.pn) * 8 + (wr * 4 + wc)) * 8192 + (fq * 16 + fr) * 8;
        f32x4 keep = (f32x4){0.f, 0.f, 0.f, 0.f};
#pragma unroll
        for (int ai = 0; ai < 2; ++ai)
#pragma unroll
            for (int m = 0; m < 4; ++m) { bf16_t* rowp = O + (size_t)(row0 + ai * HALF + m * 16) * ldc + col0;
                const float rsc = rs.get(u.pm, wr * 64 + fr + ai * HALF + m * 16);
#pragma unroll
                for (int bj = 0; bj < 2; ++bj) { f32x4 v0 = acc[ai][bj][m][0] * rsc, v1 = acc[ai][bj][m][1] * rsc;
                    v0 = __builtin_elementwise_max(v0, (f32x4){0.f, 0.f, 0.f, 0.f}); v1 = __builtin_elementwise_max(v1, (f32x4){0.f, 0.f, 0.f, 0.f}); v0 = v0 * v0; v1 = v1 * v1;
                    u32x4 w; w.x = cvt_pk_bf16(v0[0], v0[1]); w.y = cvt_pk_bf16(v0[2], v0[3]); w.z = cvt_pk_bf16(v1[0], v1[1]); w.w = cvt_pk_bf16(v1[2], v1[3]);
                    if (MODE == 0) *(u32x4*)(rowp + bj * HALF) = w;
                    else if (MODE == 1) *(u32x4*)(cbase + ((ai * 4 + m) * 2 + bj) * 512) = w;
                    else keep += v0 + v1; } }
        if (MODE == 2 && u.pm < 0) *(f32x4*)(O + threadIdx.x * 8) = keep;
    }
};
template <int W> struct StaticOrderW {
    int nM, nN, nwg, G, c;
    __host__ __device__ void init(int M, int N, int G_, int c_) { nM = M / BM; nN = N / BM; nwg = nM * nN; G = G_; c = c_; }
    __host__ __device__ bool next(int i, Unit& u) const {
        const long L = (long)i * G + c; if (L >= nwg) return false;
        int wgid = (int)L; { const int q = nwg / NXCD, xcd = wgid % NXCD, off = wgid / NXCD; wgid = xcd * q + off; }
        const int nig = W * nN, gid = wgid / nig, fm = gid * W;
        u.pm = fm + ((wgid % nig) % W); u.pn = (wgid % nig) / W; return true;
    }
    __device__ __forceinline__ void a_ready(const Unit&) const {}
    __device__ __forceinline__ void done(const Unit&) const {}
};
template <class Epi, class Sched, bool ALIGN_EPI = false, bool SP2 = false, bool ABLK = false, bool BBLK = false, int AUXA = 0, int AUXB = 0>
__device__ __forceinline__ void gemm_phase(PG8_LAS unsigned char* lds, const Gemm g, const Sched& S, const Epi& E) {
    int tid = hw_tid(lds); asm volatile("" : "+v"(tid));
    const int wid = __builtin_amdgcn_readfirstlane(tid >> 6), lane = tid & 63, wr = wid >> 2, wc = wid & 3, fr = lane & 15, fq = lane >> 4;
    const int K = g.K, nt = K / BK;
    unsigned voffA[2], voffB[2];
#pragma unroll
    for (int i = 0; i < 2; ++i) { int R, C; stage_rc(tid * 16 + i * 8192, R, C); const int Rb = Epi::PERM ? ((R & ~31) + perm32(R & 31)) : R;
        voffA[i] = (unsigned)(R * (ABLK ? 64 : g.lda) + C) * 2u; voffB[i] = (unsigned)(Rb * (BBLK ? 64 : g.ldb) + C) * 2u; }
    const size_t kstepA = ABLK ? 32768 : 128, kstepB = BBLK ? 32768 : 128;
    const size_t hstepA = (size_t)HALF * (ABLK ? 64 : g.lda) * 2, hstepB = (size_t)HALF * (BBLK ? 64 : g.ldb) * 2;
    const size_t tstepA = ABLK ? (size_t)(K / 64) * 32768 : (size_t)256 * g.lda * 2, tstepB = BBLK ? (size_t)(K / 64) * 32768 : (size_t)256 * g.ldb * 2;
    const unsigned ldsw = (unsigned)wid * 1024u;
    const int aoff = lds_byte(wr * 64 + fr, fq * 8), boff = lds_byte(wc * 32 + fr, fq * 8);
#define PG8_SA(b, h) (((b) * 2 + (h)) * HTB)
#define PG8_SB(b, h) ((4 + (b) * 2 + (h)) * HTB)
#define PG8_STAGE_X(bufoff, gbase, voff, AUX) do { _Pragma("unroll") for (int _i = 0; _i < 2; ++_i) \
        __builtin_amdgcn_global_load_lds((const unsigned*)((const char*)(gbase) + (voff)[_i]), (PG8_LAS unsigned*)(lds + (bufoff) + ldsw + _i * 8192), 16, 0, AUX); } while (0)
#define PG8_STAGEA(bufoff, gbase, voff) PG8_STAGE_X(bufoff, gbase, voff, AUXA)
#define PG8_STAGEB(bufoff, gbase, voff) PG8_STAGE_X(bufoff, gbase, voff, AUXB)
#define PG8_LDA(dst, b, h) do { _Pragma("unroll") for (int m = 0; m < 4; ++m) _Pragma("unroll") for (int k = 0; k < 2; ++k) dst[m][k] = *(const PG8_LAS bf16x8*)(lds + PG8_SA(b, h) + aoff + m * 2048 + k * 1024); } while (0)
#define PG8_LDB(dst, b, h) do { _Pragma("unroll") for (int n = 0; n < 2; ++n) _Pragma("unroll") for (int k = 0; k < 2; ++k) dst[n][k] = *(const PG8_LAS bf16x8*)(lds + PG8_SB(b, h) + boff + n * 2048 + k * 1024); } while (0)
#ifndef GEMM_RELAX
#define GEMM_RELAX 0
#endif
#ifndef GEMM_PRIO_MODE
#define GEMM_PRIO_MODE 0
#endif
#define PG8_MMA(ai, bj, At, Bt) do { if (GEMM_PRIO_MODE == 0) __builtin_amdgcn_s_setprio(1); _Pragma("unroll") for (int m = 0; m < 4; ++m) _Pragma("unroll") for (int n = 0; n < 2; ++n) _Pragma("unroll") for (int k = 0; k < 2; ++k) \
        acc[ai][bj][m][n] = __builtin_amdgcn_mfma_f32_16x16x32_bf16(Bt[n][k], At[m][k], acc[ai][bj][m][n], 0, 0, 0); if (GEMM_PRIO_MODE == 0) __builtin_amdgcn_s_setprio(0); } while (0)
#define PG8_WAIT_V(n) asm volatile("s_waitcnt vmcnt(" #n ")" ::: "memory")
#define PG8_WAIT_VR(n, nr, flag) asm volatile("s_cmp_eq_u32 %0, 0\n\ts_cbranch_scc1 .Lpg8s%=\n\ts_waitcnt vmcnt(" #nr ")\n\ts_branch .Lpg8d%=\n.Lpg8s%=:\n\ts_waitcnt vmcnt(" #n ")\n.Lpg8d%=:" :: "s"(flag) : "memory", "scc")
#define PG8_WAIT_L(n) asm volatile("s_waitcnt lgkmcnt(" #n ")" ::: "memory")
#define PG8_BAR __builtin_amdgcn_s_barrier()
#define PG8_SCHED __builtin_amdgcn_sched_barrier(0)
    Unit cur, nxt; int ui = 0;
    if (!S.next(0, cur)) return;
    if (GEMM_PRIO_MODE == 2 && wr == 1) __builtin_amdgcn_s_setprio(1);
    f32x4 acc[2][2][4][2];
#pragma unroll
    for (int a = 0; a < 2; ++a)
#pragma unroll
        for (int b = 0; b < 2; ++b)
#pragma unroll
            for (int m = 0; m < 4; ++m)
#pragma unroll
                for (int n = 0; n < 2; ++n) acc[a][b][m][n] = (f32x4){0.f, 0.f, 0.f, 0.f};
    bf16x8 At[4][2], B0[2][2], B1[2][2];
    const char* cA = (const char*)g.A + (size_t)cur.pm * tstepA; const char* cB = (const char*)g.Bt + (size_t)cur.pn * tstepB;
    S.a_ready(cur);
    if constexpr (SP2) {
        PG8_STAGEB(PG8_SB(0, 0), cB, voffB); PG8_STAGEB(PG8_SB(0, 1), cB + hstepB, voffB); PG8_STAGEA(PG8_SA(0, 0), cA, voffA); PG8_STAGEA(PG8_SA(0, 1), cA + hstepA, voffA);
        if (wr == 1) PG8_BAR;
        PG8_WAIT_V(2); PG8_BAR;
        PG8_STAGEB(PG8_SB(1, 0), cB + kstepB, voffB); PG8_STAGEA(PG8_SA(1, 0), cA + kstepA, voffA); PG8_STAGEB(PG8_SB(1, 1), cB + hstepB + kstepB, voffB);
        PG8_WAIT_V(6); PG8_BAR;
    } else {
        PG8_STAGEB(PG8_SB(0, 0), cB, voffB); PG8_STAGEA(PG8_SA(0, 0), cA, voffA); PG8_STAGEB(PG8_SB(0, 1), cB + hstepB, voffB); PG8_STAGEA(PG8_SA(0, 1), cA + hstepA, voffA);
        if (wr == 1) PG8_BAR;
        PG8_WAIT_V(4); PG8_BAR;
        PG8_STAGEB(PG8_SB(1, 0), cB + kstepB, voffB); PG8_STAGEA(PG8_SA(1, 0), cA + kstepA, voffA); PG8_STAGEB(PG8_SB(1, 1), cB + hstepB + kstepB, voffB);
        PG8_WAIT_V(6); PG8_BAR;
    }
    for (;;) {
        const bool has_next = S.next(ui + 1, nxt);
        const char* nA = has_next ? (const char*)g.A + (size_t)nxt.pm * tstepA : cA; const char* nB = has_next ? (const char*)g.Bt + (size_t)nxt.pn * tstepB : cB;
        int t0 = 0;
        if constexpr (SP2 && GEMM_RELAX == 1) { if (ui > 0) {
            const char* a1 = cA + kstepA; const char* a2 = cA + 2 * kstepA; const char* b2 = cB + 2 * kstepB; const char* a3 = a2 + kstepA; const char* b3 = b2 + kstepB;
            PG8_LDB(B0, 0, 0); PG8_LDB(B1, 0, 1); PG8_SCHED; PG8_LDA(At, 0, 0); PG8_STAGEA(PG8_SA(1, 1), a1 + hstepA, voffA);
            PG8_WAIT_V(24); PG8_WAIT_L(0); PG8_BAR; PG8_MMA(0, 0, At, B0); PG8_MMA(0, 1, At, B1); PG8_BAR; PG8_SCHED;
            PG8_LDA(At, 0, 1); PG8_STAGEB(PG8_SB(0, 0), b2, voffB); PG8_STAGEB(PG8_SB(0, 1), b2 + hstepB, voffB); PG8_STAGEA(PG8_SA(0, 0), a2, voffA);
            PG8_WAIT_V(24); PG8_WAIT_L(0); PG8_BAR; PG8_MMA(1, 0, At, B0); PG8_MMA(1, 1, At, B1); PG8_BAR; PG8_SCHED;
            PG8_LDB(B0, 1, 0); PG8_LDB(B1, 1, 1); PG8_SCHED; PG8_LDA(At, 1, 0); PG8_STAGEA(PG8_SA(0, 1), a2 + hstepA, voffA);
            PG8_WAIT_V(8); PG8_WAIT_L(0); PG8_BAR; PG8_MMA(0, 0, At, B0); PG8_MMA(0, 1, At, B1); PG8_BAR; PG8_SCHED;
            PG8_LDA(At, 1, 1); PG8_STAGEB(PG8_SB(1, 0), b3, voffB); PG8_STAGEB(PG8_SB(1, 1), b3 + hstepB, voffB); PG8_STAGEA(PG8_SA(1, 0), a3, voffA);
            PG8_WAIT_V(8); PG8_WAIT_L(0); PG8_BAR; PG8_MMA(1, 0, At, B0); PG8_MMA(1, 1, At, B1); PG8_BAR; PG8_SCHED;
            t0 = 2; } }
        for (int t = t0; t < nt; t += 2) {
            const bool last = (t == nt - 2);
            const char* a1 = cA + (size_t)(t + 1) * kstepA;
            const char* a2 = last ? nA : cA + (size_t)(t + 2) * kstepA; const char* b2 = last ? nB : cB + (size_t)(t + 2) * kstepB;
            const char* a3 = a2 + kstepA; const char* b3 = b2 + kstepB;
            if (last && has_next) S.a_ready(nxt);
            if constexpr (SP2) {
            PG8_LDB(B0, 0, 0); PG8_LDB(B1, 0, 1); PG8_SCHED; PG8_LDA(At, 0, 0); PG8_STAGEA(PG8_SA(1, 1), a1 + hstepA, voffA);
#if GEMM_RELAX == 2
            const int relax = __builtin_amdgcn_readfirstlane((t == 0 && ui > 0) ? 1 : 0);
            PG8_WAIT_VR(8, 24, relax); PG8_WAIT_L(0); PG8_BAR; PG8_MMA(0, 0, At, B0); PG8_MMA(0, 1, At, B1); PG8_BAR; PG8_SCHED;
#else
            PG8_WAIT_V(8); PG8_WAIT_L(0); PG8_BAR; PG8_MMA(0, 0, At, B0); PG8_MMA(0, 1, At, B1); PG8_BAR; PG8_SCHED;
#endif
            PG8_LDA(At, 0, 1); PG8_STAGEB(PG8_SB(0, 0), b2, voffB); PG8_STAGEB(PG8_SB(0, 1), b2 + hstepB, voffB); PG8_STAGEA(PG8_SA(0, 0), a2, voffA);
#if GEMM_RELAX == 2
            PG8_WAIT_VR(8, 24, relax); PG8_WAIT_L(0); PG8_BAR; PG8_MMA(1, 0, At, B0); PG8_MMA(1, 1, At, B1); PG8_BAR; PG8_SCHED;
#else
            PG8_WAIT_V(8); PG8_WAIT_L(0); PG8_BAR; PG8_MMA(1, 0, At, B0); PG8_MMA(1, 1, At, B1); PG8_BAR; PG8_SCHED;
#endif
            PG8_LDB(B0, 1, 0); PG8_LDB(B1, 1, 1); PG8_SCHED; PG8_LDA(At, 1, 0); PG8_STAGEA(PG8_SA(0, 1), a2 + hstepA, voffA);
            PG8_WAIT_V(8); PG8_WAIT_L(0); PG8_BAR; PG8_MMA(0, 0, At, B0); PG8_MMA(0, 1, At, B1); PG8_BAR; PG8_SCHED;
            PG8_LDA(At, 1, 1); PG8_STAGEB(PG8_SB(1, 0), b3, voffB); PG8_STAGEB(PG8_SB(1, 1), b3 + hstepB, voffB); PG8_STAGEA(PG8_SA(1, 0), a3, voffA);
            PG8_WAIT_V(8); PG8_WAIT_L(0); PG8_BAR; PG8_MMA(1, 0, At, B0); PG8_MMA(1, 1, At, B1); PG8_BAR; PG8_SCHED;
            } else {
            PG8_LDB(B0, 0, 0); PG8_SCHED; PG8_LDA(At, 0, 0); PG8_STAGEA(PG8_SA(1, 1), a1 + hstepA, voffA);
            PG8_WAIT_L(8); PG8_BAR; PG8_WAIT_L(0); PG8_MMA(0, 0, At, B0); PG8_BAR; PG8_SCHED;
            PG8_LDB(B1, 0, 1); PG8_STAGEB(PG8_SB(0, 0), b2, voffB);
            PG8_BAR; PG8_WAIT_L(0); PG8_MMA(0, 1, At, B1); PG8_BAR;
            PG8_LDA(At, 0, 1); PG8_STAGEA(PG8_SA(0, 0), a2, voffA);
            PG8_BAR; PG8_WAIT_L(0); PG8_MMA(1, 0, At, B0); PG8_BAR; PG8_SCHED;
            PG8_STAGEB(PG8_SB(0, 1), b2 + hstepB, voffB);
            PG8_WAIT_V(6); PG8_BAR; PG8_MMA(1, 1, At, B1); PG8_BAR;
            PG8_LDB(B0, 1, 0); PG8_SCHED; PG8_LDA(At, 1, 0); PG8_STAGEA(PG8_SA(0, 1), a2 + hstepA, voffA);
            PG8_WAIT_L(8); PG8_BAR; PG8_WAIT_L(0); PG8_MMA(0, 0, At, B0); PG8_BAR; PG8_SCHED;
            PG8_LDB(B1, 1, 1); PG8_STAGEB(PG8_SB(1, 0), b3, voffB);
            PG8_BAR; PG8_WAIT_L(0); PG8_MMA(0, 1, At, B1); PG8_BAR;
            PG8_LDA(At, 1, 1); PG8_STAGEA(PG8_SA(1, 0), a3, voffA);
            PG8_BAR; PG8_WAIT_L(0); PG8_MMA(1, 0, At, B0); PG8_BAR; PG8_SCHED;
            PG8_STAGEB(PG8_SB(1, 1), b3 + hstepB, voffB);
            PG8_WAIT_V(6); PG8_BAR; PG8_MMA(1, 1, At, B1); PG8_BAR;
            }
        }
        if constexpr (ALIGN_EPI) { if (wr == 0) PG8_BAR; }
        if constexpr (!Epi::AFTER_DRAIN) { E(acc, cur, wr, wc, fr, fq); S.done(cur); }
        if (!has_next) break;
#pragma unroll
        for (int a = 0; a < 2; ++a)
#pragma unroll
            for (int b = 0; b < 2; ++b)
#pragma unroll
                for (int m = 0; m < 4; ++m)
#pragma unroll
                    for (int n = 0; n < 2; ++n) acc[a][b][m][n] = (f32x4){0.f, 0.f, 0.f, 0.f};
        cur = nxt; cA = nA; cB = nB; ++ui;
        if constexpr (ALIGN_EPI) { if (wr == 1) PG8_BAR; }
    }
    PG8_WAIT_V(0);
    if constexpr (!ALIGN_EPI) { if (wr == 0) PG8_BAR; }
    PG8_BAR;
    if (GEMM_PRIO_MODE == 2) __builtin_amdgcn_s_setprio(0);
    if constexpr (Epi::AFTER_DRAIN) { E.fused(acc, cur, wr, wc, fr, fq, lds, wid, lane); S.done(cur); }
#undef PG8_SA
#undef PG8_SB
#undef PG8_STAGE_X
#undef PG8_STAGEA
#undef PG8_STAGEB
#undef PG8_LDA
#undef PG8_LDB
#undef PG8_MMA
#undef PG8_WAIT_V
#undef PG8_WAIT_VR
#undef PG8_WAIT_L
#undef PG8_BAR
#undef PG8_SCHED
}
}
constexpr int BATCH = 4, SEQ = 4096, DM = 4096, DEPTH = 2, HDIM = 128, CHUNK = 128, NCH = SEQ / CHUNK;
constexpr int M = BATCH * SEQ;
constexpr int DFF = 4 * DM;
#ifndef PITCH_PAD
#define PITCH_PAD 64
#endif
constexpr int LDH = DFF + PITCH_PAD;
constexpr int INW = 9216;
constexpr int C_U = 0, C_V = 1024, C_RQ = 2048, C_RK = 3072, C_RV = 4096, C_RG = 5120, C_AQ = 6144, C_AK = 8192, C_AV = 8704;
constexpr int MIX_A = 0, MIX_R = 1024, MIX_C = 2048;
constexpr int NRH = 8, NQH = 16, NSG = 8;
constexpr float NORM_EPS = 1e-5f;
constexpr float QK_SCALE = 0.08838834764831845f;
constexpr float LOG2E = 1.4426950408889634f;

constexpr size_t MiB = 1u << 20;
constexpr size_t WS_CTL = 0, CTL_ZERO_BYTES = 1 * MiB;
constexpr size_t WS_COS = 1 * MiB, WS_SIN = 2 * MiB;
constexpr size_t WS_WIN = 4 * MiB;
constexpr size_t WS_WOUT = WS_WIN + 144 * MiB;
constexpr size_t WS_WUP = WS_WOUT + 64 * MiB;
constexpr size_t WS_WDN = WS_WUP + 256 * MiB;
constexpr size_t WS_H = WS_WDN + 260 * MiB;
constexpr size_t WS_PROJ = WS_H + 128 * MiB;
constexpr size_t WS_MIX = WS_PROJ + 288 * MiB;
constexpr size_t WS_HID = WS_MIX + 128 * MiB;
constexpr size_t WS_ST = WS_HID;
constexpr size_t WS_RSA = WS_HID + 520 * MiB;
constexpr size_t WS_RSB = WS_RSA + 4 * MiB;
constexpr size_t WS_SGUP = WS_RSB + 4 * MiB;
constexpr size_t WS_END = WS_SGUP + 2 * MiB;
static_assert(WS_END == 1802 * MiB && (size_t)M * LDH * 2 <= 520 * MiB && (size_t)DEPTH * DM * LDH * 2 <= 260 * MiB, "ws map");
constexpr int CW_BAR = 4096;
constexpr int CW_Q = 16384;

constexpr int RSTD_OFF = 131072;
constexpr int RING_BYTES = 139264;
constexpr int LDSCTL_OFF = RING_BYTES, MISC_OFF = LDSCTL_OFF + 320;
constexpr int LDS_BYTES = 147456;
constexpr int NWAVES = 8;

#define GAS __attribute__((address_space(1)))
#define LAS __attribute__((address_space(3)))
typedef unsigned short bf16;
typedef unsigned v4u __attribute__((ext_vector_type(4)));
typedef unsigned v2u __attribute__((ext_vector_type(2)));
typedef float f32x4 __attribute__((ext_vector_type(4)));
typedef short bf16x8 __attribute__((ext_vector_type(8)));
typedef short s16x4 __attribute__((ext_vector_type(4)));
typedef LAS unsigned char* ldsp;
#define LDS_WAIT() asm volatile("s_waitcnt lgkmcnt(0)" ::: "memory")
#define VM_WAIT() asm volatile("s_waitcnt vmcnt(0)" ::: "memory")
using pg8::cvt_pk_bf16; using pg8::hw_tid; using pg8::hw_slot; using pg8::HWTAB_OFF;
__device__ __forceinline__ float bf_lo(unsigned w) { return __uint_as_float(w << 16); }
__device__ __forceinline__ float bf_hi(unsigned w) { return __uint_as_float(w & 0xffff0000u); }

#define XB_TMO      128
#define XB_XCNT(j)  (256  + 64 * (j))
#define XB_XSUB(j)  (1280 + 64 * (j))
#define XB_XGEN(j)  (2304 + 64 * (j))
#define XB_TOP      3328
#define XB_TOPGEN   3392
#define XCD_BAR_WORDS 3456
#define XB_SPIN_CAP (1u << 18)

__device__ __forceinline__ unsigned xb_ld(unsigned* p)              { return __hip_atomic_load(p, __ATOMIC_RELAXED, __HIP_MEMORY_SCOPE_AGENT); }
__device__ __forceinline__ unsigned xb_add(unsigned* p, unsigned v) { return __hip_atomic_fetch_add(p, v, __ATOMIC_RELAXED, __HIP_MEMORY_SCOPE_AGENT); }
__device__ __forceinline__ unsigned xb_xcc_id() { return (unsigned)__builtin_amdgcn_s_getreg((3 << 11) | 20) & 0xFu; }
#define XB_SPIN(cond, bar) do { unsigned _sp = 0; while (cond) { __builtin_amdgcn_s_sleep(1); \
    if ((++_sp & 255u) == 0u) { if (xb_ld(&(bar)[XB_TMO])) break; if (_sp > XB_SPIN_CAP) { atomicAdd(&(bar)[XB_TMO], 1u); break; } } } } while (0)

#define XB_TID0(st_) (hw_tid((__attribute__((address_space(3))) unsigned char*)(st_) - (139264 + 320 + 32)) == 0)
struct XcdBarrier {
    unsigned* bar; unsigned x;
    volatile LAS unsigned* st;
};

__device__ __forceinline__ XcdBarrier xcd_barrier_post(unsigned* bar, volatile LAS unsigned* st) {
    XcdBarrier b; b.bar = bar; b.x = xb_xcc_id(); b.st = st;
    if (XB_TID0(st)) (void)xb_add(&bar[XB_XCNT(b.x)], 1u);
    return b;
}
__device__ __forceinline__ void xcd_barrier_complete(unsigned* bar, unsigned x, unsigned& nloc, unsigned& nx) {
    const unsigned G = gridDim.x * gridDim.y * gridDim.z;
    unsigned sum, cnt, mine, sp = 0u;
    for (;;) {
        sum = 0u; cnt = 0u; mine = 0u;
#pragma unroll
        for (unsigned j = 0; j < 16; ++j) { const unsigned c = xb_ld(&bar[XB_XCNT(j)]); sum += c; cnt += (c > 0u) ? 1u : 0u; mine = (j == x) ? c : mine; }
        if (sum == G) break;
        __builtin_amdgcn_s_sleep(1);
        if ((++sp & 255u) == 0u) { if (xb_ld(&bar[XB_TMO])) break; if (sp > XB_SPIN_CAP) { atomicAdd(&bar[XB_TMO], 1u); break; } }
    }
    nloc = mine > 0u ? mine : 1u; nx = cnt > 0u ? cnt : 1u;
}

__device__ __forceinline__ void xcd_barrier(const XcdBarrier& b) {
    asm volatile("s_waitcnt vmcnt(0)" ::: "memory");
    __syncthreads();
    if (XB_TID0(b.st)) {
        unsigned* bar = b.bar;
        __builtin_amdgcn_s_waitcnt(0);
        unsigned nloc = b.st[0], nx = b.st[1];
        if (nloc == 0u) { xcd_barrier_complete(bar, b.x, nloc, nx); b.st[0] = nloc; b.st[1] = nx; }
        const unsigned old = xb_add(&bar[XB_XSUB(b.x)], 1u);
        const unsigned gen = old / nloc;
        if (old + 1u == (gen + 1u) * nloc) {
            __builtin_amdgcn_fence(__ATOMIC_RELEASE, "agent");
            asm volatile("s_waitcnt vmcnt(0)" ::: "memory");
            const unsigned og = xb_add(&bar[XB_TOP], 1u);
            const unsigned tg = og / nx;
            if (og + 1u == (tg + 1u) * nx) xb_add(&bar[XB_TOPGEN], 1u);
            else XB_SPIN(xb_ld(&bar[XB_TOPGEN]) == tg, bar);
            __builtin_amdgcn_fence(__ATOMIC_ACQUIRE, "agent");
            xb_add(&bar[XB_XGEN(b.x)], 1u);
            asm volatile("s_waitcnt vmcnt(0)" ::: "memory");
        } else {
            XB_SPIN(xb_ld(&bar[XB_XGEN(b.x)]) == gen, bar);
            __builtin_amdgcn_fence(__ATOMIC_ACQUIRE, "agent");
            asm volatile("s_waitcnt vmcnt(0)" ::: "memory");
        }
    }
    __syncthreads();
}
constexpr unsigned TP = 272u, TILE_BYTES = 128u * TP;
__device__ __forceinline__ unsigned offb(unsigned row, unsigned ch) { return TP * row + 16u * ch; }
__device__ __forceinline__ bf16x8 frag_row(ldsp rb, int idx, int ks) { return *(const LAS bf16x8*)(rb + 16u * TP * idx + 64u * ks); }
__device__ __forceinline__ bf16x8 frag_tr(ldsp tb, int idx, int ks) {
    const s16x4 lo = __builtin_bit_cast(s16x4, __builtin_amdgcn_ds_read_tr16_b64_v4i16((LAS s16x4*)(tb + 32u * TP * ks + 32u * idx)));
    const s16x4 hi = __builtin_bit_cast(s16x4, __builtin_amdgcn_ds_read_tr16_b64_v4i16((LAS s16x4*)(tb + 32u * TP * ks + 4u * TP + 32u * idx)));
    return (bf16x8){lo[0], lo[1], lo[2], lo[3], hi[0], hi[1], hi[2], hi[3]};
}
__device__ __forceinline__ ldsp row_base(ldsp T, int lane) { return T + TP * (unsigned)(lane & 15) + 16u * (unsigned)(lane >> 4); }
__device__ __forceinline__ ldsp tr_base(ldsp T, int lane) { return T + TP * (8u * (unsigned)(lane >> 4) + (((unsigned)lane & 15u) >> 2)) + 8u * ((unsigned)lane & 3u); }
#ifndef ATTN_VFIX
#define ATTN_VFIX 1
#endif
constexpr unsigned TPV = 288u;
__device__ __forceinline__ unsigned offb_v(unsigned row, unsigned ch) { return TPV * row + 128u * ((row >> 3) & 1u) + 128u * (row >> 4) + 16u * ch; }
__device__ __forceinline__ ldsp tr_base_v(ldsp T, int lane) { const unsigned fq = (unsigned)lane >> 4; return T + TPV * (8u * fq + (((unsigned)lane & 15u) >> 2)) + 128u * (fq & 1u) + 128u * (fq >> 1) + 8u * ((unsigned)lane & 3u); }
__device__ __forceinline__ bf16x8 frag_tr_v(ldsp tb, int idx, int ks) {
    const s16x4 lo = __builtin_bit_cast(s16x4, __builtin_amdgcn_ds_read_tr16_b64_v4i16((LAS s16x4*)(tb + (32u * TPV + 256u) * ks + 32u * idx)));
    const s16x4 hi = __builtin_bit_cast(s16x4, __builtin_amdgcn_ds_read_tr16_b64_v4i16((LAS s16x4*)(tb + (32u * TPV + 256u) * ks + 4u * TPV + 32u * idx)));
    return (bf16x8){lo[0], lo[1], lo[2], lo[3], hi[0], hi[1], hi[2], hi[3]};
}
#ifndef MM_SETPRIO
#define MM_SETPRIO 1
#endif
#ifndef ATTN_SPRIO_OLD
#define ATTN_SPRIO_OLD 0
#endif
#ifndef ATTN_SPRIO
#define ATTN_SPRIO 0
#endif
#ifndef ATTN_FULL
#define ATTN_FULL 0
#endif
#ifndef ATTN_RG
#define ATTN_RG 0
#endif
#define ATTN_RG_SKIP (ATTN_RG == 1 || ATTN_RG == 2)
#ifndef SGU_EARLY
#define SGU_EARLY 0
#endif
#ifndef PAIR_QPRE
#define PAIR_QPRE 0
#endif
#ifndef CVT_DEEP
#define CVT_DEEP 0
#endif
#ifndef ATTN_BIAS
#define ATTN_BIAS 1
#endif
#ifndef ATTN_PIPE
#define ATTN_PIPE 1
#endif
#ifndef ATTN_G
#define ATTN_G 8
#endif
#ifndef MM_G
#define MM_G 8
#endif
#ifndef MM_PIPE
#define MM_PIPE 1
#endif
template <int G, int KS0, int NK, int C0, int NC, class FB, class FA>
__device__ __forceinline__ void mm_pipe(f32x4 (&acc)[8], FB fb, FA fa) {
    constexpr int NS = NK * NC, NG = NS / G;
    static_assert(NS % G == 0, "group size must divide the step count");
    bf16x8 b[2][G];
#pragma unroll
    for (int i = 0; i < G; ++i) b[0][i] = fb(C0 + i % NC, KS0 + i / NC);
    if (NG > 1) {
#pragma unroll
        for (int i = 0; i < G; ++i) b[1][i] = fb(C0 + (G + i) % NC, KS0 + (G + i) / NC); }
#pragma unroll
    for (int g = 0; g < NG; ++g) {
        __builtin_amdgcn_sched_barrier(0);
#pragma unroll
        for (int i = 0; i < G; ++i) { const int st = g * G + i, c = C0 + st % NC, ks = KS0 + st / NC;
            acc[c] = __builtin_amdgcn_mfma_f32_16x16x32_bf16(b[g & 1][i], fa(ks), acc[c], 0, 0, 0); }
        __builtin_amdgcn_sched_barrier(0);
        if (g + 2 < NG) {
#pragma unroll
            for (int i = 0; i < G; ++i) { const int st = (g + 2) * G + i; b[g & 1][i] = fb(C0 + st % NC, KS0 + st / NC); } }
    }
}
template <bool A_TR, bool B_TR>
__device__ __forceinline__ void mm128(f32x4 (&acc)[8], ldsp TA, ldsp TB, int w, int lane) {
    const ldsp ab = A_TR ? tr_base(TA, lane) + 32u * w : row_base(TA, lane) + 16u * TP * w;
    const ldsp bb = B_TR ? tr_base(TB, lane) : row_base(TB, lane);
    if (MM_SETPRIO) __builtin_amdgcn_s_setprio(1);
#if MM_PIPE
    bf16x8 a[4];
#pragma unroll
    for (int ks = 0; ks < 4; ++ks) a[ks] = A_TR ? frag_tr(ab, 0, ks) : frag_row(ab, 0, ks);
    mm_pipe<MM_G, 0, 4, 0, 8>(acc, [&](int c, int ks) { return B_TR ? frag_tr(bb, c, ks) : frag_row(bb, c, ks); }, [&](int ks) { return a[ks]; });
#else
#pragma unroll
    for (int ks = 0; ks < 4; ++ks) {
        const bf16x8 a = A_TR ? frag_tr(ab, 0, ks) : frag_row(ab, 0, ks);
#pragma unroll
        for (int c = 0; c < 8; ++c) {
            const bf16x8 b = B_TR ? frag_tr(bb, c, ks) : frag_row(bb, c, ks);
            acc[c] = __builtin_amdgcn_mfma_f32_16x16x32_bf16(b, a, acc[c], 0, 0, 0);
        }
    }
#endif
    if (MM_SETPRIO) __builtin_amdgcn_s_setprio(0);
}
__device__ __forceinline__ void zero8(f32x4 (&a)[8]) {
#pragma unroll
    for (int c = 0; c < 8; ++c) a[c] = (f32x4){0.f, 0.f, 0.f, 0.f};
}
struct TileRegs { v4u v[4]; };
__device__ __forceinline__ void tile_fetch(TileRegs& t, const bf16* src, size_t ld, int tid) {
#pragma unroll
    for (int i = 0; i < 4; ++i) { const int ck = tid + 512 * i, r = ck >> 4, ch = ck & 15; t.v[i] = *(const v4u*)(src + (size_t)r * ld + 8 * ch); }
}
__device__ __forceinline__ void tile_put(ldsp T, const TileRegs& t, int tid) {
#pragma unroll
    for (int i = 0; i < 4; ++i) { const int ck = tid + 512 * i, r = ck >> 4, ch = ck & 15; *(LAS v4u*)(T + offb(r, ch)) = t.v[i]; }
}
__device__ __forceinline__ void tile_put_v(ldsp T, const TileRegs& t, int tid) {
#pragma unroll
    for (int i = 0; i < 4; ++i) { const int ck = tid + 512 * i, r = ck >> 4, ch = ck & 15; *(LAS v4u*)(T + offb_v(r, ch)) = t.v[i]; }
}
__device__ __forceinline__ void tile_put_scaled(ldsp T, const TileRegs& t, float l2, float a0, float a1, int tid) {
#pragma unroll
    for (int i = 0; i < 4; ++i) { const int ck = tid + 512 * i, r = ck >> 4, ch = ck & 15;
        const float sc = __builtin_amdgcn_exp2f(l2 * (a0 + a1 * (float)r));
        v4u o;
#pragma unroll
        for (int k = 0; k < 4; ++k) o[k] = cvt_pk_bf16(bf_lo(t.v[i][k]) * sc, bf_hi(t.v[i][k]) * sc);
        *(LAS v4u*)(T + offb(r, ch)) = o; }
}
__device__ __forceinline__ void tile_put_frag(ldsp T, const TileRegs& t, int tid) {
#pragma unroll
    for (int i = 0; i < 4; ++i) { const int q = tid + 512 * i; *(LAS v4u*)(T + offb(16 * (q >> 8) + (q & 15), (q >> 4) & 15)) = t.v[i]; }
}
__device__ __forceinline__ void load_tile(ldsp T, const bf16* src, size_t ld, int tid) { TileRegs t; tile_fetch(t, src, ld, tid); tile_put(T, t, tid); }
__device__ __forceinline__ void store_acc_tile(ldsp T, const f32x4 (&a)[8], int w, int lane) {
    const unsigned fr = lane & 15, fq = lane >> 4, row = 16u * w + fr;
#pragma unroll
    for (int c = 0; c < 8; ++c) { v2u v; v[0] = cvt_pk_bf16(a[c][0], a[c][1]); v[1] = cvt_pk_bf16(a[c][2], a[c][3]);
        *(LAS v2u*)(T + offb(row, 2u * c + (fq >> 1)) + 8u * (fq & 1)) = v; }
}
__device__ __forceinline__ float wave_sum(float v) {
#pragma unroll
    for (int o = 1; o < 64; o <<= 1) v += __shfl_xor(v, o);
    return v;
}

__host__ __device__ __forceinline__ bool win_rope_tile(int t) { return (t >= 8 && t < 16) || (t >= 24 && t < 34); }
__host__ __device__ __forceinline__ int win_phys_col(int n) { if (!win_rope_tile(n >> 8)) return n; const int cl = n & 255; return (n & ~255) | (cl & 63) | ((cl & 64) << 1) | ((cl & 128) >> 1); }
template <bool PERMUTE, bool BLOCKED = false>
__device__ __forceinline__ void cvt_tile64(const float* W, int K, int N, bf16* WT, int ldo, const float* gk, LAS float* scr, int tile, int lane) {
    const int nblk = N >> 6, kb = tile / nblk, nb = tile - kb * nblk, k0 = 64 * kb, n0 = 64 * nb;
    const int lk = lane >> 4, ln = (lane & 15) * 4;
#if CVT_DEEP
    {
        f32x4 v[16];
#pragma unroll
        for (int i = 0; i < 16; ++i) v[i] = *(const f32x4*)(W + (size_t)(k0 + 4 * i + lk) * N + n0 + ln);
#pragma unroll
        for (int i = 0; i < 16; ++i) { const int kk = 4 * i + lk; const float g = gk ? gk[k0 + kk] : 1.0f; LAS float* d = scr + kk * 65 + ln;
            d[0] = v[i][0] * g; d[1] = v[i][1] * g; d[2] = v[i][2] * g; d[3] = v[i][3] * g; }
    }
#else
#pragma unroll
    for (int hh = 0; hh < 2; ++hh) {
        f32x4 v[8];
#pragma unroll
        for (int i = 0; i < 8; ++i) v[i] = *(const f32x4*)(W + (size_t)(k0 + 32 * hh + 4 * i + lk) * N + n0 + ln);
#pragma unroll
        for (int i = 0; i < 8; ++i) { const int kk = 32 * hh + 4 * i + lk; const float g = gk ? gk[k0 + kk] : 1.0f; LAS float* d = scr + kk * 65 + ln;
            d[0] = v[i][0] * g; d[1] = v[i][1] * g; d[2] = v[i][2] * g; d[3] = v[i][3] * g; }
    }
#endif
    LDS_WAIT(); asm volatile("" ::: "memory");
    const int kc = lane & 7, nrow0 = PERMUTE ? win_phys_col(n0) : n0;
#pragma unroll
    for (int j = 0; j < 8; ++j) { const int n = (lane >> 3) + 8 * j; const LAS float* s = scr + (8 * kc) * 65 + n;
        v4u o; o[0] = cvt_pk_bf16(s[0 * 65], s[1 * 65]); o[1] = cvt_pk_bf16(s[2 * 65], s[3 * 65]); o[2] = cvt_pk_bf16(s[4 * 65], s[5 * 65]); o[3] = cvt_pk_bf16(s[6 * 65], s[7 * 65]);
        *(v4u*)(WT + (BLOCKED ? pg8::blocked_off(nrow0 + n, k0 + 8 * kc, K) : (size_t)(nrow0 + n) * ldo + k0 + 8 * kc)) = o; }
    LDS_WAIT(); asm volatile("" ::: "memory");
}
struct CvtCtx { const float* w_in; const float* w_out; const float* w_up; const float* w_down; const float* g_mix; const float* g_mlp; bf16* WinT; bf16* WoutT; bf16* WupT; bf16* WdnT; };
constexpr int CVT_IN = (DM / 64) * (INW / 64) / 8, CVT_OUT = (DM / 64) * (DM / 64) / 8, CVT_UP = (DM / 64) * (DFF / 64) / 8, CVT_DN = (DFF / 64) * (DM / 64) / 8;
__host__ __device__ constexpr int cvt_batch_items(int batch) { return batch == 0 ? CVT_OUT + CVT_UP + CVT_DN + CVT_IN : CVT_OUT + CVT_UP + CVT_DN; }
__device__ __forceinline__ void cvt_item(const CvtCtx& c, int batch, int wi, LAS float* scr, int wave, int lane) {
    const int l = batch;
    if (wi < CVT_OUT) { cvt_tile64<false>(c.w_out + (size_t)l * DM * DM, DM, DM, c.WoutT + (size_t)l * DM * DM, DM, nullptr, scr, 8 * wi + wave, lane); return; } wi -= CVT_OUT;
    if (wi < CVT_UP) { cvt_tile64<false>(c.w_up + (size_t)l * DM * DFF, DM, DFF, c.WupT + (size_t)l * DFF * DM, DM, c.g_mlp + l * DM, scr, 8 * wi + wave, lane); return; } wi -= CVT_UP;
    if (wi < CVT_DN) { cvt_tile64<false, true>(c.w_down + (size_t)l * DFF * DM, DFF, DM, c.WdnT + (size_t)l * DM * DFF, 0, nullptr, scr, 8 * wi + wave, lane); return; } wi -= CVT_DN;
    cvt_tile64<true>(c.w_in + (size_t)1 * DM * INW, DM, INW, c.WinT + (size_t)1 * INW * DM, DM, c.g_mix + 1 * DM, scr, 8 * wi + wave, lane);
}
struct KArgs { const float* in[14]; float* out; unsigned char* ws; int ph_lo, ph_hi; };
__device__ __forceinline__ void cvt_step(int batch, int& ci, int nmax, ldsp lds, int tid, int hi = 1 << 30) {
    const int total = cvt_batch_items(batch) < hi ? cvt_batch_items(batch) : hi;
    if (nmax <= 0 || ci >= total) return;
    const int lane = tid & 63, wave = __builtin_amdgcn_readfirstlane(tid >> 6);
    LAS float* scr = (LAS float*)(lds + wave * 16640);
    const __attribute__((address_space(4))) KArgs* ka = (const __attribute__((address_space(4))) KArgs*)__builtin_amdgcn_kernarg_segment_ptr();
    asm volatile("" : "+s"(ka));
    unsigned char* ws = ka->ws;
    const CvtCtx c{ka->in[2], ka->in[9], ka->in[11], ka->in[12], ka->in[1], ka->in[10], (bf16*)(ws + WS_WIN), (bf16*)(ws + WS_WOUT), (bf16*)(ws + WS_WUP), (bf16*)(ws + WS_WDN)};
    __syncthreads();
    for (int r = 0; r < nmax && ci < total; ++r, ci += 256) cvt_item(c, batch, ci, scr, wave, lane);
    __syncthreads();
}

#ifndef ATTN_XCDQ
#define ATTN_XCDQ 0
#endif
__device__ __forceinline__ int attn_next(unsigned* qx, int& cq, int& tries) {
    for (;;) {
        if (tries >= 8) return 1 << 30;
        const unsigned k = __hip_atomic_fetch_add(qx + 64 * cq, 1u, __ATOMIC_RELAXED, __HIP_MEMORY_SCOPE_AGENT);
        if (k < 256u) return cq * 256 + (int)k;
        cq = (cq + 1) & 7; ++tries;
    }
}
struct AttnItem { int hq, n, b, kh, jb0, jb1; size_t row0; };
__device__ __forceinline__ AttnItem attn_decode(int unit) {
    AttnItem a; a.hq = unit & 15; a.n = (unit >> 4) & 31; a.b = unit >> 9; a.kh = a.hq >> 2;
    a.jb0 = a.n > 0 ? a.n - 1 : 0; a.jb1 = a.n < NCH - 1 ? a.n + 1 : NCH - 1; a.row0 = (size_t)a.b * SEQ + (size_t)a.n * CHUNK; return a;
}
template <int VAR = 0>
__device__ __forceinline__ void attn_queue(ldsp lds, const bf16* proj, bf16* mix, const float* sink, unsigned* qw, volatile LAS int* qslot, int nitems, int tid, int batch, int& ci, int cvt_per_item) {
    const int lane = tid & 63, w = __builtin_amdgcn_readfirstlane(tid >> 6), fr = lane & 15, fq = lane >> 4;
    const ldsp TK = lds, TV = ATTN_VFIX ? lds + 2 * TILE_BYTES : lds + TILE_BYTES, TPp = ATTN_VFIX ? lds + TILE_BYTES : lds + 2 * TILE_BYTES;
    const int rg = ATTN_RG ? (w < 4 ? w : 11 - w) : w;
    const int i = 16 * rg + fr;
    const ldsp kb = row_base(TK, lane), pb = row_base(TPp, lane) + 16u * TP * w, vb = ATTN_VFIX ? tr_base_v(TV, lane) : tr_base(TV, lane);
    if (ATTN_SPRIO) { if ((ATTN_SPRIO_OLD ? w < 4 : w >= 4)) __builtin_amdgcn_s_setprio(ATTN_SPRIO); else __builtin_amdgcn_s_setprio(0); }
    int cq = (int)(xb_xcc_id() & 7u), tries = 0;
    __syncthreads();
    if (tid == 0) *qslot = ATTN_XCDQ ? attn_next(qw, cq, tries) : (int)__hip_atomic_fetch_add(qw, 1u, __ATOMIC_RELAXED, __HIP_MEMORY_SCOPE_AGENT);
    __syncthreads();
    int item = *qslot;
    bf16x8 qf[4]; TileRegs rk, rv;
    if (item < nitems) { const AttnItem a = attn_decode(item);
        const bf16* qrow = proj + (a.row0 + i) * INW + C_AQ + a.hq * HDIM + 8 * fq;
#pragma unroll
        for (int ks = 0; ks < 4; ++ks) qf[ks] = *(const bf16x8*)(qrow + 32 * ks);
        const bf16* kv0 = proj + ((size_t)a.b * SEQ + (size_t)a.jb0 * CHUNK) * INW + a.kh * HDIM; tile_fetch(rk, kv0 + C_AK, INW, tid); tile_fetch(rv, kv0 + C_AV, INW, tid); }
    while (item < nitems) {
        const AttnItem a = attn_decode(item);
        int nxt = 0; if (tid == 0) nxt = ATTN_XCDQ ? attn_next(qw, cq, tries) : (int)__hip_atomic_fetch_add(qw, 1u, __ATOMIC_RELAXED, __HIP_MEMORY_SCOPE_AGENT);
        float mrun = sink[a.hq] * LOG2E, lrun = 1.0f;
        f32x4 O[8]; zero8(O);
        int item_next = nitems;
        for (int jb = a.jb0; jb <= a.jb1; ++jb) {
            __syncthreads();
            if (VAR != 4) { tile_put(TK, rk, tid); if (ATTN_VFIX) tile_put_v(TV, rv, tid); else tile_put(TV, rv, tid); }
            if (jb == a.jb1) item_next = *qslot;
            __syncthreads();
            if (VAR != 3 && jb < a.jb1) { const bf16* kv1 = proj + ((size_t)a.b * SEQ + (size_t)(jb + 1) * CHUNK) * INW + a.kh * HDIM; tile_fetch(rk, kv1 + C_AK, INW, tid); tile_fetch(rv, kv1 + C_AV, INW, tid); }
            const int rel = jb - a.n;
            const bool h0 = ATTN_FULL ? true : (rel <= 0 ? (rel == 0 || rg <= 3) : true), h1 = ATTN_FULL ? true : (rel >= 0 ? (rel == 0 || rg >= 4) : true);
            f32x4 S[8];
#if ATTN_BIAS
            { int d0 = i - 4 * fq; asm volatile("" : "+v"(d0));
              if (rel == 0) zero8(S);
              else if (rel < 0) {
#pragma unroll
                  for (int c = 0; c < 8; ++c)
#pragma unroll
                      for (int j = 0; j < 4; ++j) S[c][j] = (16 * c + j >= d0) ? 0.f : -1e30f;
              } else {
#pragma unroll
                  for (int c = 0; c < 8; ++c)
#pragma unroll
                      for (int j = 0; j < 4; ++j) S[c][j] = (16 * c + j <= d0) ? 0.f : -1e30f; } }
#else
            zero8(S);
#endif
#if ATTN_PIPE
            { auto fk = [&](int c, int ks) { return frag_row(kb, c, ks); }; auto fqq = [&](int ks) { return qf[ks]; };
              if (h0 && h1) mm_pipe<ATTN_G, 0, 4, 0, 8>(S, fk, fqq); else if (h0) mm_pipe<ATTN_G, 0, 4, 0, 4>(S, fk, fqq); else mm_pipe<ATTN_G, 0, 4, 4, 4>(S, fk, fqq); }
#elif ATTN_RG_SKIP
#if ATTN_RG == 2
#pragma unroll
            for (int qd = 0; qd < 4; ++qd) {
                if (rel == 0 || (rel < 0 ? 2 * qd + 1 >= rg : 2 * qd <= rg)) {
#pragma unroll
                    for (int ks = 0; ks < 4; ++ks) {
                        S[2 * qd] = __builtin_amdgcn_mfma_f32_16x16x32_bf16(frag_row(kb, 2 * qd, ks), qf[ks], S[2 * qd], 0, 0, 0);
                        S[2 * qd + 1] = __builtin_amdgcn_mfma_f32_16x16x32_bf16(frag_row(kb, 2 * qd + 1, ks), qf[ks], S[2 * qd + 1], 0, 0, 0); } } }
#else
#pragma unroll
            for (int c = 0; c < 8; ++c) {
                if (rel == 0 || (rel < 0 ? c >= rg : c <= rg)) {
#pragma unroll
                    for (int ks = 0; ks < 4; ++ks) S[c] = __builtin_amdgcn_mfma_f32_16x16x32_bf16(frag_row(kb, c, ks), qf[ks], S[c], 0, 0, 0); } }
#endif
#else
            if (VAR != 2 && h0) {
#pragma unroll
                for (int ks = 0; ks < 4; ++ks)
#pragma unroll
                    for (int c = 0; c < 4; ++c) S[c] = __builtin_amdgcn_mfma_f32_16x16x32_bf16(frag_row(kb, c, ks), qf[ks], S[c], 0, 0, 0); }
            if (VAR != 2 && h1) {
#pragma unroll
                for (int ks = 0; ks < 4; ++ks)
#pragma unroll
                    for (int c = 4; c < 8; ++c) S[c] = __builtin_amdgcn_mfma_f32_16x16x32_bf16(frag_row(kb, c, ks), qf[ks], S[c], 0, 0, 0); }
#endif
            if (jb == a.jb0 && tid == 0) *qslot = nxt;
            if (VAR != 3 && jb == a.jb1 && item_next < nitems) {
                const AttnItem an = attn_decode(item_next);
                const bf16* qrow = proj + (an.row0 + i) * INW + C_AQ + an.hq * HDIM + 8 * fq;
#pragma unroll
                for (int ks = 0; ks < 4; ++ks) qf[ks] = *(const bf16x8*)(qrow + 32 * ks);
                const bf16* kv0 = proj + ((size_t)an.b * SEQ + (size_t)an.jb0 * CHUNK) * INW + an.kh * HDIM; tile_fetch(rk, kv0 + C_AK, INW, tid); tile_fetch(rv, kv0 + C_AV, INW, tid); }
            if (VAR == 1) { lrun += S[0][0]; } else {
#if ATTN_BIAS && ATTN_RG_SKIP
            float mx = -1e30f;
#pragma unroll
            for (int c = 0; c < 8; ++c) mx = fmaxf(fmaxf(mx, fmaxf(S[c][0], S[c][1])), fmaxf(S[c][2], S[c][3]));
            mx = fmaxf(mx, __shfl_xor(mx, 16)); mx = fmaxf(mx, __shfl_xor(mx, 32));
            const float mnew = fmaxf(mrun, mx), alpha = __builtin_amdgcn_exp2f(mrun - mnew);
            float rs = 0.f;
#if ATTN_RG == 2
#pragma unroll
            for (int qd = 0; qd < 4; ++qd) {
                if (rel == 0 || (rel < 0 ? 2 * qd + 1 >= rg : 2 * qd <= rg)) {
#pragma unroll
                    for (int c = 2 * qd; c < 2 * qd + 2; ++c)
#pragma unroll
                        for (int j = 0; j < 4; ++j) { const float p = __builtin_amdgcn_exp2f(S[c][j] - mnew); S[c][j] = p; rs += p; }
                } else { S[2 * qd] = (f32x4){0.f, 0.f, 0.f, 0.f}; S[2 * qd + 1] = (f32x4){0.f, 0.f, 0.f, 0.f}; } }
#else
#pragma unroll
            for (int c = 0; c < 8; ++c) {
                if (rel == 0 || (rel < 0 ? c >= rg : c <= rg)) {
#pragma unroll
                    for (int j = 0; j < 4; ++j) { const float p = __builtin_amdgcn_exp2f(S[c][j] - mnew); S[c][j] = p; rs += p; }
                } else S[c] = (f32x4){0.f, 0.f, 0.f, 0.f}; }
#endif
#elif ATTN_BIAS
            float mx = -1e30f;
            if (h0) {
#pragma unroll
                for (int c = 0; c < 4; ++c) mx = fmaxf(fmaxf(mx, fmaxf(S[c][0], S[c][1])), fmaxf(S[c][2], S[c][3])); }
            if (h1) {
#pragma unroll
                for (int c = 4; c < 8; ++c) mx = fmaxf(fmaxf(mx, fmaxf(S[c][0], S[c][1])), fmaxf(S[c][2], S[c][3])); }
            mx = fmaxf(mx, __shfl_xor(mx, 16)); mx = fmaxf(mx, __shfl_xor(mx, 32));
            const float mnew = fmaxf(mrun, mx), alpha = __builtin_amdgcn_exp2f(mrun - mnew);
            float rs = 0.f;
            if (h0) {
#pragma unroll
                for (int c = 0; c < 4; ++c)
#pragma unroll
                    for (int j = 0; j < 4; ++j) { const float p = __builtin_amdgcn_exp2f(S[c][j] - mnew); S[c][j] = p; rs += p; }
            } else {
#pragma unroll
                for (int c = 0; c < 4; ++c) S[c] = (f32x4){0.f, 0.f, 0.f, 0.f}; }
            if (h1) {
#pragma unroll
                for (int c = 4; c < 8; ++c)
#pragma unroll
                    for (int j = 0; j < 4; ++j) { const float p = __builtin_amdgcn_exp2f(S[c][j] - mnew); S[c][j] = p; rs += p; }
            } else {
#pragma unroll
                for (int c = 4; c < 8; ++c) S[c] = (f32x4){0.f, 0.f, 0.f, 0.f}; }
#else
            float mx = -1e30f;
#pragma unroll
            for (int c = 0; c < 8; ++c) {
                if (rel != 0 && c == w) {
#pragma unroll
                    for (int j = 0; j < 4; ++j) { const int col = 16 * c + 4 * fq + j; const bool valid = rel < 0 ? (col >= i) : (col <= i);
                        const float s = valid ? S[c][j] : -1e30f; S[c][j] = s; mx = fmaxf(mx, s); }
                } else if (rel == 0 || (rel < 0 ? c > w : c < w)) {
                    mx = fmaxf(fmaxf(mx, fmaxf(S[c][0], S[c][1])), fmaxf(S[c][2], S[c][3])); } }
            mx = fmaxf(mx, __shfl_xor(mx, 16)); mx = fmaxf(mx, __shfl_xor(mx, 32));
            const float mnew = fmaxf(mrun, mx), alpha = __builtin_amdgcn_exp2f(mrun - mnew);
            float rs = 0.f;
#pragma unroll
            for (int c = 0; c < 8; ++c) {
                if (rel == 0 || (rel < 0 ? c >= w : c <= w)) {
#pragma unroll
                    for (int j = 0; j < 4; ++j) { const float p = __builtin_amdgcn_exp2f(S[c][j] - mnew); S[c][j] = p; rs += p; }
                } else S[c] = (f32x4){0.f, 0.f, 0.f, 0.f}; }
#endif
            rs += __shfl_xor(rs, 16); rs += __shfl_xor(rs, 32);
            lrun = lrun * alpha + rs; mrun = mnew;
#pragma unroll
            for (int c = 0; c < 8; ++c) O[c] = O[c] * alpha;
            }
            store_acc_tile(TPp, S, w, lane);
            LDS_WAIT();
#if ATTN_PIPE
            { bf16x8 pa[4]; auto fv = [&](int c, int ks) { return ATTN_VFIX ? frag_tr_v(vb, c, ks) : frag_tr(vb, c, ks); }; auto fp = [&](int ks) { return pa[ks]; };
              if (h0 && h1) {
#pragma unroll
                  for (int ks = 0; ks < 4; ++ks) pa[ks] = frag_row(pb, 0, ks);
                  mm_pipe<ATTN_G, 0, 4, 0, 8>(O, fv, fp);
              } else if (h0) { pa[0] = frag_row(pb, 0, 0); pa[1] = frag_row(pb, 0, 1); mm_pipe<ATTN_G, 0, 2, 0, 8>(O, fv, fp);
              } else { pa[2] = frag_row(pb, 0, 2); pa[3] = frag_row(pb, 0, 3); mm_pipe<ATTN_G, 2, 2, 0, 8>(O, fv, fp); } }
#elif ATTN_RG_SKIP
#pragma unroll
            for (int ks = 0; ks < 4; ++ks) {
                if (rel == 0 || (rel < 0 ? 2 * ks + 1 >= rg : 2 * ks <= rg)) { const bf16x8 pa = frag_row(pb, 0, ks);
#pragma unroll
                    for (int c = 0; c < 8; ++c) O[c] = __builtin_amdgcn_mfma_f32_16x16x32_bf16(ATTN_VFIX ? frag_tr_v(vb, c, ks) : frag_tr(vb, c, ks), pa, O[c], 0, 0, 0); } }
#else
            if (VAR != 2 && h0) {
#pragma unroll
                for (int ks = 0; ks < 2; ++ks) { const bf16x8 pa = frag_row(pb, 0, ks);
#pragma unroll
                    for (int c = 0; c < 8; ++c) O[c] = __builtin_amdgcn_mfma_f32_16x16x32_bf16(ATTN_VFIX ? frag_tr_v(vb, c, ks) : frag_tr(vb, c, ks), pa, O[c], 0, 0, 0); } }
            if (VAR != 2 && h1) {
#pragma unroll
                for (int ks = 2; ks < 4; ++ks) { const bf16x8 pa = frag_row(pb, 0, ks);
#pragma unroll
                    for (int c = 0; c < 8; ++c) O[c] = __builtin_amdgcn_mfma_f32_16x16x32_bf16(ATTN_VFIX ? frag_tr_v(vb, c, ks) : frag_tr(vb, c, ks), pa, O[c], 0, 0, 0); } }
#endif
        }
        const float inv = 1.0f / lrun;
#pragma unroll
        for (int c = 0; c < 8; ++c) O[c] = O[c] * inv;
        store_acc_tile(TPp, O, w, lane);
        LDS_WAIT();
        bf16* obase = mix + (a.row0 + 16 * rg) * DM + MIX_C + a.hq * HDIM;
#pragma unroll
        for (int k = 0; k < 4; ++k) { const int q = lane + 64 * k, r = q >> 4, ch = q & 15;
            *(v4u*)(obase + (size_t)r * DM + 8 * ch) = *(const LAS v4u*)(TPp + offb(16 * w + r, ch)); }
        item = item_next;
        cvt_step(batch, ci, cvt_per_item, lds, tid);
    }
    if (ATTN_SPRIO) __builtin_amdgcn_s_setprio(0);
}

#ifndef ATTN_PAIR
#define ATTN_PAIR 0
#endif
__device__ __forceinline__ void attn_bias_init(f32x4 (&S)[8], int rel, int d0) {
    if (rel == 0) zero8(S);
    else if (rel < 0) {
#pragma unroll
        for (int c = 0; c < 8; ++c)
#pragma unroll
            for (int j = 0; j < 4; ++j) S[c][j] = (16 * c + j >= d0) ? 0.f : -1e30f;
    } else {
#pragma unroll
        for (int c = 0; c < 8; ++c)
#pragma unroll
            for (int j = 0; j < 4; ++j) S[c][j] = (16 * c + j <= d0) ? 0.f : -1e30f; }
}
__device__ __forceinline__ void attn_softmax_bias(f32x4 (&S)[8], float& mrun, float& lrun, f32x4 (&O)[8], bool h0, bool h1) {
    float mx = -1e30f;
    if (h0) {
#pragma unroll
        for (int c = 0; c < 4; ++c) mx = fmaxf(fmaxf(mx, fmaxf(S[c][0], S[c][1])), fmaxf(S[c][2], S[c][3])); }
    if (h1) {
#pragma unroll
        for (int c = 4; c < 8; ++c) mx = fmaxf(fmaxf(mx, fmaxf(S[c][0], S[c][1])), fmaxf(S[c][2], S[c][3])); }
    mx = fmaxf(mx, __shfl_xor(mx, 16)); mx = fmaxf(mx, __shfl_xor(mx, 32));
    const float mnew = fmaxf(mrun, mx), alpha = __builtin_amdgcn_exp2f(mrun - mnew);
    float rs = 0.f;
    if (h0) {
#pragma unroll
        for (int c = 0; c < 4; ++c)
#pragma unroll
            for (int j = 0; j < 4; ++j) { const float pp = __builtin_amdgcn_exp2f(S[c][j] - mnew); S[c][j] = pp; rs += pp; }
    } else {
#pragma unroll
        for (int c = 0; c < 4; ++c) S[c] = (f32x4){0.f, 0.f, 0.f, 0.f}; }
    if (h1) {
#pragma unroll
        for (int c = 4; c < 8; ++c)
#pragma unroll
            for (int j = 0; j < 4; ++j) { const float pp = __builtin_amdgcn_exp2f(S[c][j] - mnew); S[c][j] = pp; rs += pp; }
    } else {
#pragma unroll
        for (int c = 4; c < 8; ++c) S[c] = (f32x4){0.f, 0.f, 0.f, 0.f}; }
    rs += __shfl_xor(rs, 16); rs += __shfl_xor(rs, 32);
    lrun = lrun * alpha + rs; mrun = mnew;
#pragma unroll
    for (int c = 0; c < 8; ++c) O[c] = O[c] * alpha;
}
__device__ __forceinline__ void attn_softmax_block(f32x4 (&S)[8], float& mrun, float& lrun, f32x4 (&O)[8], int rel, int w, int i, int fq) {
    float mx = -1e30f;
#pragma unroll
    for (int c = 0; c < 8; ++c) {
        if (rel != 0 && c == w) {
#pragma unroll
            for (int j = 0; j < 4; ++j) { const int col = 16 * c + 4 * fq + j; const bool valid = rel < 0 ? (col >= i) : (col <= i);
                const float s = valid ? S[c][j] : -1e30f; S[c][j] = s; mx = fmaxf(mx, s); }
        } else if (rel == 0 || (rel < 0 ? c > w : c < w)) {
            mx = fmaxf(fmaxf(mx, fmaxf(S[c][0], S[c][1])), fmaxf(S[c][2], S[c][3])); } }
    mx = fmaxf(mx, __shfl_xor(mx, 16)); mx = fmaxf(mx, __shfl_xor(mx, 32));
    const float mnew = fmaxf(mrun, mx), alpha = __builtin_amdgcn_exp2f(mrun - mnew);
    float rs = 0.f;
#pragma unroll
    for (int c = 0; c < 8; ++c) {
        if (rel == 0 || (rel < 0 ? c >= w : c <= w)) {
#pragma unroll
            for (int j = 0; j < 4; ++j) { const float pp = __builtin_amdgcn_exp2f(S[c][j] - mnew); S[c][j] = pp; rs += pp; }
        } else S[c] = (f32x4){0.f, 0.f, 0.f, 0.f}; }
    rs += __shfl_xor(rs, 16); rs += __shfl_xor(rs, 32);
    lrun = lrun * alpha + rs; mrun = mnew;
#pragma unroll
    for (int c = 0; c < 8; ++c) O[c] = O[c] * alpha;
}
struct AttnPItem { int hq0, n, b, kh, jb0, jb1; size_t row0; };
__device__ __forceinline__ AttnPItem attn_pdecode(int unit) {
    AttnPItem a; a.kh = (unit >> 1) & 3; a.hq0 = 4 * a.kh + 2 * (unit & 1); a.n = (unit >> 3) & 31; a.b = unit >> 8;
    a.jb0 = a.n > 0 ? a.n - 1 : 0; a.jb1 = a.n < NCH - 1 ? a.n + 1 : NCH - 1; a.row0 = (size_t)a.b * SEQ + (size_t)a.n * CHUNK; return a;
}
__device__ __forceinline__ void attn_pair_queue(ldsp lds, const bf16* proj, bf16* mix, const float* sink, unsigned* qw, volatile LAS int* qslot, int nitems, int tid0) {
    const ldsp TK = lds, TV = lds + TILE_BYTES, TPa = lds + 2 * TILE_BYTES, TPb = lds + 3 * TILE_BYTES;
    int tid = tid0;
    int lane = tid & 63, w = __builtin_amdgcn_readfirstlane(tid >> 6), fr = lane & 15, fq = lane >> 4, i = 16 * w + fr;
    __syncthreads();
    if (tid == 0) *qslot = (int)__hip_atomic_fetch_add(qw, 1u, __ATOMIC_RELAXED, __HIP_MEMORY_SCOPE_AGENT);
    __syncthreads();
    int item = *qslot;
    bf16x8 qfA[4], qfB[4]; TileRegs rk, rv;
    if (item < nitems) { const AttnPItem a = attn_pdecode(item);
        const bf16* qrow = proj + (a.row0 + i) * INW + C_AQ + a.hq0 * HDIM + 8 * fq;
#pragma unroll
        for (int ks = 0; ks < 4; ++ks) { qfA[ks] = *(const bf16x8*)(qrow + 32 * ks); qfB[ks] = *(const bf16x8*)(qrow + HDIM + 32 * ks); }
        const bf16* kv0 = proj + ((size_t)a.b * SEQ + (size_t)a.jb0 * CHUNK) * INW + a.kh * HDIM; tile_fetch(rk, kv0 + C_AK, INW, tid); tile_fetch(rv, kv0 + C_AV, INW, tid); }
    while (item < nitems) {
        asm volatile("" : "+v"(tid));
        lane = tid & 63; w = __builtin_amdgcn_readfirstlane(tid >> 6); fr = lane & 15; fq = lane >> 4; i = 16 * w + fr;
        const AttnPItem a = attn_pdecode(item);
#if !PAIR_QPRE
        { const bf16* qrow = proj + (a.row0 + i) * INW + C_AQ + a.hq0 * HDIM + 8 * fq;
#pragma unroll
          for (int ks = 0; ks < 4; ++ks) { qfA[ks] = *(const bf16x8*)(qrow + 32 * ks); qfB[ks] = *(const bf16x8*)(qrow + HDIM + 32 * ks); } }
#endif
        int nxt = 0; if (tid == 0) nxt = (int)__hip_atomic_fetch_add(qw, 1u, __ATOMIC_RELAXED, __HIP_MEMORY_SCOPE_AGENT);
        float mA = sink[a.hq0] * LOG2E, lA = 1.0f, mB = sink[a.hq0 + 1] * LOG2E, lB = 1.0f;
        f32x4 OA[8], OB[8]; zero8(OA); zero8(OB);
        int item_next = nitems;
        for (int jb = a.jb0; jb <= a.jb1; ++jb) {
            asm volatile("" : "+v"(tid));
            lane = tid & 63; w = __builtin_amdgcn_readfirstlane(tid >> 6); fr = lane & 15; fq = lane >> 4; i = 16 * w + fr;
            const ldsp kb = row_base(TK, lane), vb = tr_base(TV, lane), pba = row_base(TPa, lane) + 16u * TP * w, pbb = row_base(TPb, lane) + 16u * TP * w;
            __syncthreads();
            tile_put(TK, rk, tid); tile_put(TV, rv, tid);
            if (jb == a.jb1) item_next = *qslot;
            __syncthreads();
            const int rel = jb - a.n;
            const bool h0 = rel <= 0 ? (rel == 0 || w <= 3) : true, h1 = rel >= 0 ? (rel == 0 || w >= 4) : true;
            {
                f32x4 S[8]; if (ATTN_BIAS) { int d0 = i - 4 * fq; asm volatile("" : "+v"(d0)); attn_bias_init(S, rel, d0); } else zero8(S);
                if (h0) {
#pragma unroll
                    for (int ks = 0; ks < 4; ++ks) {
#pragma unroll
                        for (int c = 0; c < 4; ++c) S[c] = __builtin_amdgcn_mfma_f32_16x16x32_bf16(frag_row(kb, c, ks), qfA[ks], S[c], 0, 0, 0);
                        __builtin_amdgcn_sched_barrier(0); } }
                if (h1) {
#pragma unroll
                    for (int ks = 0; ks < 4; ++ks) {
#pragma unroll
                        for (int c = 4; c < 8; ++c) S[c] = __builtin_amdgcn_mfma_f32_16x16x32_bf16(frag_row(kb, c, ks), qfA[ks], S[c], 0, 0, 0);
                        __builtin_amdgcn_sched_barrier(0); } }
                if (jb == a.jb0 && tid == 0) *qslot = nxt;
                if (ATTN_BIAS) attn_softmax_bias(S, mA, lA, OA, h0, h1); else attn_softmax_block(S, mA, lA, OA, rel, w, i, fq);
                store_acc_tile(TPa, S, w, lane); }
            __builtin_amdgcn_sched_barrier(0);
            {
                f32x4 S[8]; if (ATTN_BIAS) { int d0 = i - 4 * fq; asm volatile("" : "+v"(d0)); attn_bias_init(S, rel, d0); } else zero8(S);
                if (h0) {
#pragma unroll
                    for (int ks = 0; ks < 4; ++ks) {
#pragma unroll
                        for (int c = 0; c < 4; ++c) S[c] = __builtin_amdgcn_mfma_f32_16x16x32_bf16(frag_row(kb, c, ks), qfB[ks], S[c], 0, 0, 0);
                        __builtin_amdgcn_sched_barrier(0); } }
                if (h1) {
#pragma unroll
                    for (int ks = 0; ks < 4; ++ks) {
#pragma unroll
                        for (int c = 4; c < 8; ++c) S[c] = __builtin_amdgcn_mfma_f32_16x16x32_bf16(frag_row(kb, c, ks), qfB[ks], S[c], 0, 0, 0);
                        __builtin_amdgcn_sched_barrier(0); } }
                asm volatile("" ::: "memory");
                if (ATTN_BIAS) attn_softmax_bias(S, mB, lB, OB, h0, h1); else attn_softmax_block(S, mB, lB, OB, rel, w, i, fq);
                store_acc_tile(TPb, S, w, lane); }
            __builtin_amdgcn_sched_barrier(0);
            if (jb < a.jb1) { const bf16* kv1 = proj + ((size_t)a.b * SEQ + (size_t)(jb + 1) * CHUNK) * INW + a.kh * HDIM; tile_fetch(rk, kv1 + C_AK, INW, tid); tile_fetch(rv, kv1 + C_AV, INW, tid); }
            else if (item_next < nitems) { const AttnPItem an = attn_pdecode(item_next);
                const bf16* kv0 = proj + ((size_t)an.b * SEQ + (size_t)an.jb0 * CHUNK) * INW + an.kh * HDIM; tile_fetch(rk, kv0 + C_AK, INW, tid); tile_fetch(rv, kv0 + C_AV, INW, tid); }
            LDS_WAIT();
            if (MM_SETPRIO) __builtin_amdgcn_s_setprio(1);
#pragma unroll
            for (int ks = 0; ks < 4; ++ks) {
                if (ks < 2 ? h0 : h1) {
                    const bf16x8 paA = frag_row(pba, 0, ks), paB = frag_row(pbb, 0, ks);
#pragma unroll
                    for (int c = 0; c < 8; ++c) { const bf16x8 vf = frag_tr(vb, c, ks);
                        OA[c] = __builtin_amdgcn_mfma_f32_16x16x32_bf16(vf, paA, OA[c], 0, 0, 0);
                        OB[c] = __builtin_amdgcn_mfma_f32_16x16x32_bf16(vf, paB, OB[c], 0, 0, 0); } }
                __builtin_amdgcn_sched_barrier(0); }
            if (MM_SETPRIO) __builtin_amdgcn_s_setprio(0);
        }
#if PAIR_QPRE
        if (item_next < nitems) { const AttnPItem an = attn_pdecode(item_next);
            const bf16* qrow = proj + (an.row0 + i) * INW + C_AQ + an.hq0 * HDIM + 8 * fq;
#pragma unroll
            for (int ks = 0; ks < 4; ++ks) { qfA[ks] = *(const bf16x8*)(qrow + 32 * ks); qfB[ks] = *(const bf16x8*)(qrow + HDIM + 32 * ks); } }
#endif
        const float invA = 1.0f / lA, invB = 1.0f / lB;
#pragma unroll
        for (int c = 0; c < 8; ++c) { OA[c] = OA[c] * invA; OB[c] = OB[c] * invB; }
        store_acc_tile(TPa, OA, w, lane); store_acc_tile(TPb, OB, w, lane);
        LDS_WAIT();
        bf16* obase = mix + (a.row0 + 16 * w) * DM + MIX_C + a.hq0 * HDIM;
#pragma unroll
        for (int k = 0; k < 4; ++k) { const int q = lane + 64 * k, r = q >> 4, ch = q & 15;
            *(v4u*)(obase + (size_t)r * DM + 8 * ch) = *(const LAS v4u*)(TPa + offb(16 * w + r, ch));
            *(v4u*)(obase + (size_t)r * DM + HDIM + 8 * ch) = *(const LAS v4u*)(TPb + offb(16 * w + r, ch)); }
        item = item_next;
    }
}

__device__ __forceinline__ void sgu_unit(ldsp lds, const bf16* proj, bf16* mix, const float* sgup, const float* ln_g, const float* ln_b, const float* w_s, const float* b_s, int unit, int tid) {
    const int lane = tid & 63, w = __builtin_amdgcn_readfirstlane(tid >> 6), fr = lane & 15, fq = lane >> 4;
    const int g = unit & 7, n = (unit >> 3) & 31, b = unit >> 8;
    const ldsp TA = lds, TB = lds + TILE_BYTES;
    LAS float* stat = (LAS float*)(lds + 3 * TILE_BYTES);
    const size_t row0 = (size_t)b * SEQ + (size_t)n * CHUNK;
#if SGU_EARLY
    TileRegs rv; tile_fetch(rv, proj + row0 * INW + C_V + g * HDIM, INW, tid);
    v4u ur[4];
    { const bf16* ub = proj + (row0 + 16 * w) * INW + C_U + g * HDIM;
#pragma unroll
      for (int k = 0; k < 4; ++k) { const int q = lane + 64 * k; ur[k] = *(const v4u*)(ub + (size_t)(q >> 4) * INW + 8 * (q & 15)); } }
    f32x4 wx[4], wy[4];
    { const float* wsp = w_s + (size_t)g * CHUNK * CHUNK;
#pragma unroll
      for (int i = 0; i < 4; ++i) { const int ck = tid + 512 * i, r = ck >> 4, ch = ck & 15; wx[i] = *(const f32x4*)(wsp + r * 128 + 8 * ch); wy[i] = *(const f32x4*)(wsp + r * 128 + 8 * ch + 4); } }
#endif
    __syncthreads();
    { const int tok = tid >> 2, q = tid & 3;
      const f32x4* p = (const f32x4*)(sgup + ((row0 + tok) * 16 + 4 * q) * 2);
      const f32x4 a = p[0], c = p[1];
      float s = (a[0] + a[2]) + (c[0] + c[2]), ss = (a[1] + a[3]) + (c[1] + c[3]);
      s += __shfl_xor(s, 1); ss += __shfl_xor(ss, 1); s += __shfl_xor(s, 2); ss += __shfl_xor(ss, 2);
      const float mean = s * (1.f / 1024.f), var = fmaxf(ss * (1.f / 1024.f) - mean * mean, 0.f);
      if (q == 0) { stat[2 * tok] = mean; stat[2 * tok + 1] = rsqrtf(var + NORM_EPS); } }
    const float* ws = w_s + (size_t)g * CHUNK * CHUNK;
#pragma unroll
    for (int i = 0; i < 4; ++i) { const int ck = tid + 512 * i, r = ck >> 4, ch = ck & 15;
#if SGU_EARLY
        const f32x4 x = wx[i], y = wy[i];
#else
        const f32x4 x = *(const f32x4*)(ws + r * 128 + 8 * ch), y = *(const f32x4*)(ws + r * 128 + 8 * ch + 4);
#endif
        v4u v; v[0] = cvt_pk_bf16(x[0], x[1]); v[1] = cvt_pk_bf16(x[2], x[3]); v[2] = cvt_pk_bf16(y[0], y[1]); v[3] = cvt_pk_bf16(y[2], y[3]);
        *(LAS v4u*)(TA + offb(r, ch)) = v; }
#if !SGU_EARLY
    TileRegs rv; tile_fetch(rv, proj + row0 * INW + C_V + g * HDIM, INW, tid);
#endif
    __syncthreads();
#pragma unroll
    for (int i = 0; i < 4; ++i) { const int ck = tid + 512 * i, r = ck >> 4, ch = ck & 15;
        const v4u v = rv.v[i];
        const float mean = stat[2 * r], rstd = stat[2 * r + 1];
        const f32x4 g0 = *(const f32x4*)(ln_g + g * HDIM + 8 * ch), g1 = *(const f32x4*)(ln_g + g * HDIM + 8 * ch + 4);
        const f32x4 b0 = *(const f32x4*)(ln_b + g * HDIM + 8 * ch), b1 = *(const f32x4*)(ln_b + g * HDIM + 8 * ch + 4);
        v4u o;
        o[0] = cvt_pk_bf16((bf_lo(v[0]) - mean) * rstd * g0[0] + b0[0], (bf_hi(v[0]) - mean) * rstd * g0[1] + b0[1]);
        o[1] = cvt_pk_bf16((bf_lo(v[1]) - mean) * rstd * g0[2] + b0[2], (bf_hi(v[1]) - mean) * rstd * g0[3] + b0[3]);
        o[2] = cvt_pk_bf16((bf_lo(v[2]) - mean) * rstd * g1[0] + b1[0], (bf_hi(v[2]) - mean) * rstd * g1[1] + b1[1]);
        o[3] = cvt_pk_bf16((bf_lo(v[3]) - mean) * rstd * g1[2] + b1[2], (bf_hi(v[3]) - mean) * rstd * g1[3] + b1[3]);
        *(LAS v4u*)(TB + offb(r, ch)) = o; }
    __syncthreads();
    f32x4 acc[8]; zero8(acc);
    mm128<false, true>(acc, TA, TB, w, lane);
    const int i = 16 * w + fr;
    const float bs = b_s[g * CHUNK + i];
#pragma unroll
    for (int c = 0; c < 8; ++c) acc[c] = acc[c] + bs;
    store_acc_tile(TA, acc, w, lane);
    LDS_WAIT();
    const bf16* ubase = proj + (row0 + 16 * w) * INW + C_U + g * HDIM;
    bf16* obase = mix + (row0 + 16 * w) * DM + MIX_A + g * HDIM;
#pragma unroll
    for (int k = 0; k < 4; ++k) { const int q = lane + 64 * k, r = q >> 4, ch = q & 15;
        const v4u s = *(const LAS v4u*)(TA + offb(16 * w + r, ch)), u = SGU_EARLY ? ur[k] : *(const v4u*)(ubase + (size_t)r * INW + 8 * ch);
        v4u o;
#pragma unroll
        for (int e = 0; e < 4; ++e) o[e] = cvt_pk_bf16(bf_lo(u[e]) * bf_lo(s[e]), bf_hi(u[e]) * bf_hi(s[e]));
        *(v4u*)(obase + (size_t)r * DM + 8 * ch) = o; }
}

__device__ __forceinline__ void ret_chain(ldsp lds, const bf16* proj, bf16* st, const float* ldr, int item, int tid) {
    const int lane = tid & 63, w = __builtin_amdgcn_readfirstlane(tid >> 6), fr = lane & 15, fq = lane >> 4;
    const int h = item & 7, b = (item >> 3) & 3, dir = item >> 5;
    const float l2 = -__expf(ldr[dir * NRH + h]) * LOG2E, cd = __builtin_amdgcn_exp2f(l2 * (float)CHUNK);
    const float a0 = dir ? 0.f : 127.f, a1 = dir ? 1.f : -1.f;
    const int n0 = dir ? NCH - 1 : 0, step = dir ? -1 : 1;
    const bf16* src = proj + (size_t)b * SEQ * INW + h * HDIM;
    bf16* stp = st + (((size_t)dir * BATCH + b) * NRH + h) * (size_t)NCH * (HDIM * HDIM) + (size_t)((16 * w + (fq >> 1)) * 16 + fr) * 8 + 4 * (fq & 1);
    TileRegs rvA, rkA, rvB, rkB;
    tile_fetch(rvA, src + (size_t)n0 * CHUNK * INW + C_RV, INW, tid); tile_fetch(rkA, src + (size_t)n0 * CHUNK * INW + C_RK, INW, tid);
    tile_fetch(rvB, src + (size_t)(n0 + step) * CHUNK * INW + C_RV, INW, tid); tile_fetch(rkB, src + (size_t)(n0 + step) * CHUNK * INW + C_RK, INW, tid);
    __syncthreads();
    tile_put(lds, rvA, tid); tile_put_scaled(lds + TILE_BYTES, rkA, l2, a0, a1, tid);
    __syncthreads();
    f32x4 acc[8]; zero8(acc);
#define CHAIN_STEP(T, RVF, RKF, RVW, RKW) do { const int t_ = (T), n = n0 + step * t_, cur = t_ & 1; \
        const ldsp TV = lds + (cur ? 2 * TILE_BYTES : 0), TKW = TV + TILE_BYTES, TVn = lds + (cur ? 0 : 2 * TILE_BYTES), TKWn = TVn + TILE_BYTES; \
        if (t_ + 2 < NCH) { const size_t o_ = (size_t)(n + 2 * step) * CHUNK * INW; tile_fetch(RVF, src + o_ + C_RV, INW, tid); tile_fetch(RKF, src + o_ + C_RK, INW, tid); } \
        bf16* o = stp + (size_t)n * (HDIM * HDIM); \
        _Pragma("unroll") for (int c = 0; c < 8; ++c) { v2u v; v[0] = cvt_pk_bf16(acc[c][0], acc[c][1]); v[1] = cvt_pk_bf16(acc[c][2], acc[c][3]); *(v2u*)(o + 256 * c) = v; } \
        if (t_ + 1 < NCH) { \
            _Pragma("unroll") for (int c = 0; c < 8; ++c) acc[c] = acc[c] * cd; \
            mm128<true, true>(acc, TV, TKW, w, lane); \
            tile_put(TVn, RVW, tid); tile_put_scaled(TKWn, RKW, l2, a0, a1, tid); } \
        __syncthreads(); } while (0)
    for (int t = 0; t < NCH; t += 2) {
        CHAIN_STEP(t, rvA, rkA, rvB, rkB);
        CHAIN_STEP(t + 1, rvB, rkB, rvA, rkA);
    }
#undef CHAIN_STEP
}

struct RetoutRegs { TileRegs q, k, v, sf, sb; };
__device__ __forceinline__ void retout_fetch(RetoutRegs& R, const bf16* proj, const bf16* st, int unit, int tid) {
    const int h = unit & 7, n = (unit >> 3) & 31, b = unit >> 8;
    const bf16* base = proj + ((size_t)b * SEQ + (size_t)n * CHUNK) * INW + h * HDIM;
    tile_fetch(R.q, base + C_RQ, INW, tid); tile_fetch(R.k, base + C_RK, INW, tid); tile_fetch(R.v, base + C_RV, INW, tid);
    tile_fetch(R.sf, st + ((((size_t)0 * BATCH + b) * NRH + h) * NCH + n) * (size_t)(HDIM * HDIM), HDIM, tid);
    tile_fetch(R.sb, st + ((((size_t)1 * BATCH + b) * NRH + h) * NCH + n) * (size_t)(HDIM * HDIM), HDIM, tid);
}
__device__ __forceinline__ void retout_loop(ldsp lds, const bf16* proj, const bf16* st, bf16* mix, const float* ldr, int u0, int ustep, int nunits, int tid0) {
    const ldsp TQ = lds, TK = lds + TILE_BYTES, TV = lds + 2 * TILE_BYTES, TS = lds + 3 * TILE_BYTES;
    int tid = tid0;
    RetoutRegs R;
    int unit = u0;
    if (unit < nunits) retout_fetch(R, proj, st, unit, tid);
#pragma clang loop unroll(disable)
    while (unit < nunits) {
        asm volatile("" : "+v"(tid));
        const int lane = tid & 63, w = __builtin_amdgcn_readfirstlane(tid >> 6), fr = lane & 15, fq = lane >> 4, i = 16 * w + fr;
        const int h = unit & 7, n = (unit >> 3) & 31, b = unit >> 8;
        const size_t row0 = (size_t)b * SEQ + (size_t)n * CHUNK;
        const float l2f = -__expf(ldr[h]) * LOG2E, l2b = -__expf(ldr[NRH + h]) * LOG2E;
        __syncthreads();
        tile_put(TQ, R.q, tid); tile_put(TK, R.k, tid); tile_put(TV, R.v, tid); tile_put_frag(TS, R.sf, tid);
        __syncthreads();
        f32x4 P[8]; zero8(P);
        mm128<false, false>(P, TQ, TK, w, lane);
#pragma unroll
        for (int c = 0; c < 8; ++c)
#pragma unroll
            for (int j = 0; j < 4; ++j) { const int dl = i - (16 * c + 4 * fq + j);
                P[c][j] *= __builtin_amdgcn_exp2f(dl >= 0 ? l2f * (float)dl : l2b * (float)(-dl)); }
        f32x4 accF[8]; zero8(accF);
        mm128<false, false>(accF, TQ, TS, w, lane);
        __syncthreads();
        store_acc_tile(TK, P, w, lane);
        tile_put_frag(TS, R.sb, tid);
        const bf16* gbase = proj + (row0 + 16 * w) * INW + C_RG + h * HDIM;
        v4u gr[4];
#pragma unroll
        for (int k = 0; k < 4; ++k) { const int q = lane + 64 * k; gr[k] = *(const v4u*)(gbase + (size_t)(q >> 4) * INW + 8 * (q & 15)); }
        const int unext = unit + ustep;
        __syncthreads();
        f32x4 acc[8]; zero8(acc);
        mm128<false, false>(acc, TQ, TS, w, lane);
        const float wf = __builtin_amdgcn_exp2f(l2f * (float)(i + 1)), wb = __builtin_amdgcn_exp2f(l2b * (float)(CHUNK - i));
#pragma unroll
        for (int c = 0; c < 8; ++c) acc[c] = acc[c] * wb + accF[c] * wf;
        asm volatile("" ::: "memory");
        if (unext < nunits) retout_fetch(R, proj, st, unext, tid);
        mm128<false, true>(acc, TK, TV, w, lane);
        float ss = 0.f;
#pragma unroll
        for (int c = 0; c < 8; ++c) ss += (acc[c][0] * acc[c][0] + acc[c][1] * acc[c][1]) + (acc[c][2] * acc[c][2] + acc[c][3] * acc[c][3]);
        ss += __shfl_xor(ss, 16); ss += __shfl_xor(ss, 32);
        const float rn = rsqrtf(ss * (1.f / 128.f) + NORM_EPS);
#pragma unroll
        for (int c = 0; c < 8; ++c) acc[c] = acc[c] * rn;
        store_acc_tile(TK, acc, w, lane);
        LDS_WAIT();
        bf16* obase = mix + (row0 + 16 * w) * DM + MIX_R + h * HDIM;
#pragma unroll
        for (int k = 0; k < 4; ++k) { const int q = lane + 64 * k, r = q >> 4, ch = q & 15;
            const v4u s = *(const LAS v4u*)(TK + offb(16 * w + r, ch)), gw = gr[k];
            v4u o;
#pragma unroll
            for (int e = 0; e < 4; ++e) { const float g0 = bf_lo(gw[e]), g1 = bf_hi(gw[e]);
                o[e] = cvt_pk_bf16(g0 / (1.f + __expf(-g0)) * bf_lo(s[e]), g1 / (1.f + __expf(-g1)) * bf_hi(s[e])); }
            *(v4u*)(obase + (size_t)r * DM + 8 * ch) = o; }
        unit = unext;
    }
}

__device__ __forceinline__ void cvt_rows_bf16(const float* x, bf16* out, float* part, int gw, int ngw, int lane) {
    for (int m = gw; m < M; m += ngw) {
        const f32x4* xr = (const f32x4*)(x + (size_t)m * DM) + lane;
        v2u* o = (v2u*)(out + (size_t)m * DM) + lane;
        float ss = 0.f;
#pragma unroll
        for (int j = 0; j < 16; ++j) { const f32x4 v = xr[64 * j]; ss += (v[0] * v[0] + v[1] * v[1]) + (v[2] * v[2] + v[3] * v[3]);
            v2u ov; ov[0] = cvt_pk_bf16(v[0], v[1]); ov[1] = cvt_pk_bf16(v[2], v[3]); o[64 * j] = ov; }
        ss = wave_sum(ss);
        part[(size_t)m * 64 + lane] = (lane == 0) ? ss : 0.f;
    }
}
__device__ __forceinline__ void final_norm(const bf16* x, float* out, const float* g, const float* part, int gw, int ngw, int lane) {
    for (int m = gw; m < M; m += ngw) {
        const float rstd = 1.0f / sqrtf(wave_sum(part[(size_t)m * 64 + lane]) * (1.f / DM) + NORM_EPS);
        const v4u* xr = (const v4u*)(x + (size_t)m * DM) + lane;
        f32x4* o = (f32x4*)(out + (size_t)m * DM) + 2 * lane;
#pragma unroll
        for (int j = 0; j < 8; ++j) { const v4u v = xr[64 * j];
            const f32x4 g0 = *((const f32x4*)g + 128 * j + 2 * lane), g1 = *((const f32x4*)g + 128 * j + 2 * lane + 1);
            o[128 * j] = (f32x4){bf_lo(v[0]), bf_hi(v[0]), bf_lo(v[1]), bf_hi(v[1])} * rstd * g0;
            o[128 * j + 1] = (f32x4){bf_lo(v[2]), bf_hi(v[2]), bf_lo(v[3]), bf_hi(v[3])} * rstd * g1; }
    }
}
__device__ __forceinline__ void build_rstd(LAS float* tab, const float* part, int pm, int tid) {
    const f32x4* p = (const f32x4*)(part + ((size_t)pm * 256 + (tid >> 1)) * 64 + (tid & 1) * 32); float s = 0.f;
#pragma unroll
    for (int k = 0; k < 8; ++k) { const f32x4 v = p[k]; s += (v[0] + v[1]) + (v[2] + v[3]); }
    s += __shfl_xor(s, 1);
    if ((tid & 1) == 0) tab[tid >> 1] = 1.0f / sqrtf(s * (1.f / DM) + NORM_EPS);
    __syncthreads();
}
template <bool PERMUTE>
__device__ __forceinline__ void transpose_item(const float* W, int K, int N, bf16* WT, const float* gk, LAS float* scr, int item, int lane) {
    const int nblk = N / 32, kb = item / nblk, nb = item % nblk, k0 = 64 * kb, n0 = 32 * nb;
#pragma unroll 8
    for (int i = 0; i < 32; ++i) { const int kk = 2 * i + (lane >> 5); scr[kk * 33 + (lane & 31)] = W[(size_t)(k0 + kk) * N + n0 + (lane & 31)] * (gk ? gk[k0 + kk] : 1.0f); }
    LDS_WAIT(); asm volatile("" ::: "memory");
    const int c = lane & 7;
#pragma unroll
    for (int j = 0; j < 4; ++j) { const int n = (lane >> 3) + 8 * j; const LAS float* s = scr + (8 * c) * 33 + n;
        v4u o; o[0] = cvt_pk_bf16(s[0 * 33], s[1 * 33]); o[1] = cvt_pk_bf16(s[2 * 33], s[3 * 33]); o[2] = cvt_pk_bf16(s[4 * 33], s[5 * 33]); o[3] = cvt_pk_bf16(s[6 * 33], s[7 * 33]);
        *(v4u*)(WT + (size_t)((PERMUTE ? win_phys_col(n0) : n0) + n) * K + k0 + 8 * c) = o; }
    LDS_WAIT(); asm volatile("" ::: "memory");
}
#ifndef MK_MULTI
#define MK_MULTI 0
#endif
#ifndef GEMM_SP2
#define GEMM_SP2 true
#endif
#ifndef GEMM_ALIGN
#define GEMM_ALIGN true
#endif
#ifndef G4_AUXA
#define G4_AUXA 0
#endif
#ifndef G4_AUXB
#define G4_AUXB 0
#endif
#ifndef ORDER4K
#define ORDER4K BlockOrder
#endif
#ifndef CVT_ALL_IN_P0
#define CVT_ALL_IN_P0 0
#endif
#ifndef CVT_PER_ITEM
#define CVT_PER_ITEM 0
#endif
#ifndef CVT_STAGGER
#define CVT_STAGGER 1
#endif
__host__ __device__ constexpr int cvt_slot_lo(int s) { return s == 0 ? 0 : s == 1 ? 1440 : s == 2 ? 2880 : 4608; }
__host__ __device__ constexpr int cvt_slot_hi(int s) { return s == 0 ? 1440 : s == 1 ? 2880 : s == 2 ? 4608 : 5760; }
#define PLACE_STR2(x) #x
#define PLACE_STR(x) PLACE_STR2(x)
constexpr int NPH = 1 + 9 * DEPTH;
#ifndef PROBE_REP_GEMM
#define PROBE_REP_GEMM 0
#endif
#ifndef PROBE_ATTN_VAR
#define PROBE_ATTN_VAR 0
#endif
#ifndef MERGE_M3
#define MERGE_M3 0
#endif
#ifndef PROBE_REP_MIX
#define PROBE_REP_MIX 0
#endif
#ifndef PROBE_REP_CVT
#define PROBE_REP_CVT 0
#endif
constexpr size_t WS_DUMMY = WS_END;
struct Args { const float* in[14]; float* out; unsigned char* ws; int ph_lo, ph_hi; };
__global__ void __launch_bounds__(NWAVES * 64, 2) hybrid_fwd(Args args) {
#if defined(PLACE_SHIFT)
    for (int i_ = 0; i_ < 0; ++i_) {}
    asm volatile(".rept " PLACE_STR(PLACE_SHIFT) "\n\ts_nop 0\n\t.endr" ::: "memory");
#endif
    extern __shared__ __attribute__((aligned(16))) unsigned char lds_raw[];
    const ldsp lds = (ldsp)lds_raw;
    volatile LAS unsigned* MISC = (volatile LAS unsigned*)(lds + MISC_OFF);
    const int tid = threadIdx.x;
    const int G = gridDim.x, bx = blockIdx.x;
    const int ngw = G * NWAVES;
    unsigned char* ws = args.ws;
    unsigned* ctl = (unsigned*)(ws + WS_CTL);
    const float* x_in = args.in[0]; const float* ln_mix_g = args.in[1]; const float* w_in = args.in[2]; const float* sgu_ln_g = args.in[3]; const float* sgu_ln_b = args.in[4];
    const float* sgu_w = args.in[5]; const float* sgu_b = args.in[6]; const float* ret_ld = args.in[7]; const float* attn_sink = args.in[8]; const float* w_out = args.in[9];
    const float* ln_mlp_g = args.in[10]; const float* w_up = args.in[11]; const float* w_down = args.in[12]; const float* final_g = args.in[13];
    float* out = args.out;
    float* cosT = (float*)(ws + WS_COS); float* sinT = (float*)(ws + WS_SIN);
    bf16* WinT = (bf16*)(ws + WS_WIN); bf16* WoutT = (bf16*)(ws + WS_WOUT); bf16* WupT = (bf16*)(ws + WS_WUP); bf16* WdnT = (bf16*)(ws + WS_WDN);
    bf16* Hb = (bf16*)(ws + WS_H); bf16* PROJ = (bf16*)(ws + WS_PROJ); bf16* MIX = (bf16*)(ws + WS_MIX); bf16* HID = (bf16*)(ws + WS_HID);
    bf16* ST = (bf16*)(ws + WS_ST); float* SGUP = (float*)(ws + WS_SGUP);
    float* RSA = (float*)(ws + WS_RSA); float* RSB = (float*)(ws + WS_RSB);
    LAS float* rstd_tab = (LAS float*)(lds + RSTD_OFF);

    for (int u = tid; u < (LDS_BYTES - LDSCTL_OFF) / 4; u += NWAVES * 64) ((LAS unsigned*)(lds + LDSCTL_OFF))[u] = 0u;
    __syncthreads();
#if HW_TID
    if ((tid & 63) == 0) *(volatile LAS int*)(lds + HWTAB_OFF + 4u * hw_slot()) = tid >> 6;
    __syncthreads();
#endif
#if !MK_MULTI
    { XcdBarrier bar0 = xcd_barrier_post(ctl + CW_BAR, MISC + 8); (void)bar0; }
#if defined(PROBE_BAR2)
#define GRID_BAR() do { xcd_barrier(bar); xcd_barrier(bar); xcd_barrier(bar); } while (0)
#else
#define GRID_BAR() do { const __attribute__((address_space(4))) KArgs* ka_ = (const __attribute__((address_space(4))) KArgs*)__builtin_amdgcn_kernarg_segment_ptr(); asm volatile("" : "+s"(ka_)); \
        XcdBarrier b_; b_.bar = (unsigned*)(ka_->ws + WS_CTL) + CW_BAR; b_.x = xb_xcc_id(); b_.st = MISC + 8; xcd_barrier(b_); } while (0)
#endif
#else
#define GRID_BAR() do {} while (0)
#endif
    const int lo = args.ph_lo, hi = args.ph_hi;
#ifndef MK_ONLY
#define MK_ONLY -1
#endif
#ifndef MK_SUB
#define MK_SUB -1
#endif
#define SUB(k) (MK_SUB < 0 || MK_SUB == (k))
#define SITE(k) (MK_ONLY < 0 || MK_ONLY == (k))
#if MK_MULTI
#define IN(k) (lo <= (k) && (k) < hi)
#else
#define IN(k) true
#endif
#define CVT_SLOT(S, WHEN_ODD) do { if (CVT_STAGGER && !CVT_ALL_IN_P0 && ((bx & 1) != 0) == (WHEN_ODD)) { int tq = hw_tid(lds); asm volatile("" : "+v"(tq)); int ci_ = cvt_slot_lo(S) + bx; cvt_step(l, ci_, 1 << 30, lds, tq, cvt_slot_hi(S)); } } while (0)
#define CVT_GRP() ((((bx & 1) << 1) | ((bx >> 3) & 1)))
#define CVT_SLOT4_BEFORE(S) int ci_slot = cvt_slot_lo(S) + bx; do { int tq = hw_tid(lds); asm volatile("" : "+v"(tq)); \
        const int hi_ = cvt_slot_hi(S) < cvt_batch_items(l) ? cvt_slot_hi(S) : cvt_batch_items(l); const int nit_ = ci_slot < hi_ ? (hi_ - ci_slot + 255) / 256 : 0; \
        cvt_step(l, ci_slot, (nit_ * (3 - CVT_GRP()) + 1) / 3, lds, tq, cvt_slot_hi(S)); } while (0)
#define CVT_SLOT4_AFTER(S) do { int tq = hw_tid(lds); asm volatile("" : "+v"(tq)); cvt_step(l, ci_slot, 1 << 30, lds, tq, cvt_slot_hi(S)); } while (0)
#define FRESH_TID() int tz = hw_tid(lds); asm volatile("" : "+v"(tz)); const int lz = tz & 63, wz = __builtin_amdgcn_readfirstlane(tz >> 6), gwz = bx * NWAVES + wz; (void)lz; (void)gwz

    if (SITE(0) && IN(0)) {
        FRESH_TID();
        LAS float* scr64 = (LAS float*)(lds + wz * 16640);
        for (int wi = bx; wi < CVT_IN; wi += G) cvt_tile64<true>(w_in, DM, INW, WinT, DM, ln_mix_g, scr64, 8 * wi + wz, lz);
#if CVT_ALL_IN_P0
        { int ci0 = bx, ci1 = bx; cvt_step(0, ci0, 1 << 30, lds, tz); cvt_step(1, ci1, 1 << 30, lds, tz); }
#endif
        if (bx == 0 && tz < 64) cosT[tz] = powf(10000.0f, -(float)(2 * tz) / 128.0f) * 0.15915494309189535f;
        cvt_rows_bf16(x_in, Hb, RSA, gwz, ngw, lz);
        GRID_BAR();
    }
#if defined(PROBE_BARS)
    if (IN(0)) { for (int i = 0; i < PROBE_BARS; ++i) GRID_BAR(); }
#endif
#if defined(PROBE_EPI)
    if (IN(0)) {
        pg8::Gemm g{Hb, WinT, M, 8192, DM, DM, DM};
#ifndef PROBE_WGM
#define PROBE_WGM 8
#endif
#if PROBE_WGM == 0
        typedef pg8::SameTileOrder ProbeOrder;
#else
        typedef pg8::StaticOrderW<PROBE_WGM> ProbeOrder;
#endif
        ProbeOrder S; S.init(M, 8192, G, bx);
        { FRESH_TID(); for (int q = 0; q < 4; ++q) build_rstd(rstd_tab + 256 * q, RSA, 0, tz); }
        pg8::EpiProbe<PROBE_EPI - 1> E{HID, 8192, pg8::RowScale{rstd_tab}};
#if defined(PROBE_SPLIT)
        pg8::Gemm g1{Hb, WinT, M, 4096, DM, DM, DM}, g2{Hb, WinT + (size_t)4096 * DM, M, 4096, DM, DM, DM}; ProbeOrder S1; S1.init(M, 4096, G, bx);
        for (int rep = 0; rep < PROBE_REPS; ++rep) { pg8::gemm_phase<pg8::EpiProbe<PROBE_EPI - 1>, ProbeOrder, GEMM_ALIGN, GEMM_SP2>(lds, g1, S1, E); GRID_BAR();
                                                     pg8::gemm_phase<pg8::EpiProbe<PROBE_EPI - 1>, ProbeOrder, GEMM_ALIGN, GEMM_SP2>(lds, g2, S1, E); GRID_BAR(); }
#else
        for (int rep = 0; rep < PROBE_REPS; ++rep) { pg8::gemm_phase<pg8::EpiProbe<PROBE_EPI - 1>, ProbeOrder, GEMM_ALIGN, GEMM_SP2>(lds, g, S, E); GRID_BAR(); }
#endif
    }
#endif
    for (int l = 0; l < DEPTH; ++l) {
        const int p0 = 1 + 9 * l;
        for (int rep = 0; rep < 1 + (PROBE_REP_GEMM & 1); ++rep)
        if (SITE(1) && IN(p0 + 0)) {
#if CVT_STAGGER == 4
            CVT_SLOT4_BEFORE(0);
#else
            CVT_SLOT(0, true);
#endif
            pg8::Gemm g{Hb, WinT + (size_t)l * INW * DM, M, INW, DM, DM, DM}; pg8::StaticOrder S; S.init(M, INW, G, bx);
            { pg8::Unit u0; S.next(0, u0); FRESH_TID(); build_rstd(rstd_tab + 256 * (u0.pm >> 4), RSA, u0.pm, tz); }
            pg8::EpiIn E{PROJ, INW, pg8::RowScale{rstd_tab}, cosT, SGUP, SEQ};
            pg8::gemm_phase<pg8::EpiIn, pg8::StaticOrder, GEMM_ALIGN, GEMM_SP2>(lds, g, S, E);
#if CVT_STAGGER == 4
            CVT_SLOT4_AFTER(0);
#else
            CVT_SLOT(0, false);
#endif
            GRID_BAR();
        }
        for (int rep = 0; rep < 1 + PROBE_REP_MIX; ++rep) {
        if (SITE(2) && IN(p0 + 1)) {
            FRESH_TID();
            volatile LAS int* qslot = (volatile LAS int*)(lds + MISC_OFF + 64);
#define RUN_QUEUE(QI, NITEMS, CALL) do { unsigned* qw = ctl + CW_Q + 64 * (3 * l + (QI)) + 64 * 6 * rep; __syncthreads(); \
                if (tz == 0) *qslot = (int)__hip_atomic_fetch_add(qw, 1u, __ATOMIC_RELAXED, __HIP_MEMORY_SCOPE_AGENT); __syncthreads(); int item = *qslot; \
                while (item < (NITEMS)) { int nxt = 0; if (tz == 0) nxt = (int)__hip_atomic_fetch_add(qw, 1u, __ATOMIC_RELAXED, __HIP_MEMORY_SCOPE_AGENT); \
                    CALL; __syncthreads(); if (tz == 0) *qslot = nxt; __syncthreads(); item = *qslot; } } while (0)
#define SGU_PASS(QI) RUN_QUEUE(QI, 1024, sgu_unit(lds, PROJ, MIX, SGUP, sgu_ln_g + l * 1024, sgu_ln_b + l * 1024, sgu_w + (size_t)l * NSG * CHUNK * CHUNK, sgu_b + l * NSG * CHUNK, item, tz))
#if defined(PROBE_MIXPART)
#ifndef PROBE_MIXREPS
#define PROBE_MIXREPS 1
#endif
            for (int pr = 0; pr < PROBE_MIXREPS; ++pr) {
#if PROBE_MIXPART == 1
            RUN_QUEUE((20 - 2 * l + 4 * pr), 64, ret_chain(lds, PROJ, ST, ret_ld + l * 2 * NRH, item, tz));
#endif
#if PROBE_MIXPART == 5
            { int cix = 1 << 30; attn_queue<PROBE_ATTN_VAR>(lds, PROJ, MIX, attn_sink + l * NQH, ctl + CW_Q + 64 * (20 - 2 * l + 4 * pr), qslot, 2048, tz, l, cix, 0); }
#endif
            __syncthreads(); GRID_BAR(); }
#endif
#if MERGE_M3
            unsigned* const chains_done = ctl + CW_Q + 64 * (40 + l + 2 * rep);
            { unsigned* qw = ctl + CW_Q + 64 * (3 * l) + 64 * 6 * rep; int ndone = 0; __syncthreads();
              if (tz == 0) *qslot = (int)__hip_atomic_fetch_add(qw, 1u, __ATOMIC_RELAXED, __HIP_MEMORY_SCOPE_AGENT); __syncthreads(); int item = *qslot;
              while (item < 64) { int nxt = 0; if (tz == 0) nxt = (int)__hip_atomic_fetch_add(qw, 1u, __ATOMIC_RELAXED, __HIP_MEMORY_SCOPE_AGENT);
                  ret_chain(lds, PROJ, ST, ret_ld + l * 2 * NRH, item, tz); ++ndone; __syncthreads(); if (tz == 0) *qslot = nxt; __syncthreads(); item = *qslot; }
              if (__builtin_amdgcn_readfirstlane(ndone) != 0) {
                  asm volatile("s_waitcnt vmcnt(0)" ::: "memory"); __syncthreads();
                  if (tz == 0) { __builtin_amdgcn_fence(__ATOMIC_RELEASE, "agent"); asm volatile("s_waitcnt vmcnt(0)" ::: "memory"); (void)xb_add(chains_done, (unsigned)ndone); } } }
#else
            RUN_QUEUE(0, 64, ret_chain(lds, PROJ, ST, ret_ld + l * 2 * NRH, item, tz));
#endif


            int ci = (CVT_ALL_IN_P0 || CVT_STAGGER) ? (1 << 30) : bx;
#if ATTN_PAIR
            attn_pair_queue(lds, PROJ, MIX, attn_sink + l * NQH, ctl + CW_Q + 64 * (3 * l + 1) + 64 * 6 * rep, qslot, 1024, tz);
#else
            attn_queue(lds, PROJ, MIX, attn_sink + l * NQH, ATTN_XCDQ ? ctl + CW_Q + 64 * (64 + 16 * l + 32 * rep) : ctl + CW_Q + 64 * (3 * l + 1) + 64 * 6 * rep, qslot, 2048, tz, l, ci, CVT_PER_ITEM);
#endif
            { int tz = hw_tid(lds); asm volatile("" : "+v"(tz));
            SGU_PASS(2);
            if (!CVT_STAGGER) cvt_step(l, ci, 1 << 30, lds, tz); }
#undef SGU_PASS
#undef RUN_QUEUE
#if MERGE_M3
            __syncthreads();
            if (tz == 0) { XB_SPIN(xb_ld(chains_done) < 64u, ctl + CW_BAR); __builtin_amdgcn_fence(__ATOMIC_ACQUIRE, "agent"); asm volatile("s_waitcnt vmcnt(0)" ::: "memory"); }
            __syncthreads();
            { FRESH_TID(); retout_loop(lds, PROJ, ST, MIX, ret_ld + l * 2 * NRH, bx, G, 1024, tz); }
            __syncthreads();
#endif
            GRID_BAR();
        }
#define SGU_STATIC_PASS() do { for (int u = bx; u < 1024; u += G) sgu_unit(lds, PROJ, MIX, SGUP, sgu_ln_g + l * 1024, sgu_ln_b + l * 1024, sgu_w + (size_t)l * NSG * CHUNK * CHUNK, sgu_b + l * NSG * CHUNK, u, tz); } while (0)
#define RETOUT_PASS() retout_loop(lds, PROJ, ST, MIX, ret_ld + l * 2 * NRH, bx, G, 1024, tz)
        if (!MERGE_M3 && SITE(4) && IN(p0 + 3)) {
            FRESH_TID();
#if defined(PROBE_MIXPART) && PROBE_MIXPART == 3
            for (int pr = 0; pr < PROBE_MIXREPS; ++pr) { SGU_STATIC_PASS(); __syncthreads(); GRID_BAR(); }
#endif
#if defined(PROBE_MIXPART) && PROBE_MIXPART == 2
            for (int pr = 0; pr < PROBE_MIXREPS; ++pr) { volatile LAS int* qslot2 = (volatile LAS int*)(lds + MISC_OFF + 64); int cix = 1 << 30;
                attn_queue<PROBE_ATTN_VAR>(lds, PROJ, MIX, attn_sink + l * NQH, ctl + CW_Q + 64 * (20 - 2 * l + 4 * pr), qslot2, 2048, tz, l, cix, 0); __syncthreads(); GRID_BAR(); }
#endif
#if defined(PROBE_MIXPART) && PROBE_MIXPART == 4
            for (int pr = 0; pr <= PROBE_MIXREPS; ++pr) { RETOUT_PASS(); __syncthreads(); GRID_BAR(); }
#else
            RETOUT_PASS();
            __syncthreads();
            GRID_BAR();
#endif
        }
        }
        if (SITE(5) && IN(p0 + 4)) {
#if CVT_STAGGER == 4
            CVT_SLOT4_BEFORE(1);
#else
            CVT_SLOT(1, true);
#endif
            pg8::Gemm g{MIX, WoutT + (size_t)l * DM * DM, M, DM, DM, DM, DM}; pg8::ORDER4K S; S.init(M, DM, G, bx);
            pg8::EpiResB E{Hb, DM, RSB};
            pg8::gemm_phase<pg8::EpiResB, pg8::ORDER4K, GEMM_ALIGN, GEMM_SP2>(lds, g, S, E);
#if CVT_STAGGER == 4
            CVT_SLOT4_AFTER(1);
#else
            CVT_SLOT(1, false);
#endif
            GRID_BAR();
        }
        for (int rep = 0; rep < 1 + ((PROBE_REP_GEMM >> 1) & 1); ++rep)
        if (SITE(7) && IN(p0 + 6)) {
#if CVT_STAGGER == 4
            CVT_SLOT4_BEFORE(2);
#else
            CVT_SLOT(2, true);
#endif
            pg8::Gemm g{Hb, WupT + (size_t)l * DFF * DM, M, DFF, DM, DM, DM}; pg8::StaticOrder S; S.init(M, DFF, G, bx);
            { pg8::Unit u0; S.next(0, u0); FRESH_TID(); build_rstd(rstd_tab + 256 * (u0.pm >> 4), RSB, u0.pm, tz); }
            pg8::EpiRelu2 E{HID, DFF, pg8::RowScale{rstd_tab}};
            pg8::gemm_phase<pg8::EpiRelu2, pg8::StaticOrder, GEMM_ALIGN, GEMM_SP2>(lds, g, S, E);
#if CVT_STAGGER == 4
            CVT_SLOT4_AFTER(2);
#else
            CVT_SLOT(2, false);
#endif
            GRID_BAR();
        }
        if (SITE(8) && IN(p0 + 7)) {
#if CVT_STAGGER == 4
            CVT_SLOT4_BEFORE(3);
#else
            CVT_SLOT(3, true);
#endif
            pg8::Gemm g{HID, WdnT + (size_t)l * DM * DFF, M, DM, DFF, 64, 64}; pg8::ORDER4K S; S.init(M, DM, G, bx);
            pg8::EpiResB E{Hb, DM, RSA};
            pg8::gemm_phase<pg8::EpiResB, pg8::ORDER4K, GEMM_ALIGN, GEMM_SP2, true, true, G4_AUXA, G4_AUXB>(lds, g, S, E);
#if CVT_STAGGER == 4
            CVT_SLOT4_AFTER(3);
#else
            CVT_SLOT(3, false);
#endif
            GRID_BAR();
        }
        if (SITE(9) && IN(p0 + 8) && l + 1 == DEPTH) {
            FRESH_TID();
            final_norm(Hb, out, final_g, RSA, gwz, ngw, lz);
        }
    }
#undef IN
}

extern "C" void kernel_launch(void* const* d_in, const int* in_sizes, int n_in, void* d_out, int out_size, void* d_ws, size_t ws_size, hipStream_t stream) {
    static int grid = 0;
    if (grid == 0) {
        if (n_in != 14 || in_sizes[0] != M * DM || out_size != M * DM || ws_size < WS_END + ((PROBE_REP_GEMM) ? 256 * MiB : 0)) { fprintf(stderr, "kernel_launch: unexpected shapes (n_in %d, in0 %d, out %d, ws %zu < %zu); nothing launched\n", n_in, n_in > 0 ? in_sizes[0] : -1, out_size, ws_size, (size_t)WS_END); grid = -1; return; }
        int dev = 0, cus = 0, per_cu = 0;
        if (hipGetDevice(&dev) != hipSuccess || hipDeviceGetAttribute(&cus, hipDeviceAttributeMultiprocessorCount, dev) != hipSuccess) { grid = -1; return; }
        if (hipFuncSetAttribute((const void*)hybrid_fwd, hipFuncAttributeMaxDynamicSharedMemorySize, LDS_BYTES) != hipSuccess) { fprintf(stderr, "kernel_launch: hipFuncSetAttribute failed\n"); grid = -1; return; }
        if (hipOccupancyMaxActiveBlocksPerMultiprocessor(&per_cu, (const void*)hybrid_fwd, NWAVES * 64, LDS_BYTES) != hipSuccess || per_cu < 1)
            fprintf(stderr, "kernel_launch: note: occupancy query reports %d workgroups per CU\n", per_cu);
        (void)hipGetLastError();
        if (cus < 256) { fprintf(stderr, "kernel_launch: needs 256 CUs, found %d\n", cus); grid = -1; return; }
        grid = 256;
    }
    if (grid < 0) return;
    if (hipMemsetAsync((char*)d_ws + WS_CTL, 0, CTL_ZERO_BYTES, stream) != hipSuccess) { fprintf(stderr, "kernel_launch: memset failed\n"); return; }
    Args a{};
    for (int i = 0; i < 14; ++i) a.in[i] = (const float*)d_in[i];
    a.out = (float*)d_out; a.ws = (unsigned char*)d_ws;
#if MK_MULTI
    for (int p = 0; p < NPH; ++p) { a.ph_lo = p; a.ph_hi = p + 1; hipLaunchKernelGGL(hybrid_fwd, dim3(grid), dim3(NWAVES * 64), LDS_BYTES, stream, a); }
#else
    a.ph_lo = 0; a.ph_hi = NPH;
    hipLaunchKernelGGL(hybrid_fwd, dim3(grid), dim3(NWAVES * 64), LDS_BYTES, stream, a);
#endif
    const hipError_t le = hipPeekAtLastError();
    if (le != hipSuccess) fprintf(stderr, "kernel_launch: launch failed: %s\n", hipGetErrorName(le));
}
```

```cpp
#define HW_TID 1
#define MM_PIPE 0
#define ATTN_PIPE 0
#define ATTN_VFIX 0
#define ATTN_BIAS 1
#define ATTN_PAIR 1
#define GEMM_LOOP_ALIGN 6
#include <hip/hip_runtime.h>
#include <cstdio>
#include <cstdint>
namespace pg8 {
#define PG8_LAS __attribute__((address_space(3)))
typedef unsigned short bf16_t;
typedef short bf16x8 __attribute__((ext_vector_type(8)));
typedef float f32x4 __attribute__((ext_vector_type(4)));
typedef unsigned u32x4 __attribute__((ext_vector_type(4)));
constexpr int BM = 256, BK = 64, HALF = 128, HTB = HALF * BK * 2  , STAGE_BYTES = 8 * HTB, NXCD = 8, WGM = 8;

__host__ __device__ __forceinline__ int lds_byte(int r, int c) { const int st = (r >> 4) * 2 + (c >> 5), rr = r & 15, cc = c & 31, ob = rr * 64 + cc * 2; return st * 1024 + (ob ^ (((ob >> 9) & 1) << 5)); }
__host__ __device__ __forceinline__ void stage_rc(int b, int& R, int& C) { const int st = b / 1024, sb = b % 1024, swz = sb ^ (((sb >> 9) & 1) << 5); R = (st >> 1) * 16 + swz / 64; C = (st & 1) * 32 + (swz % 64) / 2; }
__host__ __device__ __forceinline__ int perm32(int rho) { const int n = rho >> 4, i = rho & 15; return 8 * (i >> 2) + 4 * n + (i & 3); }

struct Unit { int pm, pn; };
struct Gemm { const bf16_t* A; const bf16_t* Bt; int M, N, K, lda, ldb; };
__host__ __device__ __forceinline__ size_t blocked_off(int row, int col, int K) { return (((size_t)(row >> 8) * (K >> 6) + (col >> 6)) * 256 + (row & 255)) * 64 + (col & 63); }

#ifndef HW_TID
#define HW_TID 0
#endif
constexpr int HWTAB_OFF = 139264 + 320 + 256;
__device__ __forceinline__ unsigned hw_slot() { return (unsigned)__builtin_amdgcn_s_getreg((5 << 11) | 4) & 63u; }
__device__ __forceinline__ int hw_lane() { int l; asm volatile("v_mbcnt_lo_u32_b32 %0, -1, 0\n\tv_mbcnt_hi_u32_b32 %0, -1, %0" : "=v"(l)); return l; }
__device__ __forceinline__ int hw_tid(__attribute__((address_space(3))) unsigned char* lds) {
#if HW_TID
    const int wv = __builtin_amdgcn_readfirstlane(*(volatile __attribute__((address_space(3))) int*)(lds + HWTAB_OFF + 4u * hw_slot()));
    return 64 * wv + hw_lane();
#else
    (void)lds; return (int)threadIdx.x;
#endif
}
struct StaticOrder {
    int nM, nN, nwg, G, c;
    __host__ __device__ void init(int M, int N, int G_, int c_) { nM = M / BM; nN = N / BM; nwg = nM * nN; G = G_; c = c_; }
    __host__ __device__ bool next(int i, Unit& u) const {
        const long L = (long)i * G + c; if (L >= nwg) return false;
        int wgid = (int)L; { const int q = nwg / NXCD, r = nwg % NXCD, xcd = wgid % NXCD, off = wgid / NXCD; wgid = (xcd < r ? xcd * (q + 1) : r * (q + 1) + (xcd - r) * q) + off; }
        const int nig = WGM * nN, gid = wgid / nig, fm = gid * WGM, gsz = (nM - fm) < WGM ? (nM - fm) : WGM;
        u.pm = fm + ((wgid % nig) % gsz); u.pn = (wgid % nig) / gsz; return true;
    }
    __device__ __forceinline__ void a_ready(const Unit&) const {}
    __device__ __forceinline__ void done(const Unit&) const {}
};

typedef float f32x2c_t __attribute__((ext_vector_type(2))); typedef __bf16 bf16x2c_t __attribute__((ext_vector_type(2)));
__device__ __forceinline__ unsigned cvt_pk_bf16(float lo, float hi) { const f32x2c_t v = {lo, hi}; return __builtin_bit_cast(unsigned, __builtin_convertvector(v, bf16x2c_t)); }
__device__ __forceinline__ float quad_sum(float x) {
    auto r = __builtin_amdgcn_permlane16_swap(__builtin_bit_cast(unsigned, x), __builtin_bit_cast(unsigned, x), false, false);
    x = __builtin_bit_cast(float, (unsigned)r[0]) + __builtin_bit_cast(float, (unsigned)r[1]);
    auto q = __builtin_amdgcn_permlane32_swap(__builtin_bit_cast(unsigned, x), __builtin_bit_cast(unsigned, x), false, false);
    return __builtin_bit_cast(float, (unsigned)q[0]) + __builtin_bit_cast(float, (unsigned)q[1]);
}
__device__ __forceinline__ float quad_max(float x) {
    auto r = __builtin_amdgcn_permlane16_swap(__builtin_bit_cast(unsigned, x), __builtin_bit_cast(unsigned, x), false, false);
    x = __builtin_fmaxf(__builtin_bit_cast(float, (unsigned)r[0]), __builtin_bit_cast(float, (unsigned)r[1]));
    auto q = __builtin_amdgcn_permlane32_swap(__builtin_bit_cast(unsigned, x), __builtin_bit_cast(unsigned, x), false, false);
    return __builtin_fmaxf(__builtin_bit_cast(float, (unsigned)q[0]), __builtin_bit_cast(float, (unsigned)q[1]));
}
typedef float f32x2 __attribute__((ext_vector_type(2)));
__device__ __forceinline__ f32x2 gelu_pk(f32x2 v) {
    const f32x2 av = __builtin_elementwise_abs(v), d = av * 0.2316418882f + 1.0f;
    f32x2 t; t.x = __builtin_amdgcn_rcpf(d.x); t.y = __builtin_amdgcn_rcpf(d.y);
    f32x2 q = t * 0.5307027145f + (-0.7265760135f); q = q * t + 0.7107068705f; q = q * t + (-0.142248368f); q = q * t + 0.127414796f; q = q * t;
    const f32x2 s = (v * v) * (-0.72134752044f);
    f32x2 e; e.x = __builtin_amdgcn_exp2f(s.x); e.y = __builtin_amdgcn_exp2f(s.y);
    const f32x2 m = v * (q * e), r = v - m;
    f32x2 o; o.x = v.x < 0.f ? m.x : r.x; o.y = v.y < 0.f ? m.y : r.y; return o;
}

#ifndef EPI_NT
#define EPI_NT 0
#endif
#if EPI_NT
#define EPI_STORE16(p, v) __builtin_nontemporal_store((v), (u32x4*)(p))
#else
#define EPI_STORE16(p, v) (*(u32x4*)(p) = (v))
#endif
struct RowScale {
    const PG8_LAS float* tab;
    __device__ __forceinline__ float get(int pm, int rl) const { return tab[((pm >> 4) << 8) + rl]; }
};
struct EpiIn {
    static constexpr bool PERM = true, AFTER_DRAIN = false;
    bf16_t* O; int ldc; RowScale rs; const float* invrev; float* sgup; int seq;
    __device__ __forceinline__ void operator()(const f32x4 (&acc)[2][2][4][2], const Unit& u, int wr, int wc, int fr, int fq) const {
        const int pn = u.pn, row0 = u.pm * BM + wr * 64 + fr;
        const bool rope = (pn >= 8 && pn < 16) || (pn >= 24 && pn < 34);
        if (rope) {
            const float qs = (pn >= 24 && pn < 32) ? 0.08838834764831845f * 1.4426950408889634f : ((pn >= 12 && pn < 16) ? 0.08838834764831845f : 1.0f);
            const int dp = 32 * (wc & 1) + 8 * fq, colr = pn * BM + 128 * (wc >> 1) + dp;
            f32x4 fr0 = *(const f32x4*)(invrev + dp), fr1 = *(const f32x4*)(invrev + dp + 4);
#pragma unroll
            for (int gi = 0; gi < 8; ++gi) { const int ai = gi >> 2, m = gi & 3;
                const int row = row0 + ai * HALF + m * 16; bf16_t* rowp = O + (size_t)row * ldc + colr;
                const float pos = (float)(row & (seq - 1));
                f32x4 c0, c1, s0, s1;
#pragma unroll
                for (int e = 0; e < 4; ++e) { const float t0 = __builtin_amdgcn_fractf(pos * fr0[e]), t1 = __builtin_amdgcn_fractf(pos * fr1[e]);
                    c0[e] = __builtin_amdgcn_cosf(t0); s0[e] = __builtin_amdgcn_sinf(t0); c1[e] = __builtin_amdgcn_cosf(t1); s1[e] = __builtin_amdgcn_sinf(t1); }
                const float rsc = rs.get(u.pm, wr * 64 + fr + ai * HALF + m * 16) * qs;
                const f32x4 l0 = acc[ai][0][m][0] * rsc, l1 = acc[ai][0][m][1] * rsc, h0 = acc[ai][1][m][0] * rsc, h1 = acc[ai][1][m][1] * rsc;
                const f32x4 ol0 = l0 * c0 - h0 * s0, ol1 = l1 * c1 - h1 * s1, oh0 = h0 * c0 + l0 * s0, oh1 = h1 * c1 + l1 * s1;
                u32x4 wl, wh;
                wl.x = cvt_pk_bf16(ol0[0], ol0[1]); wl.y = cvt_pk_bf16(ol0[2], ol0[3]); wl.z = cvt_pk_bf16(ol1[0], ol1[1]); wl.w = cvt_pk_bf16(ol1[2], ol1[3]);
                wh.x = cvt_pk_bf16(oh0[0], oh0[1]); wh.y = cvt_pk_bf16(oh0[2], oh0[3]); wh.z = cvt_pk_bf16(oh1[0], oh1[1]); wh.w = cvt_pk_bf16(oh1[2], oh1[3]);
                EPI_STORE16(rowp, wl); EPI_STORE16(rowp + 64, wh); }
        } else {
            const int col0 = pn * BM + wc * 32 + 8 * fq;
            const bool act = pn < 8, stats = pn >= 4 && pn < 8;
#pragma unroll
            for (int ai = 0; ai < 2; ++ai)
#pragma unroll
                for (int m = 0; m < 4; ++m) { const int row = row0 + ai * HALF + m * 16; bf16_t* rowp = O + (size_t)row * ldc + col0;
                    const float rsc = rs.get(u.pm, wr * 64 + fr + ai * HALF + m * 16);
                    float s = 0.f, ss = 0.f;
#pragma unroll
                    for (int bj = 0; bj < 2; ++bj) { f32x4 v0 = acc[ai][bj][m][0] * rsc, v1 = acc[ai][bj][m][1] * rsc;
                        if (act) { f32x2 a = gelu_pk((f32x2){v0[0], v0[1]}), b = gelu_pk((f32x2){v0[2], v0[3]}), c = gelu_pk((f32x2){v1[0], v1[1]}), d = gelu_pk((f32x2){v1[2], v1[3]});
                            v0 = (f32x4){a.x, a.y, b.x, b.y}; v1 = (f32x4){c.x, c.y, d.x, d.y};
                            s += ((v0[0] + v0[1]) + (v0[2] + v0[3])) + ((v1[0] + v1[1]) + (v1[2] + v1[3]));
                            ss += ((v0[0] * v0[0] + v0[1] * v0[1]) + (v0[2] * v0[2] + v0[3] * v0[3])) + ((v1[0] * v1[0] + v1[1] * v1[1]) + (v1[2] * v1[2] + v1[3] * v1[3])); }
                        u32x4 w; w.x = cvt_pk_bf16(v0[0], v0[1]); w.y = cvt_pk_bf16(v0[2], v0[3]); w.z = cvt_pk_bf16(v1[0], v1[1]); w.w = cvt_pk_bf16(v1[2], v1[3]);
                        EPI_STORE16(rowp + bj * HALF, w); }
                    if (stats) { s += __shfl_xor(s, 16); ss += __shfl_xor(ss, 16); s += __shfl_xor(s, 32); ss += __shfl_xor(ss, 32);
                        if (fq == 0) *(f32x2*)(sgup + ((size_t)row * 16 + (pn - 4) * 4 + wc) * 2) = (f32x2){s, ss}; } }
        }
    }
};
struct EpiRelu2 {
    static constexpr bool PERM = true, AFTER_DRAIN = false;
    bf16_t* O; int K2; RowScale rs;
    __device__ __forceinline__ void operator()(const f32x4 (&acc)[2][2][4][2], const Unit& u, int wr, int wc, int fr, int fq) const {
        const int rl0 = wr * 64 + fr;
        bf16_t* base = O + ((size_t)u.pm * (K2 >> 6) + 4 * u.pn + (wc >> 1)) * 16384 + rl0 * 64 + 32 * (wc & 1) + 8 * fq;
#pragma unroll
        for (int ai = 0; ai < 2; ++ai)
#pragma unroll
            for (int m = 0; m < 4; ++m) { const int rl = rl0 + ai * HALF + m * 16;
                const float rsc = rs.get(u.pm, rl);
#pragma unroll
                for (int bj = 0; bj < 2; ++bj) { f32x4 v0 = acc[ai][bj][m][0] * rsc, v1 = acc[ai][bj][m][1] * rsc;
                    v0 = __builtin_elementwise_max(v0, (f32x4){0.f, 0.f, 0.f, 0.f}); v1 = __builtin_elementwise_max(v1, (f32x4){0.f, 0.f, 0.f, 0.f}); v0 = v0 * v0; v1 = v1 * v1;
                    u32x4 w; w.x = cvt_pk_bf16(v0[0], v0[1]); w.y = cvt_pk_bf16(v0[2], v0[3]); w.z = cvt_pk_bf16(v1[0], v1[1]); w.w = cvt_pk_bf16(v1[2], v1[3]);
                    EPI_STORE16(base + 64 * (ai * HALF + m * 16) + 32768 * bj, w); } }
    }
};
struct EpiResB {
    static constexpr bool PERM = true, AFTER_DRAIN = false;
    bf16_t* X; int ldc; float* part;
    __device__ __forceinline__ void operator()(const f32x4 (&acc)[2][2][4][2], const Unit& u, int wr, int wc, int fr, int fq) const {
        const int row0 = u.pm * BM + wr * 64 + fr, col0 = u.pn * BM + wc * 32 + 8 * fq;
        u32x4 nb[2];
        { const bf16_t* rp = X + (size_t)row0 * ldc + col0; nb[0] = *(const u32x4*)(rp); nb[1] = *(const u32x4*)(rp + HALF); }
#pragma unroll
        for (int gi = 0; gi < 8; ++gi) { const int ai = gi >> 2, m = gi & 3;
            const int row = row0 + ai * HALF + m * 16; bf16_t* rowp = X + (size_t)row * ldc + col0;
            u32x4 b[2]; b[0] = nb[0]; b[1] = nb[1];
            if (gi < 7) { const bf16_t* rp = X + (size_t)(row0 + ((gi + 1) >> 2) * HALF + ((gi + 1) & 3) * 16) * ldc + col0; nb[0] = *(const u32x4*)(rp); nb[1] = *(const u32x4*)(rp + HALF); }
            float ss = 0.f;
#pragma unroll
            for (int bj = 0; bj < 2; ++bj) {
                f32x4 v0 = acc[ai][bj][m][0], v1 = acc[ai][bj][m][1];
                v0[0] += __uint_as_float(b[bj].x << 16); v0[1] += __uint_as_float(b[bj].x & 0xffff0000u); v0[2] += __uint_as_float(b[bj].y << 16); v0[3] += __uint_as_float(b[bj].y & 0xffff0000u);
                v1[0] += __uint_as_float(b[bj].z << 16); v1[1] += __uint_as_float(b[bj].z & 0xffff0000u); v1[2] += __uint_as_float(b[bj].w << 16); v1[3] += __uint_as_float(b[bj].w & 0xffff0000u);
                ss += ((v0[0] * v0[0] + v0[1] * v0[1]) + (v0[2] * v0[2] + v0[3] * v0[3])) + ((v1[0] * v1[0] + v1[1] * v1[1]) + (v1[2] * v1[2] + v1[3] * v1[3]));
                u32x4 w; w.x = cvt_pk_bf16(v0[0], v0[1]); w.y = cvt_pk_bf16(v0[2], v0[3]); w.z = cvt_pk_bf16(v1[0], v1[1]); w.w = cvt_pk_bf16(v1[2], v1[3]);
                *(u32x4*)(rowp + bj * HALF) = w; }
            ss += __shfl_xor(ss, 16); ss += __shfl_xor(ss, 32);
            if (fq == 0) part[(size_t)row * 64 + u.pn * 4 + wc] = ss; }
    }
};
struct EpiNone {
    static constexpr bool PERM = true, AFTER_DRAIN = false;
    float* sink;
    __device__ __forceinline__ void operator()(const f32x4 (&acc)[2][2][4][2], const Unit& u, int wr, int wc, int fr, int fq) const {
        f32x4 s = (f32x4){0.f, 0.f, 0.f, 0.f};
#pragma unroll
        for (int ai = 0; ai < 2; ++ai)
#pragma unroll
            for (int bj = 0; bj < 2; ++bj)
#pragma unroll
                for (int m = 0; m < 4; ++m)
#pragma unroll
                    for (int n = 0; n < 2; ++n) s += acc[ai][bj][m][n];
        if (u.pm < 0) sink[threadIdx.x] = (s[0] + s[1]) + (s[2] + s[3]);
    }
};
struct SameTileOrder : StaticOrder {
    __host__ __device__ bool next(int i, Unit& u) const { Unit t; const bool ok = StaticOrder::next(i, t);
#if defined(PROBE_G) && PROBE_G == 4
        u.pm = 0; u.pn = t.pn;
#elif defined(PROBE_G) && PROBE_G == 5
        u.pm = t.pm; u.pn = 0;
#else
        u.pm = 0; u.pn = 0;
#endif
        return ok; }
};
struct BlockOrder {
    int nN, nU, c;
    __host__ __device__ void init(int M, int N, int, int c_) { nN = N / BM; nU = (M / BM) * nN; c = c_; }
    __host__ __device__ int rp0() const { return 4 * ((c & 7) >> 1) + ((c >> 3) & 3); }
    __host__ __device__ bool next(int i, Unit& u) const {
        const int xcd = c & 7, j = c >> 3, L = 256 * i + (8 * (xcd & 1) + (j >> 2)) * 16 + 4 * (xcd >> 1) + (j & 3);
        if (L >= nU) return false;
        const int rb = L / (16 * nN), rem = L - rb * 16 * nN;
        u.pm = 16 * rb + (rem & 15); u.pn = rem >> 4; return true;
    }
    __device__ __forceinline__ void a_ready(const Unit&) const {}
    __device__ __forceinline__ void done(const Unit&) const {}
};
template <int MODE> struct EpiProbe {
    static constexpr bool PERM = true, AFTER_DRAIN = false;
    bf16_t* O; int ldc; RowScale rs;
    __device__ __forceinline__ void operator()(const f32x4 (&acc)[2][2][4][2], const Unit& u, int wr, int wc, int fr, int fq) const {
        const int row0 = u.pm * BM + wr * 64 + fr, col0 = u.pn * BM + wc * 32 + 8 * fq;
        bf16_t* cbase = O + ((size_t)(u.pm * 32 + u.pn) * 8 + (wr * 4 + wc)) * 8192 + (fq * 16 + fr) * 8;
        f32x4 keep = (f32x4){0.f, 0.f, 0.f, 0.f};
#pragma unroll
        for (int ai = 0; ai < 2; ++ai)
#pragma unroll
            for (int m = 0; m < 4; ++m) { bf16_t* rowp = O + (size_t)(row0 + ai * HALF + m * 16) * ldc + col0;
                const float rsc = rs.get(u.pm, wr * 64 + fr + ai * HALF + m * 16);
#pragma unroll
                for (int bj = 0; bj < 2; ++bj) { f32x4 v0 = acc[ai][bj][m][0] * rsc, v1 = acc[ai][bj][m][1] * rsc;
                    v0 = __builtin_elementwise_max(v0, (f32x4){0.f, 0.f, 0.f, 0.f}); v1 = __builtin_elementwise_max(v1, (f32x4){0.f, 0.f, 0.f, 0.f}); v0 = v0 * v0; v1 = v1 * v1;
                    u32x4 w; w.x = cvt_pk_bf16(v0[0], v0[1]); w.y = cvt_pk_bf16(v0[2], v0[3]); w.z = cvt_pk_bf16(v1[0], v1[1]); w.w = cvt_pk_bf16(v1[2], v1[3]);
                    if (MODE == 0) *(u32x4*)(rowp + bj * HALF) = w;
                    else if (MODE == 1) *(u32x4*)(cbase + ((ai * 4 + m) * 2 + bj) * 512) = w;
                    else keep += v0 + v1; } }
        if (MODE == 2 && u.pm < 0) *(f32x4*)(O + threadIdx.x * 8) = keep;
    }
};
template <int W> struct StaticOrderW {
    int nM, nN, nwg, G, c;
    __host__ __device__ void init(int M, int N, int G_, int c_) { nM = M / BM; nN = N / BM; nwg = nM * nN; G = G_; c = c_; }
    __host__ __device__ bool next(int i, Unit& u) const {
        const long L = (long)i * G + c; if (L >= nwg) return false;
        int wgid = (int)L; { const int q = nwg / NXCD, xcd = wgid % NXCD, off = wgid / NXCD; wgid = xcd * q + off; }
        const int nig = W * nN, gid = wgid / nig, fm = gid * W;
        u.pm = fm + ((wgid % nig) % W); u.pn = (wgid % nig) / W; return true;
    }
    __device__ __forceinline__ void a_ready(const Unit&) const {}
    __device__ __forceinline__ void done(const Unit&) const {}
};
template <class Epi, class Sched, bool ALIGN_EPI = false, bool SP2 = false, bool ABLK = false, bool BBLK = false, int AUXA = 0, int AUXB = 0>
__device__ __forceinline__ void gemm_phase(PG8_LAS unsigned char* lds, const Gemm g, const Sched& S, const Epi& E) {
    int tid = hw_tid(lds); asm volatile("" : "+v"(tid));
    const int wid = __builtin_amdgcn_readfirstlane(tid >> 6), lane = tid & 63, wr = wid >> 2, wc = wid & 3, fr = lane & 15, fq = lane >> 4;
    const int K = g.K, nt = K / BK;
    unsigned voffA[2], voffB[2];
#pragma unroll
    for (int i = 0; i < 2; ++i) { int R, C; stage_rc(tid * 16 + i * 8192, R, C); const int Rb = Epi::PERM ? ((R & ~31) + perm32(R & 31)) : R;
        voffA[i] = (unsigned)(R * (ABLK ? 64 : g.lda) + C) * 2u; voffB[i] = (unsigned)(Rb * (BBLK ? 64 : g.ldb) + C) * 2u; }
    const size_t kstepA = ABLK ? 32768 : 128, kstepB = BBLK ? 32768 : 128;
    const size_t hstepA = (size_t)HALF * (ABLK ? 64 : g.lda) * 2, hstepB = (size_t)HALF * (BBLK ? 64 : g.ldb) * 2;
    const size_t tstepA = ABLK ? (size_t)(K / 64) * 32768 : (size_t)256 * g.lda * 2, tstepB = BBLK ? (size_t)(K / 64) * 32768 : (size_t)256 * g.ldb * 2;
    const unsigned ldsw = (unsigned)wid * 1024u;
    const int aoff = lds_byte(wr * 64 + fr, fq * 8), boff = lds_byte(wc * 32 + fr, fq * 8);
#define PG8_SA(b, h) (((b) * 2 + (h)) * HTB)
#define PG8_SB(b, h) ((4 + (b) * 2 + (h)) * HTB)
#define PG8_STAGE_X(bufoff, gbase, voff, AUX) do { _Pragma("unroll") for (int _i = 0; _i < 2; ++_i) \
        __builtin_amdgcn_global_load_lds((const unsigned*)((const char*)(gbase) + (voff)[_i]), (PG8_LAS unsigned*)(lds + (bufoff) + ldsw + _i * 8192), 16, 0, AUX); } while (0)
#define PG8_STAGEA(bufoff, gbase, voff) PG8_STAGE_X(bufoff, gbase, voff, AUXA)
#define PG8_STAGEB(bufoff, gbase, voff) PG8_STAGE_X(bufoff, gbase, voff, AUXB)
#define PG8_LDA(dst, b, h) do { _Pragma("unroll") for (int m = 0; m < 4; ++m) _Pragma("unroll") for (int k = 0; k < 2; ++k) dst[m][k] = *(const PG8_LAS bf16x8*)(lds + PG8_SA(b, h) + aoff + m * 2048 + k * 1024); } while (0)
#define PG8_LDB(dst, b, h) do { _Pragma("unroll") for (int n = 0; n < 2; ++n) _Pragma("unroll") for (int k = 0; k < 2; ++k) dst[n][k] = *(const PG8_LAS bf16x8*)(lds + PG8_SB(b, h) + boff + n * 2048 + k * 1024); } while (0)
#define PG8_STR2(x) #x
#define PG8_STR(x) PG8_STR2(x)
#ifndef GEMM_RELAX
#define GEMM_RELAX 0
#endif
#ifndef GEMM_PRIO_MODE
#define GEMM_PRIO_MODE 0
#endif
#define PG8_MMA(ai, bj, At, Bt) do { if (GEMM_PRIO_MODE == 0) __builtin_amdgcn_s_setprio(1); _Pragma("unroll") for (int m = 0; m < 4; ++m) _Pragma("unroll") for (int n = 0; n < 2; ++n) _Pragma("unroll") for (int k = 0; k < 2; ++k) \
        acc[ai][bj][m][n] = __builtin_amdgcn_mfma_f32_16x16x32_bf16(Bt[n][k], At[m][k], acc[ai][bj][m][n], 0, 0, 0); if (GEMM_PRIO_MODE == 0) __builtin_amdgcn_s_setprio(0); } while (0)
#define PG8_WAIT_V(n) asm volatile("s_waitcnt vmcnt(" #n ")" ::: "memory")
#define PG8_WAIT_VR(n, nr, flag) asm volatile("s_cmp_eq_u32 %0, 0\n\ts_cbranch_scc1 .Lpg8s%=\n\ts_waitcnt vmcnt(" #nr ")\n\ts_branch .Lpg8d%=\n.Lpg8s%=:\n\ts_waitcnt vmcnt(" #n ")\n.Lpg8d%=:" :: "s"(flag) : "memory", "scc")
#define PG8_WAIT_L(n) asm volatile("s_waitcnt lgkmcnt(" #n ")" ::: "memory")
#define PG8_BAR __builtin_amdgcn_s_barrier()
#define PG8_SCHED __builtin_amdgcn_sched_barrier(0)
    Unit cur, nxt; int ui = 0;
    if (!S.next(0, cur)) return;
    if (GEMM_PRIO_MODE == 2 && wr == 1) __builtin_amdgcn_s_setprio(1);
    f32x4 acc[2][2][4][2];
#pragma unroll
    for (int a = 0; a < 2; ++a)
#pragma unroll
        for (int b = 0; b < 2; ++b)
#pragma unroll
            for (int m = 0; m < 4; ++m)
#pragma unroll
                for (int n = 0; n < 2; ++n) acc[a][b][m][n] = (f32x4){0.f, 0.f, 0.f, 0.f};
    bf16x8 At[4][2], B0[2][2], B1[2][2];
    const char* cA = (const char*)g.A + (size_t)cur.pm * tstepA; const char* cB = (const char*)g.Bt + (size_t)cur.pn * tstepB;
    S.a_ready(cur);
    if constexpr (SP2) {
        PG8_STAGEB(PG8_SB(0, 0), cB, voffB); PG8_STAGEB(PG8_SB(0, 1), cB + hstepB, voffB); PG8_STAGEA(PG8_SA(0, 0), cA, voffA); PG8_STAGEA(PG8_SA(0, 1), cA + hstepA, voffA);
        if (wr == 1) PG8_BAR;
        PG8_WAIT_V(2); PG8_BAR;
        PG8_STAGEB(PG8_SB(1, 0), cB + kstepB, voffB); PG8_STAGEA(PG8_SA(1, 0), cA + kstepA, voffA); PG8_STAGEB(PG8_SB(1, 1), cB + hstepB + kstepB, voffB);
        PG8_WAIT_V(6); PG8_BAR;
    } else {
        PG8_STAGEB(PG8_SB(0, 0), cB, voffB); PG8_STAGEA(PG8_SA(0, 0), cA, voffA); PG8_STAGEB(PG8_SB(0, 1), cB + hstepB, voffB); PG8_STAGEA(PG8_SA(0, 1), cA + hstepA, voffA);
        if (wr == 1) PG8_BAR;
        PG8_WAIT_V(4); PG8_BAR;
        PG8_STAGEB(PG8_SB(1, 0), cB + kstepB, voffB); PG8_STAGEA(PG8_SA(1, 0), cA + kstepA, voffA); PG8_STAGEB(PG8_SB(1, 1), cB + hstepB + kstepB, voffB);
        PG8_WAIT_V(6); PG8_BAR;
    }
    for (;;) {
        const bool has_next = S.next(ui + 1, nxt);
        const char* nA = has_next ? (const char*)g.A + (size_t)nxt.pm * tstepA : cA; const char* nB = has_next ? (const char*)g.Bt + (size_t)nxt.pn * tstepB : cB;
        int t0 = 0;
        if constexpr (SP2 && GEMM_RELAX == 1) { if (ui > 0) {
            const char* a1 = cA + kstepA; const char* a2 = cA + 2 * kstepA; const char* b2 = cB + 2 * kstepB; const char* a3 = a2 + kstepA; const char* b3 = b2 + kstepB;
            PG8_LDB(B0, 0, 0); PG8_LDB(B1, 0, 1); PG8_SCHED; PG8_LDA(At, 0, 0); PG8_STAGEA(PG8_SA(1, 1), a1 + hstepA, voffA);
            PG8_WAIT_V(24); PG8_WAIT_L(0); PG8_BAR; PG8_MMA(0, 0, At, B0); PG8_MMA(0, 1, At, B1); PG8_BAR; PG8_SCHED;
            PG8_LDA(At, 0, 1); PG8_STAGEB(PG8_SB(0, 0), b2, voffB); PG8_STAGEB(PG8_SB(0, 1), b2 + hstepB, voffB); PG8_STAGEA(PG8_SA(0, 0), a2, voffA);
            PG8_WAIT_V(24); PG8_WAIT_L(0); PG8_BAR; PG8_MMA(1, 0, At, B0); PG8_MMA(1, 1, At, B1); PG8_BAR; PG8_SCHED;
            PG8_LDB(B0, 1, 0); PG8_LDB(B1, 1, 1); PG8_SCHED; PG8_LDA(At, 1, 0); PG8_STAGEA(PG8_SA(0, 1), a2 + hstepA, voffA);
            PG8_WAIT_V(8); PG8_WAIT_L(0); PG8_BAR; PG8_MMA(0, 0, At, B0); PG8_MMA(0, 1, At, B1); PG8_BAR; PG8_SCHED;
            PG8_LDA(At, 1, 1); PG8_STAGEB(PG8_SB(1, 0), b3, voffB); PG8_STAGEB(PG8_SB(1, 1), b3 + hstepB, voffB); PG8_STAGEA(PG8_SA(1, 0), a3, voffA);
            PG8_WAIT_V(8); PG8_WAIT_L(0); PG8_BAR; PG8_MMA(1, 0, At, B0); PG8_MMA(1, 1, At, B1); PG8_BAR; PG8_SCHED;
            t0 = 2; } }
#if defined(GEMM_LOOP_ALIGN)
        asm volatile(".p2align " PG8_STR(GEMM_LOOP_ALIGN) ::: "memory");
#endif
        for (int t = t0; t < nt; t += 2) {
            const bool last = (t == nt - 2);
            const char* a1 = cA + (size_t)(t + 1) * kstepA;
            const char* a2 = last ? nA : cA + (size_t)(t + 2) * kstepA; const char* b2 = last ? nB : cB + (size_t)(t + 2) * kstepB;
            const char* a3 = a2 + kstepA; const char* b3 = b2 + kstepB;
            if (last && has_next) S.a_ready(nxt);
            if constexpr (SP2) {
            PG8_LDB(B0, 0, 0); PG8_LDB(B1, 0, 1); PG8_SCHED; PG8_LDA(At, 0, 0); PG8_STAGEA(PG8_SA(1, 1), a1 + hstepA, voffA);
#if GEMM_RELAX == 2
            const int relax = __builtin_amdgcn_readfirstlane((t == 0 && ui > 0) ? 1 : 0);
            PG8_WAIT_VR(8, 24, relax); PG8_WAIT_L(0); PG8_BAR; PG8_MMA(0, 0, At, B0); PG8_MMA(0, 1, At, B1); PG8_BAR; PG8_SCHED;
#else
            PG8_WAIT_V(8); PG8_WAIT_L(0); PG8_BAR; PG8_MMA(0, 0, At, B0); PG8_MMA(0, 1, At, B1); PG8_BAR; PG8_SCHED;
#endif
            PG8_LDA(At, 0, 1); PG8_STAGEB(PG8_SB(0, 0), b2, voffB); PG8_STAGEB(PG8_SB(0, 1), b2 + hstepB, voffB); PG8_STAGEA(PG8_SA(0, 0), a2, voffA);
#if GEMM_RELAX == 2
            PG8_WAIT_VR(8, 24, relax); PG8_WAIT_L(0); PG8_BAR; PG8_MMA(1, 0, At, B0); PG8_MMA(1, 1, At, B1); PG8_BAR; PG8_SCHED;
#else
            PG8_WAIT_V(8); PG8_WAIT_L(0); PG8_BAR; PG8_MMA(1, 0, At, B0); PG8_MMA(1, 1, At, B1); PG8_BAR; PG8_SCHED;
#endif
            PG8_LDB(B0, 1, 0); PG8_LDB(B1, 1, 1); PG8_SCHED; PG8_LDA(At, 1, 0); PG8_STAGEA(PG8_SA(0, 1), a2 + hstepA, voffA);
            PG8_WAIT_V(8); PG8_WAIT_L(0); PG8_BAR; PG8_MMA(0, 0, At, B0); PG8_MMA(0, 1, At, B1); PG8_BAR; PG8_SCHED;
            PG8_LDA(At, 1, 1); PG8_STAGEB(PG8_SB(1, 0), b3, voffB); PG8_STAGEB(PG8_SB(1, 1), b3 + hstepB, voffB); PG8_STAGEA(PG8_SA(1, 0), a3, voffA);
            PG8_WAIT_V(8); PG8_WAIT_L(0); PG8_BAR; PG8_MMA(1, 0, At, B0); PG8_MMA(1, 1, At, B1); PG8_BAR; PG8_SCHED;
            } else {
            PG8_LDB(B0, 0, 0); PG8_SCHED; PG8_LDA(At, 0, 0); PG8_STAGEA(PG8_SA(1, 1), a1 + hstepA, voffA);
            PG8_WAIT_L(8); PG8_BAR; PG8_WAIT_L(0); PG8_MMA(0, 0, At, B0); PG8_BAR; PG8_SCHED;
            PG8_LDB(B1, 0, 1); PG8_STAGEB(PG8_SB(0, 0), b2, voffB);
            PG8_BAR; PG8_WAIT_L(0); PG8_MMA(0, 1, At, B1); PG8_BAR;
            PG8_LDA(At, 0, 1); PG8_STAGEA(PG8_SA(0, 0), a2, voffA);
            PG8_BAR; PG8_WAIT_L(0); PG8_MMA(1, 0, At, B0); PG8_BAR; PG8_SCHED;
            PG8_STAGEB(PG8_SB(0, 1), b2 + hstepB, voffB);
            PG8_WAIT_V(6); PG8_BAR; PG8_MMA(1, 1, At, B1); PG8_BAR;
            PG8_LDB(B0, 1, 0); PG8_SCHED; PG8_LDA(At, 1, 0); PG8_STAGEA(PG8_SA(0, 1), a2 + hstepA, voffA);
            PG8_WAIT_L(8); PG8_BAR; PG8_WAIT_L(0); PG8_MMA(0, 0, At, B0); PG8_BAR; PG8_SCHED;
            PG8_LDB(B1, 1, 1); PG8_STAGEB(PG8_SB(1, 0), b3, voffB);
            PG8_BAR; PG8_WAIT_L(0); PG8_MMA(0, 1, At, B1); PG8_BAR;
            PG8_LDA(At, 1, 1); PG8_STAGEA(PG8_SA(1, 0), a3, voffA);
            PG8_BAR; PG8_WAIT_L(0); PG8_MMA(1, 0, At, B0); PG8_BAR; PG8_SCHED;
            PG8_STAGEB(PG8_SB(1, 1), b3 + hstepB, voffB);
            PG8_WAIT_V(6); PG8_BAR; PG8_MMA(1, 1, At, B1); PG8_BAR;
            }
        }
        if constexpr (ALIGN_EPI) { if (wr == 0) PG8_BAR; }
        if constexpr (!Epi::AFTER_DRAIN) { E(acc, cur, wr, wc, fr, fq); S.done(cur); }
        if (!has_next) break;
#pragma unroll
        for (int a = 0; a < 2; ++a)
#pragma unroll
            for (int b = 0; b < 2; ++b)
#pragma unroll
                for (int m = 0; m < 4; ++m)
#pragma unroll
                    for (int n = 0; n < 2; ++n) acc[a][b][m][n] = (f32x4){0.f, 0.f, 0.f, 0.f};
        cur = nxt; cA = nA; cB = nB; ++ui;
        if constexpr (ALIGN_EPI) { if (wr == 1) PG8_BAR; }
    }
    PG8_WAIT_V(0);
    if constexpr (!ALIGN_EPI) { if (wr == 0) PG8_BAR; }
    PG8_BAR;
    if (GEMM_PRIO_MODE == 2) __builtin_amdgcn_s_setprio(0);
    if constexpr (Epi::AFTER_DRAIN) { E.fused(acc, cur, wr, wc, fr, fq, lds, wid, lane); S.done(cur); }
#undef PG8_SA
#undef PG8_SB
#undef PG8_STAGE_X
#undef PG8_STAGEA
#undef PG8_STAGEB
#undef PG8_LDA
#undef PG8_LDB
#undef PG8_MMA
#undef PG8_WAIT_V
#undef PG8_WAIT_VR
#undef PG8_WAIT_L
#undef PG8_BAR
#undef PG8_SCHED
}
}
constexpr int BATCH = 4, SEQ = 4096, DM = 4096, DEPTH = 2, HDIM = 128, CHUNK = 128, NCH = SEQ / CHUNK;
constexpr int M = BATCH * SEQ;
constexpr int DFF = 4 * DM;
#ifndef PITCH_PAD
#define PITCH_PAD 64
#endif
constexpr int LDH = DFF + PITCH_PAD;
constexpr int INW = 9216;
constexpr int C_U = 0, C_V = 1024, C_RQ = 2048, C_RK = 3072, C_RV = 4096, C_RG = 5120, C_AQ = 6144, C_AK = 8192, C_AV = 8704;
constexpr int MIX_A = 0, MIX_R = 1024, MIX_C = 2048;
constexpr int NRH = 8, NQH = 16, NSG = 8;
constexpr float NORM_EPS = 1e-5f;
constexpr float QK_SCALE = 0.08838834764831845f;
constexpr float LOG2E = 1.4426950408889634f;

constexpr size_t MiB = 1u << 20;
constexpr size_t WS_CTL = 0, CTL_ZERO_BYTES = 1 * MiB;
constexpr size_t WS_COS = 1 * MiB, WS_SIN = 2 * MiB;
constexpr size_t WS_WIN = 4 * MiB;
constexpr size_t WS_WOUT = WS_WIN + 144 * MiB;
constexpr size_t WS_WUP = WS_WOUT + 64 * MiB;
constexpr size_t WS_WDN = WS_WUP + 256 * MiB;
constexpr size_t WS_H = WS_WDN + 260 * MiB;
constexpr size_t WS_PROJ = WS_H + 128 * MiB;
constexpr size_t WS_MIX = WS_PROJ + 288 * MiB;
constexpr size_t WS_HID = WS_MIX + 128 * MiB;
constexpr size_t WS_ST = WS_HID;
constexpr size_t WS_RSA = WS_HID + 520 * MiB;
constexpr size_t WS_RSB = WS_RSA + 4 * MiB;
constexpr size_t WS_SGUP = WS_RSB + 4 * MiB;
constexpr size_t WS_END = WS_SGUP + 2 * MiB;
static_assert(WS_END == 1802 * MiB && (size_t)M * LDH * 2 <= 520 * MiB && (size_t)DEPTH * DM * LDH * 2 <= 260 * MiB, "ws map");
constexpr int CW_BAR = 4096;
constexpr int CW_Q = 16384;

constexpr int RSTD_OFF = 131072;
constexpr int RING_BYTES = 139264;
constexpr int LDSCTL_OFF = RING_BYTES, MISC_OFF = LDSCTL_OFF + 320;
constexpr int LDS_BYTES = 147456;
constexpr int NWAVES = 8;

#define GAS __attribute__((address_space(1)))
#define LAS __attribute__((address_space(3)))
typedef unsigned short bf16;
typedef unsigned v4u __attribute__((ext_vector_type(4)));
typedef unsigned v2u __attribute__((ext_vector_type(2)));
typedef float f32x4 __attribute__((ext_vector_type(4)));
typedef short bf16x8 __attribute__((ext_vector_type(8)));
typedef short s16x4 __attribute__((ext_vector_type(4)));
typedef LAS unsigned char* ldsp;
#define LDS_WAIT() asm volatile("s_waitcnt lgkmcnt(0)" ::: "memory")
#define VM_WAIT() asm volatile("s_waitcnt vmcnt(0)" ::: "memory")
using pg8::cvt_pk_bf16; using pg8::hw_tid; using pg8::hw_slot; using pg8::HWTAB_OFF;
__device__ __forceinline__ float bf_lo(unsigned w) { return __uint_as_float(w << 16); }
__device__ __forceinline__ float bf_hi(unsigned w) { return __uint_as_float(w & 0xffff0000u); }

#define XB_TMO      128
#define XB_XCNT(j)  (256  + 64 * (j))
#define XB_XSUB(j)  (1280 + 64 * (j))
#define XB_XGEN(j)  (2304 + 64 * (j))
#define XB_TOP      3328
#define XB_TOPGEN   3392
#define XCD_BAR_WORDS 3456
#define XB_SPIN_CAP (1u << 18)

__device__ __forceinline__ unsigned xb_ld(unsigned* p)              { return __hip_atomic_load(p, __ATOMIC_RELAXED, __HIP_MEMORY_SCOPE_AGENT); }
__device__ __forceinline__ unsigned xb_add(unsigned* p, unsigned v) { return __hip_atomic_fetch_add(p, v, __ATOMIC_RELAXED, __HIP_MEMORY_SCOPE_AGENT); }
__device__ __forceinline__ unsigned xb_xcc_id() { return (unsigned)__builtin_amdgcn_s_getreg((3 << 11) | 20) & 0xFu; }
#define XB_SPIN(cond, bar) do { unsigned _sp = 0; while (cond) { __builtin_amdgcn_s_sleep(1); \
    if ((++_sp & 255u) == 0u) { if (xb_ld(&(bar)[XB_TMO])) break; if (_sp > XB_SPIN_CAP) { atomicAdd(&(bar)[XB_TMO], 1u); break; } } } } while (0)

#define XB_TID0(st_) (hw_tid((__attribute__((address_space(3))) unsigned char*)(st_) - (139264 + 320 + 32)) == 0)
struct XcdBarrier {
    unsigned* bar; unsigned x;
    volatile LAS unsigned* st;
};

__device__ __forceinline__ XcdBarrier xcd_barrier_post(unsigned* bar, volatile LAS unsigned* st) {
    XcdBarrier b; b.bar = bar; b.x = xb_xcc_id(); b.st = st;
    if (XB_TID0(st)) (void)xb_add(&bar[XB_XCNT(b.x)], 1u);
    return b;
}
__device__ __forceinline__ void xcd_barrier_complete(unsigned* bar, unsigned x, unsigned& nloc, unsigned& nx) {
    const unsigned G = gridDim.x * gridDim.y * gridDim.z;
    unsigned sum, cnt, mine, sp = 0u;
    for (;;) {
        sum = 0u; cnt = 0u; mine = 0u;
#pragma unroll
        for (unsigned j = 0; j < 16; ++j) { const unsigned c = xb_ld(&bar[XB_XCNT(j)]); sum += c; cnt += (c > 0u) ? 1u : 0u; mine = (j == x) ? c : mine; }
        if (sum == G) break;
        __builtin_amdgcn_s_sleep(1);
        if ((++sp & 255u) == 0u) { if (xb_ld(&bar[XB_TMO])) break; if (sp > XB_SPIN_CAP) { atomicAdd(&bar[XB_TMO], 1u); break; } }
    }
    nloc = mine > 0u ? mine : 1u; nx = cnt > 0u ? cnt : 1u;
}

__device__ __forceinline__ void xcd_barrier(const XcdBarrier& b) {
    asm volatile("s_waitcnt vmcnt(0)" ::: "memory");
    __syncthreads();
    if (XB_TID0(b.st)) {
        unsigned* bar = b.bar;
        __builtin_amdgcn_s_waitcnt(0);
        unsigned nloc = b.st[0], nx = b.st[1];
        if (nloc == 0u) { xcd_barrier_complete(bar, b.x, nloc, nx); b.st[0] = nloc; b.st[1] = nx; }
        const unsigned old = xb_add(&bar[XB_XSUB(b.x)], 1u);
        const unsigned gen = old / nloc;
        if (old + 1u == (gen + 1u) * nloc) {
            __builtin_amdgcn_fence(__ATOMIC_RELEASE, "agent");
            asm volatile("s_waitcnt vmcnt(0)" ::: "memory");
            const unsigned og = xb_add(&bar[XB_TOP], 1u);
            const unsigned tg = og / nx;
            if (og + 1u == (tg + 1u) * nx) xb_add(&bar[XB_TOPGEN], 1u);
            else XB_SPIN(xb_ld(&bar[XB_TOPGEN]) == tg, bar);
            __builtin_amdgcn_fence(__ATOMIC_ACQUIRE, "agent");
            xb_add(&bar[XB_XGEN(b.x)], 1u);
            asm volatile("s_waitcnt vmcnt(0)" ::: "memory");
        } else {
            XB_SPIN(xb_ld(&bar[XB_XGEN(b.x)]) == gen, bar);
            __builtin_amdgcn_fence(__ATOMIC_ACQUIRE, "agent");
            asm volatile("s_waitcnt vmcnt(0)" ::: "memory");
        }
    }
    __syncthreads();
}
constexpr unsigned TP = 272u, TILE_BYTES = 128u * TP;
__device__ __forceinline__ unsigned offb(unsigned row, unsigned ch) { return TP * row + 16u * ch; }
__device__ __forceinline__ bf16x8 frag_row(ldsp rb, int idx, int ks) { return *(const LAS bf16x8*)(rb + 16u * TP * idx + 64u * ks); }
__device__ __forceinline__ bf16x8 frag_tr(ldsp tb, int idx, int ks) {
    const s16x4 lo = __builtin_bit_cast(s16x4, __builtin_amdgcn_ds_read_tr16_b64_v4i16((LAS s16x4*)(tb + 32u * TP * ks + 32u * idx)));
    const s16x4 hi = __builtin_bit_cast(s16x4, __builtin_amdgcn_ds_read_tr16_b64_v4i16((LAS s16x4*)(tb + 32u * TP * ks + 4u * TP + 32u * idx)));
    return (bf16x8){lo[0], lo[1], lo[2], lo[3], hi[0], hi[1], hi[2], hi[3]};
}
__device__ __forceinline__ ldsp row_base(ldsp T, int lane) { return T + TP * (unsigned)(lane & 15) + 16u * (unsigned)(lane >> 4); }
__device__ __forceinline__ ldsp tr_base(ldsp T, int lane) { return T + TP * (8u * (unsigned)(lane >> 4) + (((unsigned)lane & 15u) >> 2)) + 8u * ((unsigned)lane & 3u); }
#ifndef ATTN_VFIX
#define ATTN_VFIX 1
#endif
constexpr unsigned TPV = 288u;
__device__ __forceinline__ unsigned offb_v(unsigned row, unsigned ch) { return TPV * row + 128u * ((row >> 3) & 1u) + 128u * (row >> 4) + 16u * ch; }
__device__ __forceinline__ ldsp tr_base_v(ldsp T, int lane) { const unsigned fq = (unsigned)lane >> 4; return T + TPV * (8u * fq + (((unsigned)lane & 15u) >> 2)) + 128u * (fq & 1u) + 128u * (fq >> 1) + 8u * ((unsigned)lane & 3u); }
__device__ __forceinline__ bf16x8 frag_tr_v(ldsp tb, int idx, int ks) {
    const s16x4 lo = __builtin_bit_cast(s16x4, __builtin_amdgcn_ds_read_tr16_b64_v4i16((LAS s16x4*)(tb + (32u * TPV + 256u) * ks + 32u * idx)));
    const s16x4 hi = __builtin_bit_cast(s16x4, __builtin_amdgcn_ds_read_tr16_b64_v4i16((LAS s16x4*)(tb + (32u * TPV + 256u) * ks + 4u * TPV + 32u * idx)));
    return (bf16x8){lo[0], lo[1], lo[2], lo[3], hi[0], hi[1], hi[2], hi[3]};
}
#ifndef MM_SETPRIO
#define MM_SETPRIO 1
#endif
#ifndef ATTN_SPRIO_OLD
#define ATTN_SPRIO_OLD 0
#endif
#ifndef ATTN_SPRIO
#define ATTN_SPRIO 0
#endif
#ifndef ATTN_FULL
#define ATTN_FULL 0
#endif
#ifndef ATTN_RG
#define ATTN_RG 0
#endif
#define ATTN_RG_SKIP (ATTN_RG == 1 || ATTN_RG == 2)
#ifndef PAIR_NOSB
#define PAIR_NOSB 0
#endif
#ifndef PAIR_EARLYKV
#define PAIR_EARLYKV 0
#endif
#ifndef SGU_EARLY
#define SGU_EARLY 0
#endif
#ifndef PAIR_QPRE
#define PAIR_QPRE 0
#endif
#ifndef CVT_DEEP
#define CVT_DEEP 0
#endif
#ifndef ATTN_BIAS
#define ATTN_BIAS 1
#endif
#ifndef ATTN_PIPE
#define ATTN_PIPE 1
#endif
#ifndef ATTN_G
#define ATTN_G 8
#endif
#ifndef MM_G
#define MM_G 8
#endif
#ifndef MM_PIPE
#define MM_PIPE 1
#endif
template <int G, int KS0, int NK, int C0, int NC, class FB, class FA>
__device__ __forceinline__ void mm_pipe(f32x4 (&acc)[8], FB fb, FA fa) {
    constexpr int NS = NK * NC, NG = NS / G;
    static_assert(NS % G == 0, "group size must divide the step count");
    bf16x8 b[2][G];
#pragma unroll
    for (int i = 0; i < G; ++i) b[0][i] = fb(C0 + i % NC, KS0 + i / NC);
    if (NG > 1) {
#pragma unroll
        for (int i = 0; i < G; ++i) b[1][i] = fb(C0 + (G + i) % NC, KS0 + (G + i) / NC); }
#pragma unroll
    for (int g = 0; g < NG; ++g) {
        __builtin_amdgcn_sched_barrier(0);
#pragma unroll
        for (int i = 0; i < G; ++i) { const int st = g * G + i, c = C0 + st % NC, ks = KS0 + st / NC;
            acc[c] = __builtin_amdgcn_mfma_f32_16x16x32_bf16(b[g & 1][i], fa(ks), acc[c], 0, 0, 0); }
        __builtin_amdgcn_sched_barrier(0);
        if (g + 2 < NG) {
#pragma unroll
            for (int i = 0; i < G; ++i) { const int st = (g + 2) * G + i; b[g & 1][i] = fb(C0 + st % NC, KS0 + st / NC); } }
    }
}
template <bool A_TR, bool B_TR>
__device__ __forceinline__ void mm128(f32x4 (&acc)[8], ldsp TA, ldsp TB, int w, int lane) {
    const ldsp ab = A_TR ? tr_base(TA, lane) + 32u * w : row_base(TA, lane) + 16u * TP * w;
    const ldsp bb = B_TR ? tr_base(TB, lane) : row_base(TB, lane);
    if (MM_SETPRIO) __builtin_amdgcn_s_setprio(1);
#if MM_PIPE
    bf16x8 a[4];
#pragma unroll
    for (int ks = 0; ks < 4; ++ks) a[ks] = A_TR ? frag_tr(ab, 0, ks) : frag_row(ab, 0, ks);
    mm_pipe<MM_G, 0, 4, 0, 8>(acc, [&](int c, int ks) { return B_TR ? frag_tr(bb, c, ks) : frag_row(bb, c, ks); }, [&](int ks) { return a[ks]; });
#else
#pragma unroll
    for (int ks = 0; ks < 4; ++ks) {
        const bf16x8 a = A_TR ? frag_tr(ab, 0, ks) : frag_row(ab, 0, ks);
#pragma unroll
        for (int c = 0; c < 8; ++c) {
            const bf16x8 b = B_TR ? frag_tr(bb, c, ks) : frag_row(bb, c, ks);
            acc[c] = __builtin_amdgcn_mfma_f32_16x16x32_bf16(b, a, acc[c], 0, 0, 0);
        }
    }
#endif
    if (MM_SETPRIO) __builtin_amdgcn_s_setprio(0);
}
__device__ __forceinline__ void zero8(f32x4 (&a)[8]) {
#pragma unroll
    for (int c = 0; c < 8; ++c) a[c] = (f32x4){0.f, 0.f, 0.f, 0.f};
}
struct TileRegs { v4u v[4]; };
__device__ __forceinline__ void tile_fetch(TileRegs& t, const bf16* src, size_t ld, int tid) {
#pragma unroll
    for (int i = 0; i < 4; ++i) { const int ck = tid + 512 * i, r = ck >> 4, ch = ck & 15; t.v[i] = *(const v4u*)(src + (size_t)r * ld + 8 * ch); }
}
__device__ __forceinline__ void tile_put(ldsp T, const TileRegs& t, int tid) {
#pragma unroll
    for (int i = 0; i < 4; ++i) { const int ck = tid + 512 * i, r = ck >> 4, ch = ck & 15; *(LAS v4u*)(T + offb(r, ch)) = t.v[i]; }
}
__device__ __forceinline__ void tile_put_v(ldsp T, const TileRegs& t, int tid) {
#pragma unroll
    for (int i = 0; i < 4; ++i) { const int ck = tid + 512 * i, r = ck >> 4, ch = ck & 15; *(LAS v4u*)(T + offb_v(r, ch)) = t.v[i]; }
}
__device__ __forceinline__ void tile_put_scaled(ldsp T, const TileRegs& t, float l2, float a0, float a1, int tid) {
#pragma unroll
    for (int i = 0; i < 4; ++i) { const int ck = tid + 512 * i, r = ck >> 4, ch = ck & 15;
        const float sc = __builtin_amdgcn_exp2f(l2 * (a0 + a1 * (float)r));
        v4u o;
#pragma unroll
        for (int k = 0; k < 4; ++k) o[k] = cvt_pk_bf16(bf_lo(t.v[i][k]) * sc, bf_hi(t.v[i][k]) * sc);
        *(LAS v4u*)(T + offb(r, ch)) = o; }
}
__device__ __forceinline__ void tile_put_frag(ldsp T, const TileRegs& t, int tid) {
#pragma unroll
    for (int i = 0; i < 4; ++i) { const int q = tid + 512 * i; *(LAS v4u*)(T + offb(16 * (q >> 8) + (q & 15), (q >> 4) & 15)) = t.v[i]; }
}
__device__ __forceinline__ void load_tile(ldsp T, const bf16* src, size_t ld, int tid) { TileRegs t; tile_fetch(t, src, ld, tid); tile_put(T, t, tid); }
__device__ __forceinline__ void store_acc_tile(ldsp T, const f32x4 (&a)[8], int w, int lane) {
    const unsigned fr = lane & 15, fq = lane >> 4, row = 16u * w + fr;
#pragma unroll
    for (int c = 0; c < 8; ++c) { v2u v; v[0] = cvt_pk_bf16(a[c][0], a[c][1]); v[1] = cvt_pk_bf16(a[c][2], a[c][3]);
        *(LAS v2u*)(T + offb(row, 2u * c + (fq >> 1)) + 8u * (fq & 1)) = v; }
}
__device__ __forceinline__ float wave_sum(float v) {
#pragma unroll
    for (int o = 1; o < 64; o <<= 1) v += __shfl_xor(v, o);
    return v;
}

__host__ __device__ __forceinline__ bool win_rope_tile(int t) { return (t >= 8 && t < 16) || (t >= 24 && t < 34); }
__host__ __device__ __forceinline__ int win_phys_col(int n) { if (!win_rope_tile(n >> 8)) return n; const int cl = n & 255; return (n & ~255) | (cl & 63) | ((cl & 64) << 1) | ((cl & 128) >> 1); }
template <bool PERMUTE, bool BLOCKED = false>
__device__ __forceinline__ void cvt_tile64(const float* W, int K, int N, bf16* WT, int ldo, const float* gk, LAS float* scr, int tile, int lane) {
    const int nblk = N >> 6, kb = tile / nblk, nb = tile - kb * nblk, k0 = 64 * kb, n0 = 64 * nb;
    const int lk = lane >> 4, ln = (lane & 15) * 4;
#if CVT_DEEP
    {
        f32x4 v[16];
#pragma unroll
        for (int i = 0; i < 16; ++i) v[i] = *(const f32x4*)(W + (size_t)(k0 + 4 * i + lk) * N + n0 + ln);
#pragma unroll
        for (int i = 0; i < 16; ++i) { const int kk = 4 * i + lk; const float g = gk ? gk[k0 + kk] : 1.0f; LAS float* d = scr + kk * 65 + ln;
            d[0] = v[i][0] * g; d[1] = v[i][1] * g; d[2] = v[i][2] * g; d[3] = v[i][3] * g; }
    }
#else
#pragma unroll
    for (int hh = 0; hh < 2; ++hh) {
        f32x4 v[8];
#pragma unroll
        for (int i = 0; i < 8; ++i) v[i] = *(const f32x4*)(W + (size_t)(k0 + 32 * hh + 4 * i + lk) * N + n0 + ln);
#pragma unroll
        for (int i = 0; i < 8; ++i) { const int kk = 32 * hh + 4 * i + lk; const float g = gk ? gk[k0 + kk] : 1.0f; LAS float* d = scr + kk * 65 + ln;
            d[0] = v[i][0] * g; d[1] = v[i][1] * g; d[2] = v[i][2] * g; d[3] = v[i][3] * g; }
    }
#endif
    LDS_WAIT(); asm volatile("" ::: "memory");
    const int kc = lane & 7, nrow0 = PERMUTE ? win_phys_col(n0) : n0;
#pragma unroll
    for (int j = 0; j < 8; ++j) { const int n = (lane >> 3) + 8 * j; const LAS float* s = scr + (8 * kc) * 65 + n;
        v4u o; o[0] = cvt_pk_bf16(s[0 * 65], s[1 * 65]); o[1] = cvt_pk_bf16(s[2 * 65], s[3 * 65]); o[2] = cvt_pk_bf16(s[4 * 65], s[5 * 65]); o[3] = cvt_pk_bf16(s[6 * 65], s[7 * 65]);
        *(v4u*)(WT + (BLOCKED ? pg8::blocked_off(nrow0 + n, k0 + 8 * kc, K) : (size_t)(nrow0 + n) * ldo + k0 + 8 * kc)) = o; }
    LDS_WAIT(); asm volatile("" ::: "memory");
}
struct CvtCtx { const float* w_in; const float* w_out; const float* w_up; const float* w_down; const float* g_mix; const float* g_mlp; bf16* WinT; bf16* WoutT; bf16* WupT; bf16* WdnT; };
constexpr int CVT_IN = (DM / 64) * (INW / 64) / 8, CVT_OUT = (DM / 64) * (DM / 64) / 8, CVT_UP = (DM / 64) * (DFF / 64) / 8, CVT_DN = (DFF / 64) * (DM / 64) / 8;
__host__ __device__ constexpr int cvt_batch_items(int batch) { return batch == 0 ? CVT_OUT + CVT_UP + CVT_DN + CVT_IN : CVT_OUT + CVT_UP + CVT_DN; }
__device__ __forceinline__ void cvt_item(const CvtCtx& c, int batch, int wi, LAS float* scr, int wave, int lane) {
    const int l = batch;
    if (wi < CVT_OUT) { cvt_tile64<false>(c.w_out + (size_t)l * DM * DM, DM, DM, c.WoutT + (size_t)l * DM * DM, DM, nullptr, scr, 8 * wi + wave, lane); return; } wi -= CVT_OUT;
    if (wi < CVT_UP) { cvt_tile64<false>(c.w_up + (size_t)l * DM * DFF, DM, DFF, c.WupT + (size_t)l * DFF * DM, DM, c.g_mlp + l * DM, scr, 8 * wi + wave, lane); return; } wi -= CVT_UP;
    if (wi < CVT_DN) { cvt_tile64<false, true>(c.w_down + (size_t)l * DFF * DM, DFF, DM, c.WdnT + (size_t)l * DM * DFF, 0, nullptr, scr, 8 * wi + wave, lane); return; } wi -= CVT_DN;
    cvt_tile64<true>(c.w_in + (size_t)1 * DM * INW, DM, INW, c.WinT + (size_t)1 * INW * DM, DM, c.g_mix + 1 * DM, scr, 8 * wi + wave, lane);
}
struct KArgs { const float* in[14]; float* out; unsigned char* ws; int ph_lo, ph_hi; };
__device__ __forceinline__ void cvt_step(int batch, int& ci, int nmax, ldsp lds, int tid, int hi = 1 << 30) {
    const int total = cvt_batch_items(batch) < hi ? cvt_batch_items(batch) : hi;
    if (nmax <= 0 || ci >= total) return;
    const int lane = tid & 63, wave = __builtin_amdgcn_readfirstlane(tid >> 6);
    LAS float* scr = (LAS float*)(lds + wave * 16640);
    const __attribute__((address_space(4))) KArgs* ka = (const __attribute__((address_space(4))) KArgs*)__builtin_amdgcn_kernarg_segment_ptr();
    asm volatile("" : "+s"(ka));
    unsigned char* ws = ka->ws;
    const CvtCtx c{ka->in[2], ka->in[9], ka->in[11], ka->in[12], ka->in[1], ka->in[10], (bf16*)(ws + WS_WIN), (bf16*)(ws + WS_WOUT), (bf16*)(ws + WS_WUP), (bf16*)(ws + WS_WDN)};
    __syncthreads();
    for (int r = 0; r < nmax && ci < total; ++r, ci += 256) cvt_item(c, batch, ci, scr, wave, lane);
    __syncthreads();
}

#ifndef ATTN_XCDQ
#define ATTN_XCDQ 0
#endif
__device__ __forceinline__ int attn_next(unsigned* qx, int& cq, int& tries) {
    for (;;) {
        if (tries >= 8) return 1 << 30;
        const unsigned k = __hip_atomic_fetch_add(qx + 64 * cq, 1u, __ATOMIC_RELAXED, __HIP_MEMORY_SCOPE_AGENT);
        if (k < 256u) return cq * 256 + (int)k;
        cq = (cq + 1) & 7; ++tries;
    }
}
struct AttnItem { int hq, n, b, kh, jb0, jb1; size_t row0; };
__device__ __forceinline__ AttnItem attn_decode(int unit) {
    AttnItem a; a.hq = unit & 15; a.n = (unit >> 4) & 31; a.b = unit >> 9; a.kh = a.hq >> 2;
    a.jb0 = a.n > 0 ? a.n - 1 : 0; a.jb1 = a.n < NCH - 1 ? a.n + 1 : NCH - 1; a.row0 = (size_t)a.b * SEQ + (size_t)a.n * CHUNK; return a;
}
template <int VAR = 0>
__device__ __forceinline__ void attn_queue(ldsp lds, const bf16* proj, bf16* mix, const float* sink, unsigned* qw, volatile LAS int* qslot, int nitems, int tid, int batch, int& ci, int cvt_per_item) {
    const int lane = tid & 63, w = __builtin_amdgcn_readfirstlane(tid >> 6), fr = lane & 15, fq = lane >> 4;
    const ldsp TK = lds, TV = ATTN_VFIX ? lds + 2 * TILE_BYTES : lds + TILE_BYTES, TPp = ATTN_VFIX ? lds + TILE_BYTES : lds + 2 * TILE_BYTES;
    const int rg = ATTN_RG ? (w < 4 ? w : 11 - w) : w;
    const int i = 16 * rg + fr;
    const ldsp kb = row_base(TK, lane), pb = row_base(TPp, lane) + 16u * TP * w, vb = ATTN_VFIX ? tr_base_v(TV, lane) : tr_base(TV, lane);
    if (ATTN_SPRIO) { if ((ATTN_SPRIO_OLD ? w < 4 : w >= 4)) __builtin_amdgcn_s_setprio(ATTN_SPRIO); else __builtin_amdgcn_s_setprio(0); }
    int cq = (int)(xb_xcc_id() & 7u), tries = 0;
    __syncthreads();
    if (tid == 0) *qslot = ATTN_XCDQ ? attn_next(qw, cq, tries) : (int)__hip_atomic_fetch_add(qw, 1u, __ATOMIC_RELAXED, __HIP_MEMORY_SCOPE_AGENT);
    __syncthreads();
    int item = *qslot;
    bf16x8 qf[4]; TileRegs rk, rv;
    if (item < nitems) { const AttnItem a = attn_decode(item);
        const bf16* qrow = proj + (a.row0 + i) * INW + C_AQ + a.hq * HDIM + 8 * fq;
#pragma unroll
        for (int ks = 0; ks < 4; ++ks) qf[ks] = *(const bf16x8*)(qrow + 32 * ks);
        const bf16* kv0 = proj + ((size_t)a.b * SEQ + (size_t)a.jb0 * CHUNK) * INW + a.kh * HDIM; tile_fetch(rk, kv0 + C_AK, INW, tid); tile_fetch(rv, kv0 + C_AV, INW, tid); }
    while (item < nitems) {
        const AttnItem a = attn_decode(item);
        int nxt = 0; if (tid == 0) nxt = ATTN_XCDQ ? attn_next(qw, cq, tries) : (int)__hip_atomic_fetch_add(qw, 1u, __ATOMIC_RELAXED, __HIP_MEMORY_SCOPE_AGENT);
        float mrun = sink[a.hq] * LOG2E, lrun = 1.0f;
        f32x4 O[8]; zero8(O);
        int item_next = nitems;
        for (int jb = a.jb0; jb <= a.jb1; ++jb) {
            __syncthreads();
            if (VAR != 4) { tile_put(TK, rk, tid); if (ATTN_VFIX) tile_put_v(TV, rv, tid); else tile_put(TV, rv, tid); }
            if (jb == a.jb1) item_next = *qslot;
            __syncthreads();
            if (VAR != 3 && jb < a.jb1) { const bf16* kv1 = proj + ((size_t)a.b * SEQ + (size_t)(jb + 1) * CHUNK) * INW + a.kh * HDIM; tile_fetch(rk, kv1 + C_AK, INW, tid); tile_fetch(rv, kv1 + C_AV, INW, tid); }
            const int rel = jb - a.n;
            const bool h0 = ATTN_FULL ? true : (rel <= 0 ? (rel == 0 || rg <= 3) : true), h1 = ATTN_FULL ? true : (rel >= 0 ? (rel == 0 || rg >= 4) : true);
            f32x4 S[8];
#if ATTN_BIAS
            { int d0 = i - 4 * fq; asm volatile("" : "+v"(d0));
              if (rel == 0) zero8(S);
              else if (rel < 0) {
#pragma unroll
                  for (int c = 0; c < 8; ++c)
#pragma unroll
                      for (int j = 0; j < 4; ++j) S[c][j] = (16 * c + j >= d0) ? 0.f : -1e30f;
              } else {
#pragma unroll
                  for (int c = 0; c < 8; ++c)
#pragma unroll
                      for (int j = 0; j < 4; ++j) S[c][j] = (16 * c + j <= d0) ? 0.f : -1e30f; } }
#else
            zero8(S);
#endif
#if ATTN_PIPE
            { auto fk = [&](int c, int ks) { return frag_row(kb, c, ks); }; auto fqq = [&](int ks) { return qf[ks]; };
              if (h0 && h1) mm_pipe<ATTN_G, 0, 4, 0, 8>(S, fk, fqq); else if (h0) mm_pipe<ATTN_G, 0, 4, 0, 4>(S, fk, fqq); else mm_pipe<ATTN_G, 0, 4, 4, 4>(S, fk, fqq); }
#elif ATTN_RG_SKIP
#if ATTN_RG == 2
#pragma unroll
            for (int qd = 0; qd < 4; ++qd) {
                if (rel == 0 || (rel < 0 ? 2 * qd + 1 >= rg : 2 * qd <= rg)) {
#pragma unroll
                    for (int ks = 0; ks < 4; ++ks) {
                        S[2 * qd] = __builtin_amdgcn_mfma_f32_16x16x32_bf16(frag_row(kb, 2 * qd, ks), qf[ks], S[2 * qd], 0, 0, 0);
                        S[2 * qd + 1] = __builtin_amdgcn_mfma_f32_16x16x32_bf16(frag_row(kb, 2 * qd + 1, ks), qf[ks], S[2 * qd + 1], 0, 0, 0); } } }
#else
#pragma unroll
            for (int c = 0; c < 8; ++c) {
                if (rel == 0 || (rel < 0 ? c >= rg : c <= rg)) {
#pragma unroll
                    for (int ks = 0; ks < 4; ++ks) S[c] = __builtin_amdgcn_mfma_f32_16x16x32_bf16(frag_row(kb, c, ks), qf[ks], S[c], 0, 0, 0); } }
#endif
#else
            if (VAR != 2 && h0) {
#pragma unroll
                for (int ks = 0; ks < 4; ++ks)
#pragma unroll
                    for (int c = 0; c < 4; ++c) S[c] = __builtin_amdgcn_mfma_f32_16x16x32_bf16(frag_row(kb, c, ks), qf[ks], S[c], 0, 0, 0); }
            if (VAR != 2 && h1) {
#pragma unroll
                for (int ks = 0; ks < 4; ++ks)
#pragma unroll
                    for (int c = 4; c < 8; ++c) S[c] = __builtin_amdgcn_mfma_f32_16x16x32_bf16(frag_row(kb, c, ks), qf[ks], S[c], 0, 0, 0); }
#endif
            if (jb == a.jb0 && tid == 0) *qslot = nxt;
            if (VAR != 3 && jb == a.jb1 && item_next < nitems) {
                const AttnItem an = attn_decode(item_next);
                const bf16* qrow = proj + (an.row0 + i) * INW + C_AQ + an.hq * HDIM + 8 * fq;
#pragma unroll
                for (int ks = 0; ks < 4; ++ks) qf[ks] = *(const bf16x8*)(qrow + 32 * ks);
                const bf16* kv0 = proj + ((size_t)an.b * SEQ + (size_t)an.jb0 * CHUNK) * INW + an.kh * HDIM; tile_fetch(rk, kv0 + C_AK, INW, tid); tile_fetch(rv, kv0 + C_AV, INW, tid); }
            if (VAR == 1) { lrun += S[0][0]; } else {
#if ATTN_BIAS && ATTN_RG_SKIP
            float mx = -1e30f;
#pragma unroll
            for (int c = 0; c < 8; ++c) mx = fmaxf(fmaxf(mx, fmaxf(S[c][0], S[c][1])), fmaxf(S[c][2], S[c][3]));
            mx = fmaxf(mx, __shfl_xor(mx, 16)); mx = fmaxf(mx, __shfl_xor(mx, 32));
            const float mnew = fmaxf(mrun, mx), alpha = __builtin_amdgcn_exp2f(mrun - mnew);
            float rs = 0.f;
#if ATTN_RG == 2
#pragma unroll
            for (int qd = 0; qd < 4; ++qd) {
                if (rel == 0 || (rel < 0 ? 2 * qd + 1 >= rg : 2 * qd <= rg)) {
#pragma unroll
                    for (int c = 2 * qd; c < 2 * qd + 2; ++c)
#pragma unroll
                        for (int j = 0; j < 4; ++j) { const float p = __builtin_amdgcn_exp2f(S[c][j] - mnew); S[c][j] = p; rs += p; }
                } else { S[2 * qd] = (f32x4){0.f, 0.f, 0.f, 0.f}; S[2 * qd + 1] = (f32x4){0.f, 0.f, 0.f, 0.f}; } }
#else
#pragma unroll
            for (int c = 0; c < 8; ++c) {
                if (rel == 0 || (rel < 0 ? c >= rg : c <= rg)) {
#pragma unroll
                    for (int j = 0; j < 4; ++j) { const float p = __builtin_amdgcn_exp2f(S[c][j] - mnew); S[c][j] = p; rs += p; }
                } else S[c] = (f32x4){0.f, 0.f, 0.f, 0.f}; }
#endif
#elif ATTN_BIAS
            float mx = -1e30f;
            if (h0) {
#pragma unroll
                for (int c = 0; c < 4; ++c) mx = fmaxf(fmaxf(mx, fmaxf(S[c][0], S[c][1])), fmaxf(S[c][2], S[c][3])); }
            if (h1) {
#pragma unroll
                for (int c = 4; c < 8; ++c) mx = fmaxf(fmaxf(mx, fmaxf(S[c][0], S[c][1])), fmaxf(S[c][2], S[c][3])); }
            mx = fmaxf(mx, __shfl_xor(mx, 16)); mx = fmaxf(mx, __shfl_xor(mx, 32));
            const float mnew = fmaxf(mrun, mx), alpha = __builtin_amdgcn_exp2f(mrun - mnew);
            float rs = 0.f;
            if (h0) {
#pragma unroll
                for (int c = 0; c < 4; ++c)
#pragma unroll
                    for (int j = 0; j < 4; ++j) { const float p = __builtin_amdgcn_exp2f(S[c][j] - mnew); S[c][j] = p; rs += p; }
            } else {
#pragma unroll
                for (int c = 0; c < 4; ++c) S[c] = (f32x4){0.f, 0.f, 0.f, 0.f}; }
            if (h1) {
#pragma unroll
                for (int c = 4; c < 8; ++c)
#pragma unroll
                    for (int j = 0; j < 4; ++j) { const float p = __builtin_amdgcn_exp2f(S[c][j] - mnew); S[c][j] = p; rs += p; }
            } else {
#pragma unroll
                for (int c = 4; c < 8; ++c) S[c] = (f32x4){0.f, 0.f, 0.f, 0.f}; }
#else
            float mx = -1e30f;
#pragma unroll
            for (int c = 0; c < 8; ++c) {
                if (rel != 0 && c == w) {
#pragma unroll
                    for (int j = 0; j < 4; ++j) { const int col = 16 * c + 4 * fq + j; const bool valid = rel < 0 ? (col >= i) : (col <= i);
                        const float s = valid ? S[c][j] : -1e30f; S[c][j] = s; mx = fmaxf(mx, s); }
                } else if (rel == 0 || (rel < 0 ? c > w : c < w)) {
                    mx = fmaxf(fmaxf(mx, fmaxf(S[c][0], S[c][1])), fmaxf(S[c][2], S[c][3])); } }
            mx = fmaxf(mx, __shfl_xor(mx, 16)); mx = fmaxf(mx, __shfl_xor(mx, 32));
            const float mnew = fmaxf(mrun, mx), alpha = __builtin_amdgcn_exp2f(mrun - mnew);
            float rs = 0.f;
#pragma unroll
            for (int c = 0; c < 8; ++c) {
                if (rel == 0 || (rel < 0 ? c >= w : c <= w)) {
#pragma unroll
                    for (int j = 0; j < 4; ++j) { const float p = __builtin_amdgcn_exp2f(S[c][j] - mnew); S[c][j] = p; rs += p; }
                } else S[c] = (f32x4){0.f, 0.f, 0.f, 0.f}; }
#endif
            rs += __shfl_xor(rs, 16); rs += __shfl_xor(rs, 32);
            lrun = lrun * alpha + rs; mrun = mnew;
#pragma unroll
            for (int c = 0; c < 8; ++c) O[c] = O[c] * alpha;
            }
            store_acc_tile(TPp, S, w, lane);
            LDS_WAIT();
#if ATTN_PIPE
            { bf16x8 pa[4]; auto fv = [&](int c, int ks) { return ATTN_VFIX ? frag_tr_v(vb, c, ks) : frag_tr(vb, c, ks); }; auto fp = [&](int ks) { return pa[ks]; };
              if (h0 && h1) {
#pragma unroll
                  for (int ks = 0; ks < 4; ++ks) pa[ks] = frag_row(pb, 0, ks);
                  mm_pipe<ATTN_G, 0, 4, 0, 8>(O, fv, fp);
              } else if (h0) { pa[0] = frag_row(pb, 0, 0); pa[1] = frag_row(pb, 0, 1); mm_pipe<ATTN_G, 0, 2, 0, 8>(O, fv, fp);
              } else { pa[2] = frag_row(pb, 0, 2); pa[3] = frag_row(pb, 0, 3); mm_pipe<ATTN_G, 2, 2, 0, 8>(O, fv, fp); } }
#elif ATTN_RG_SKIP
#pragma unroll
            for (int ks = 0; ks < 4; ++ks) {
                if (rel == 0 || (rel < 0 ? 2 * ks + 1 >= rg : 2 * ks <= rg)) { const bf16x8 pa = frag_row(pb, 0, ks);
#pragma unroll
                    for (int c = 0; c < 8; ++c) O[c] = __builtin_amdgcn_mfma_f32_16x16x32_bf16(ATTN_VFIX ? frag_tr_v(vb, c, ks) : frag_tr(vb, c, ks), pa, O[c], 0, 0, 0); } }
#else
            if (VAR != 2 && h0) {
#pragma unroll
                for (int ks = 0; ks < 2; ++ks) { const bf16x8 pa = frag_row(pb, 0, ks);
#pragma unroll
                    for (int c = 0; c < 8; ++c) O[c] = __builtin_amdgcn_mfma_f32_16x16x32_bf16(ATTN_VFIX ? frag_tr_v(vb, c, ks) : frag_tr(vb, c, ks), pa, O[c], 0, 0, 0); } }
            if (VAR != 2 && h1) {
#pragma unroll
                for (int ks = 2; ks < 4; ++ks) { const bf16x8 pa = frag_row(pb, 0, ks);
#pragma unroll
                    for (int c = 0; c < 8; ++c) O[c] = __builtin_amdgcn_mfma_f32_16x16x32_bf16(ATTN_VFIX ? frag_tr_v(vb, c, ks) : frag_tr(vb, c, ks), pa, O[c], 0, 0, 0); } }
#endif
        }
        const float inv = 1.0f / lrun;
#pragma unroll
        for (int c = 0; c < 8; ++c) O[c] = O[c] * inv;
        store_acc_tile(TPp, O, w, lane);
        LDS_WAIT();
        bf16* obase = mix + (a.row0 + 16 * rg) * DM + MIX_C + a.hq * HDIM;
#pragma unroll
        for (int k = 0; k < 4; ++k) { const int q = lane + 64 * k, r = q >> 4, ch = q & 15;
            *(v4u*)(obase + (size_t)r * DM + 8 * ch) = *(const LAS v4u*)(TPp + offb(16 * w + r, ch)); }
        item = item_next;
        cvt_step(batch, ci, cvt_per_item, lds, tid);
    }
    if (ATTN_SPRIO) __builtin_amdgcn_s_setprio(0);
}

#ifndef ATTN_PAIR
#define ATTN_PAIR 0
#endif
__device__ __forceinline__ void attn_bias_init(f32x4 (&S)[8], int rel, int d0) {
    if (rel == 0) zero8(S);
    else if (rel < 0) {
#pragma unroll
        for (int c = 0; c < 8; ++c)
#pragma unroll
            for (int j = 0; j < 4; ++j) S[c][j] = (16 * c + j >= d0) ? 0.f : -1e30f;
    } else {
#pragma unroll
        for (int c = 0; c < 8; ++c)
#pragma unroll
            for (int j = 0; j < 4; ++j) S[c][j] = (16 * c + j <= d0) ? 0.f : -1e30f; }
}
__device__ __forceinline__ void attn_softmax_bias(f32x4 (&S)[8], float& mrun, float& lrun, f32x4 (&O)[8], bool h0, bool h1) {
    float mx = -1e30f;
    if (h0) {
#pragma unroll
        for (int c = 0; c < 4; ++c) mx = fmaxf(fmaxf(mx, fmaxf(S[c][0], S[c][1])), fmaxf(S[c][2], S[c][3])); }
    if (h1) {
#pragma unroll
        for (int c = 4; c < 8; ++c) mx = fmaxf(fmaxf(mx, fmaxf(S[c][0], S[c][1])), fmaxf(S[c][2], S[c][3])); }
    mx = fmaxf(mx, __shfl_xor(mx, 16)); mx = fmaxf(mx, __shfl_xor(mx, 32));
    const float mnew = fmaxf(mrun, mx), alpha = __builtin_amdgcn_exp2f(mrun - mnew);
    float rs = 0.f;
    if (h0) {
#pragma unroll
        for (int c = 0; c < 4; ++c)
#pragma unroll
            for (int j = 0; j < 4; ++j) { const float pp = __builtin_amdgcn_exp2f(S[c][j] - mnew); S[c][j] = pp; rs += pp; }
    } else {
#pragma unroll
        for (int c = 0; c < 4; ++c) S[c] = (f32x4){0.f, 0.f, 0.f, 0.f}; }
    if (h1) {
#pragma unroll
        for (int c = 4; c < 8; ++c)
#pragma unroll
            for (int j = 0; j < 4; ++j) { const float pp = __builtin_amdgcn_exp2f(S[c][j] - mnew); S[c][j] = pp; rs += pp; }
    } else {
#pragma unroll
        for (int c = 4; c < 8; ++c) S[c] = (f32x4){0.f, 0.f, 0.f, 0.f}; }
    rs += __shfl_xor(rs, 16); rs += __shfl_xor(rs, 32);
    lrun = lrun * alpha + rs; mrun = mnew;
#pragma unroll
    for (int c = 0; c < 8; ++c) O[c] = O[c] * alpha;
}
__device__ __forceinline__ void attn_softmax_block(f32x4 (&S)[8], float& mrun, float& lrun, f32x4 (&O)[8], int rel, int w, int i, int fq) {
    float mx = -1e30f;
#pragma unroll
    for (int c = 0; c < 8; ++c) {
        if (rel != 0 && c == w) {
#pragma unroll
            for (int j = 0; j < 4; ++j) { const int col = 16 * c + 4 * fq + j; const bool valid = rel < 0 ? (col >= i) : (col <= i);
                const float s = valid ? S[c][j] : -1e30f; S[c][j] = s; mx = fmaxf(mx, s); }
        } else if (rel == 0 || (rel < 0 ? c > w : c < w)) {
            mx = fmaxf(fmaxf(mx, fmaxf(S[c][0], S[c][1])), fmaxf(S[c][2], S[c][3])); } }
    mx = fmaxf(mx, __shfl_xor(mx, 16)); mx = fmaxf(mx, __shfl_xor(mx, 32));
    const float mnew = fmaxf(mrun, mx), alpha = __builtin_amdgcn_exp2f(mrun - mnew);
    float rs = 0.f;
#pragma unroll
    for (int c = 0; c < 8; ++c) {
        if (rel == 0 || (rel < 0 ? c >= w : c <= w)) {
#pragma unroll
            for (int j = 0; j < 4; ++j) { const float pp = __builtin_amdgcn_exp2f(S[c][j] - mnew); S[c][j] = pp; rs += pp; }
        } else S[c] = (f32x4){0.f, 0.f, 0.f, 0.f}; }
    rs += __shfl_xor(rs, 16); rs += __shfl_xor(rs, 32);
    lrun = lrun * alpha + rs; mrun = mnew;
#pragma unroll
    for (int c = 0; c < 8; ++c) O[c] = O[c] * alpha;
}
struct AttnPItem { int hq0, n, b, kh, jb0, jb1; size_t row0; };
__device__ __forceinline__ AttnPItem attn_pdecode(int unit) {
    AttnPItem a; a.kh = (unit >> 1) & 3; a.hq0 = 4 * a.kh + 2 * (unit & 1); a.n = (unit >> 3) & 31; a.b = unit >> 8;
    a.jb0 = a.n > 0 ? a.n - 1 : 0; a.jb1 = a.n < NCH - 1 ? a.n + 1 : NCH - 1; a.row0 = (size_t)a.b * SEQ + (size_t)a.n * CHUNK; return a;
}
__device__ __forceinline__ void attn_pair_queue(ldsp lds, const bf16* proj, bf16* mix, const float* sink, unsigned* qw, volatile LAS int* qslot, int nitems, int tid0) {
    const ldsp TK = lds, TV = lds + TILE_BYTES, TPa = lds + 2 * TILE_BYTES, TPb = lds + 3 * TILE_BYTES;
    int tid = tid0;
    int lane = tid & 63, w = __builtin_amdgcn_readfirstlane(tid >> 6), fr = lane & 15, fq = lane >> 4, i = 16 * w + fr;
    __syncthreads();
    if (tid == 0) *qslot = (int)__hip_atomic_fetch_add(qw, 1u, __ATOMIC_RELAXED, __HIP_MEMORY_SCOPE_AGENT);
    __syncthreads();
    int item = *qslot;
    bf16x8 qfA[4], qfB[4]; TileRegs rk, rv;
    if (item < nitems) { const AttnPItem a = attn_pdecode(item);
        const bf16* qrow = proj + (a.row0 + i) * INW + C_AQ + a.hq0 * HDIM + 8 * fq;
#pragma unroll
        for (int ks = 0; ks < 4; ++ks) { qfA[ks] = *(const bf16x8*)(qrow + 32 * ks); qfB[ks] = *(const bf16x8*)(qrow + HDIM + 32 * ks); }
        const bf16* kv0 = proj + ((size_t)a.b * SEQ + (size_t)a.jb0 * CHUNK) * INW + a.kh * HDIM; tile_fetch(rk, kv0 + C_AK, INW, tid); tile_fetch(rv, kv0 + C_AV, INW, tid); }
    while (item < nitems) {
        asm volatile("" : "+v"(tid));
        lane = tid & 63; w = __builtin_amdgcn_readfirstlane(tid >> 6); fr = lane & 15; fq = lane >> 4; i = 16 * w + fr;
        const AttnPItem a = attn_pdecode(item);
#if !PAIR_QPRE
        { const bf16* qrow = proj + (a.row0 + i) * INW + C_AQ + a.hq0 * HDIM + 8 * fq;
#pragma unroll
          for (int ks = 0; ks < 4; ++ks) { qfA[ks] = *(const bf16x8*)(qrow + 32 * ks); qfB[ks] = *(const bf16x8*)(qrow + HDIM + 32 * ks); } }
#endif
        int nxt = 0; if (tid == 0) nxt = (int)__hip_atomic_fetch_add(qw, 1u, __ATOMIC_RELAXED, __HIP_MEMORY_SCOPE_AGENT);
        float mA = sink[a.hq0] * LOG2E, lA = 1.0f, mB = sink[a.hq0 + 1] * LOG2E, lB = 1.0f;
        f32x4 OA[8], OB[8]; zero8(OA); zero8(OB);
        int item_next = nitems;
        for (int jb = a.jb0; jb <= a.jb1; ++jb) {
            asm volatile("" : "+v"(tid));
            lane = tid & 63; w = __builtin_amdgcn_readfirstlane(tid >> 6); fr = lane & 15; fq = lane >> 4; i = 16 * w + fr;
            const ldsp kb = row_base(TK, lane), vb = tr_base(TV, lane), pba = row_base(TPa, lane) + 16u * TP * w, pbb = row_base(TPb, lane) + 16u * TP * w;
            __syncthreads();
            tile_put(TK, rk, tid); tile_put(TV, rv, tid);
            if (jb == a.jb1) item_next = *qslot;
            __syncthreads();
#if PAIR_EARLYKV
            if (jb < a.jb1) { const bf16* kv1 = proj + ((size_t)a.b * SEQ + (size_t)(jb + 1) * CHUNK) * INW + a.kh * HDIM; tile_fetch(rk, kv1 + C_AK, INW, tid); tile_fetch(rv, kv1 + C_AV, INW, tid); }
            else if (item_next < nitems) { const AttnPItem an = attn_pdecode(item_next);
                const bf16* kv0 = proj + ((size_t)an.b * SEQ + (size_t)an.jb0 * CHUNK) * INW + an.kh * HDIM; tile_fetch(rk, kv0 + C_AK, INW, tid); tile_fetch(rv, kv0 + C_AV, INW, tid); }
#endif
            const int rel = jb - a.n;
            const bool h0 = rel <= 0 ? (rel == 0 || w <= 3) : true, h1 = rel >= 0 ? (rel == 0 || w >= 4) : true;
            {
                f32x4 S[8]; if (ATTN_BIAS) { int d0 = i - 4 * fq; asm volatile("" : "+v"(d0)); attn_bias_init(S, rel, d0); } else zero8(S);
                if (h0) {
#pragma unroll
                    for (int ks = 0; ks < 4; ++ks) {
#pragma unroll
                        for (int c = 0; c < 4; ++c) S[c] = __builtin_amdgcn_mfma_f32_16x16x32_bf16(frag_row(kb, c, ks), qfA[ks], S[c], 0, 0, 0);
                        __builtin_amdgcn_sched_barrier(0); } }
                if (h1) {
#pragma unroll
                    for (int ks = 0; ks < 4; ++ks) {
#pragma unroll
                        for (int c = 4; c < 8; ++c) S[c] = __builtin_amdgcn_mfma_f32_16x16x32_bf16(frag_row(kb, c, ks), qfA[ks], S[c], 0, 0, 0);
                        __builtin_amdgcn_sched_barrier(0); } }
                if (jb == a.jb0 && tid == 0) *qslot = nxt;
                if (ATTN_BIAS) attn_softmax_bias(S, mA, lA, OA, h0, h1); else attn_softmax_block(S, mA, lA, OA, rel, w, i, fq);
                store_acc_tile(TPa, S, w, lane); }
            if (!PAIR_NOSB) __builtin_amdgcn_sched_barrier(0);
            {
                f32x4 S[8]; if (ATTN_BIAS) { int d0 = i - 4 * fq; asm volatile("" : "+v"(d0)); attn_bias_init(S, rel, d0); } else zero8(S);
                if (h0) {
#pragma unroll
                    for (int ks = 0; ks < 4; ++ks) {
#pragma unroll
                        for (int c = 0; c < 4; ++c) S[c] = __builtin_amdgcn_mfma_f32_16x16x32_bf16(frag_row(kb, c, ks), qfB[ks], S[c], 0, 0, 0);
                        __builtin_amdgcn_sched_barrier(0); } }
                if (h1) {
#pragma unroll
                    for (int ks = 0; ks < 4; ++ks) {
#pragma unroll
                        for (int c = 4; c < 8; ++c) S[c] = __builtin_amdgcn_mfma_f32_16x16x32_bf16(frag_row(kb, c, ks), qfB[ks], S[c], 0, 0, 0);
                        __builtin_amdgcn_sched_barrier(0); } }
                asm volatile("" ::: "memory");
                if (ATTN_BIAS) attn_softmax_bias(S, mB, lB, OB, h0, h1); else attn_softmax_block(S, mB, lB, OB, rel, w, i, fq);
                store_acc_tile(TPb, S, w, lane); }
            __builtin_amdgcn_sched_barrier(0);
#if !PAIR_EARLYKV
            if (jb < a.jb1) { const bf16* kv1 = proj + ((size_t)a.b * SEQ + (size_t)(jb + 1) * CHUNK) * INW + a.kh * HDIM; tile_fetch(rk, kv1 + C_AK, INW, tid); tile_fetch(rv, kv1 + C_AV, INW, tid); }
            else if (item_next < nitems) { const AttnPItem an = attn_pdecode(item_next);
                const bf16* kv0 = proj + ((size_t)an.b * SEQ + (size_t)an.jb0 * CHUNK) * INW + an.kh * HDIM; tile_fetch(rk, kv0 + C_AK, INW, tid); tile_fetch(rv, kv0 + C_AV, INW, tid); }
#endif
            LDS_WAIT();
            if (MM_SETPRIO) __builtin_amdgcn_s_setprio(1);
#pragma unroll
            for (int ks = 0; ks < 4; ++ks) {
                if (ks < 2 ? h0 : h1) {
                    const bf16x8 paA = frag_row(pba, 0, ks), paB = frag_row(pbb, 0, ks);
#pragma unroll
                    for (int c = 0; c < 8; ++c) { const bf16x8 vf = frag_tr(vb, c, ks);
                        OA[c] = __builtin_amdgcn_mfma_f32_16x16x32_bf16(vf, paA, OA[c], 0, 0, 0);
                        OB[c] = __builtin_amdgcn_mfma_f32_16x16x32_bf16(vf, paB, OB[c], 0, 0, 0); } }
                __builtin_amdgcn_sched_barrier(0); }
            if (MM_SETPRIO) __builtin_amdgcn_s_setprio(0);
        }
#if PAIR_QPRE
        if (item_next < nitems) { const AttnPItem an = attn_pdecode(item_next);
            const bf16* qrow = proj + (an.row0 + i) * INW + C_AQ + an.hq0 * HDIM + 8 * fq;
#pragma unroll
            for (int ks = 0; ks < 4; ++ks) { qfA[ks] = *(const bf16x8*)(qrow + 32 * ks); qfB[ks] = *(const bf16x8*)(qrow + HDIM + 32 * ks); } }
#endif
        const float invA = 1.0f / lA, invB = 1.0f / lB;
#pragma unroll
        for (int c = 0; c < 8; ++c) { OA[c] = OA[c] * invA; OB[c] = OB[c] * invB; }
        store_acc_tile(TPa, OA, w, lane); store_acc_tile(TPb, OB, w, lane);
        LDS_WAIT();
        bf16* obase = mix + (a.row0 + 16 * w) * DM + MIX_C + a.hq0 * HDIM;
#pragma unroll
        for (int k = 0; k < 4; ++k) { const int q = lane + 64 * k, r = q >> 4, ch = q & 15;
            *(v4u*)(obase + (size_t)r * DM + 8 * ch) = *(const LAS v4u*)(TPa + offb(16 * w + r, ch));
            *(v4u*)(obase + (size_t)r * DM + HDIM + 8 * ch) = *(const LAS v4u*)(TPb + offb(16 * w + r, ch)); }
        item = item_next;
    }
}

__device__ __forceinline__ void sgu_unit(ldsp lds, const bf16* proj, bf16* mix, const float* sgup, const float* ln_g, const float* ln_b, const float* w_s, const float* b_s, int unit, int tid) {
    const int lane = tid & 63, w = __builtin_amdgcn_readfirstlane(tid >> 6), fr = lane & 15, fq = lane >> 4;
    const int g = unit & 7, n = (unit >> 3) & 31, b = unit >> 8;
    const ldsp TA = lds, TB = lds + TILE_BYTES;
    LAS float* stat = (LAS float*)(lds + 3 * TILE_BYTES);
    const size_t row0 = (size_t)b * SEQ + (size_t)n * CHUNK;
#if SGU_EARLY
    TileRegs rv; tile_fetch(rv, proj + row0 * INW + C_V + g * HDIM, INW, tid);
    v4u ur[4];
    { const bf16* ub = proj + (row0 + 16 * w) * INW + C_U + g * HDIM;
#pragma unroll
      for (int k = 0; k < 4; ++k) { const int q = lane + 64 * k; ur[k] = *(const v4u*)(ub + (size_t)(q >> 4) * INW + 8 * (q & 15)); } }
    f32x4 wx[4], wy[4];
    { const float* wsp = w_s + (size_t)g * CHUNK * CHUNK;
#pragma unroll
      for (int i = 0; i < 4; ++i) { const int ck = tid + 512 * i, r = ck >> 4, ch = ck & 15; wx[i] = *(const f32x4*)(wsp + r * 128 + 8 * ch); wy[i] = *(const f32x4*)(wsp + r * 128 + 8 * ch + 4); } }
#endif
    __syncthreads();
    { const int tok = tid >> 2, q = tid & 3;
      const f32x4* p = (const f32x4*)(sgup + ((row0 + tok) * 16 + 4 * q) * 2);
      const f32x4 a = p[0], c = p[1];
      float s = (a[0] + a[2]) + (c[0] + c[2]), ss = (a[1] + a[3]) + (c[1] + c[3]);
      s += __shfl_xor(s, 1); ss += __shfl_xor(ss, 1); s += __shfl_xor(s, 2); ss += __shfl_xor(ss, 2);
      const float mean = s * (1.f / 1024.f), var = fmaxf(ss * (1.f / 1024.f) - mean * mean, 0.f);
      if (q == 0) { stat[2 * tok] = mean; stat[2 * tok + 1] = rsqrtf(var + NORM_EPS); } }
    const float* ws = w_s + (size_t)g * CHUNK * CHUNK;
#pragma unroll
    for (int i = 0; i < 4; ++i) { const int ck = tid + 512 * i, r = ck >> 4, ch = ck & 15;
#if SGU_EARLY
        const f32x4 x = wx[i], y = wy[i];
#else
        const f32x4 x = *(const f32x4*)(ws + r * 128 + 8 * ch), y = *(const f32x4*)(ws + r * 128 + 8 * ch + 4);
#endif
        v4u v; v[0] = cvt_pk_bf16(x[0], x[1]); v[1] = cvt_pk_bf16(x[2], x[3]); v[2] = cvt_pk_bf16(y[0], y[1]); v[3] = cvt_pk_bf16(y[2], y[3]);
        *(LAS v4u*)(TA + offb(r, ch)) = v; }
#if !SGU_EARLY
    TileRegs rv; tile_fetch(rv, proj + row0 * INW + C_V + g * HDIM, INW, tid);
#endif
    __syncthreads();
#pragma unroll
    for (int i = 0; i < 4; ++i) { const int ck = tid + 512 * i, r = ck >> 4, ch = ck & 15;
        const v4u v = rv.v[i];
        const float mean = stat[2 * r], rstd = stat[2 * r + 1];
        const f32x4 g0 = *(const f32x4*)(ln_g + g * HDIM + 8 * ch), g1 = *(const f32x4*)(ln_g + g * HDIM + 8 * ch + 4);
        const f32x4 b0 = *(const f32x4*)(ln_b + g * HDIM + 8 * ch), b1 = *(const f32x4*)(ln_b + g * HDIM + 8 * ch + 4);
        v4u o;
        o[0] = cvt_pk_bf16((bf_lo(v[0]) - mean) * rstd * g0[0] + b0[0], (bf_hi(v[0]) - mean) * rstd * g0[1] + b0[1]);
        o[1] = cvt_pk_bf16((bf_lo(v[1]) - mean) * rstd * g0[2] + b0[2], (bf_hi(v[1]) - mean) * rstd * g0[3] + b0[3]);
        o[2] = cvt_pk_bf16((bf_lo(v[2]) - mean) * rstd * g1[0] + b1[0], (bf_hi(v[2]) - mean) * rstd * g1[1] + b1[1]);
        o[3] = cvt_pk_bf16((bf_lo(v[3]) - mean) * rstd * g1[2] + b1[2], (bf_hi(v[3]) - mean) * rstd * g1[3] + b1[3]);
        *(LAS v4u*)(TB + offb(r, ch)) = o; }
    __syncthreads();
    f32x4 acc[8]; zero8(acc);
    mm128<false, true>(acc, TA, TB, w, lane);
    const int i = 16 * w + fr;
    const float bs = b_s[g * CHUNK + i];
#pragma unroll
    for (int c = 0; c < 8; ++c) acc[c] = acc[c] + bs;
    store_acc_tile(TA, acc, w, lane);
    LDS_WAIT();
    const bf16* ubase = proj + (row0 + 16 * w) * INW + C_U + g * HDIM;
    bf16* obase = mix + (row0 + 16 * w) * DM + MIX_A + g * HDIM;
#pragma unroll
    for (int k = 0; k < 4; ++k) { const int q = lane + 64 * k, r = q >> 4, ch = q & 15;
#if SGU_EARLY
        const v4u s = *(const LAS v4u*)(TA + offb(16 * w + r, ch)), u = ur[k];
#else
        const v4u s = *(const LAS v4u*)(TA + offb(16 * w + r, ch)), u = *(const v4u*)(ubase + (size_t)r * INW + 8 * ch);
#endif
        v4u o;
#pragma unroll
        for (int e = 0; e < 4; ++e) o[e] = cvt_pk_bf16(bf_lo(u[e]) * bf_lo(s[e]), bf_hi(u[e]) * bf_hi(s[e]));
        *(v4u*)(obase + (size_t)r * DM + 8 * ch) = o; }
}

__device__ __forceinline__ void ret_chain(ldsp lds, const bf16* proj, bf16* st, const float* ldr, int item, int tid) {
    const int lane = tid & 63, w = __builtin_amdgcn_readfirstlane(tid >> 6), fr = lane & 15, fq = lane >> 4;
    const int h = item & 7, b = (item >> 3) & 3, dir = item >> 5;
    const float l2 = -__expf(ldr[dir * NRH + h]) * LOG2E, cd = __builtin_amdgcn_exp2f(l2 * (float)CHUNK);
    const float a0 = dir ? 0.f : 127.f, a1 = dir ? 1.f : -1.f;
    const int n0 = dir ? NCH - 1 : 0, step = dir ? -1 : 1;
    const bf16* src = proj + (size_t)b * SEQ * INW + h * HDIM;
    bf16* stp = st + (((size_t)dir * BATCH + b) * NRH + h) * (size_t)NCH * (HDIM * HDIM) + (size_t)((16 * w + (fq >> 1)) * 16 + fr) * 8 + 4 * (fq & 1);
    TileRegs rvA, rkA, rvB, rkB;
    tile_fetch(rvA, src + (size_t)n0 * CHUNK * INW + C_RV, INW, tid); tile_fetch(rkA, src + (size_t)n0 * CHUNK * INW + C_RK, INW, tid);
    tile_fetch(rvB, src + (size_t)(n0 + step) * CHUNK * INW + C_RV, INW, tid); tile_fetch(rkB, src + (size_t)(n0 + step) * CHUNK * INW + C_RK, INW, tid);
    __syncthreads();
    tile_put(lds, rvA, tid); tile_put_scaled(lds + TILE_BYTES, rkA, l2, a0, a1, tid);
    __syncthreads();
    f32x4 acc[8]; zero8(acc);
#define CHAIN_STEP(T, RVF, RKF, RVW, RKW) do { const int t_ = (T), n = n0 + step * t_, cur = t_ & 1; \
        const ldsp TV = lds + (cur ? 2 * TILE_BYTES : 0), TKW = TV + TILE_BYTES, TVn = lds + (cur ? 0 : 2 * TILE_BYTES), TKWn = TVn + TILE_BYTES; \
        if (t_ + 2 < NCH) { const size_t o_ = (size_t)(n + 2 * step) * CHUNK * INW; tile_fetch(RVF, src + o_ + C_RV, INW, tid); tile_fetch(RKF, src + o_ + C_RK, INW, tid); } \
        bf16* o = stp + (size_t)n * (HDIM * HDIM); \
        _Pragma("unroll") for (int c = 0; c < 8; ++c) { v2u v; v[0] = cvt_pk_bf16(acc[c][0], acc[c][1]); v[1] = cvt_pk_bf16(acc[c][2], acc[c][3]); *(v2u*)(o + 256 * c) = v; } \
        if (t_ + 1 < NCH) { \
            _Pragma("unroll") for (int c = 0; c < 8; ++c) acc[c] = acc[c] * cd; \
            mm128<true, true>(acc, TV, TKW, w, lane); \
            tile_put(TVn, RVW, tid); tile_put_scaled(TKWn, RKW, l2, a0, a1, tid); } \
        __syncthreads(); } while (0)
    for (int t = 0; t < NCH; t += 2) {
        CHAIN_STEP(t, rvA, rkA, rvB, rkB);
        CHAIN_STEP(t + 1, rvB, rkB, rvA, rkA);
    }
#undef CHAIN_STEP
}

struct RetoutRegs { TileRegs q, k, v, sf, sb; };
__device__ __forceinline__ void retout_fetch(RetoutRegs& R, const bf16* proj, const bf16* st, int unit, int tid) {
    const int h = unit & 7, n = (unit >> 3) & 31, b = unit >> 8;
    const bf16* base = proj + ((size_t)b * SEQ + (size_t)n * CHUNK) * INW + h * HDIM;
    tile_fetch(R.q, base + C_RQ, INW, tid); tile_fetch(R.k, base + C_RK, INW, tid); tile_fetch(R.v, base + C_RV, INW, tid);
    tile_fetch(R.sf, st + ((((size_t)0 * BATCH + b) * NRH + h) * NCH + n) * (size_t)(HDIM * HDIM), HDIM, tid);
    tile_fetch(R.sb, st + ((((size_t)1 * BATCH + b) * NRH + h) * NCH + n) * (size_t)(HDIM * HDIM), HDIM, tid);
}
__device__ __forceinline__ void retout_loop(ldsp lds, const bf16* proj, const bf16* st, bf16* mix, const float* ldr, int u0, int ustep, int nunits, int tid0) {
    const ldsp TQ = lds, TK = lds + TILE_BYTES, TV = lds + 2 * TILE_BYTES, TS = lds + 3 * TILE_BYTES;
    int tid = tid0;
    RetoutRegs R;
    int unit = u0;
    if (unit < nunits) retout_fetch(R, proj, st, unit, tid);
#pragma clang loop unroll(disable)
    while (unit < nunits) {
        asm volatile("" : "+v"(tid));
        const int lane = tid & 63, w = __builtin_amdgcn_readfirstlane(tid >> 6), fr = lane & 15, fq = lane >> 4, i = 16 * w + fr;
        const int h = unit & 7, n = (unit >> 3) & 31, b = unit >> 8;
        const size_t row0 = (size_t)b * SEQ + (size_t)n * CHUNK;
        const float l2f = -__expf(ldr[h]) * LOG2E, l2b = -__expf(ldr[NRH + h]) * LOG2E;
        __syncthreads();
        tile_put(TQ, R.q, tid); tile_put(TK, R.k, tid); tile_put(TV, R.v, tid); tile_put_frag(TS, R.sf, tid);
        __syncthreads();
        f32x4 P[8]; zero8(P);
        mm128<false, false>(P, TQ, TK, w, lane);
#pragma unroll
        for (int c = 0; c < 8; ++c)
#pragma unroll
            for (int j = 0; j < 4; ++j) { const int dl = i - (16 * c + 4 * fq + j);
                P[c][j] *= __builtin_amdgcn_exp2f(dl >= 0 ? l2f * (float)dl : l2b * (float)(-dl)); }
        f32x4 accF[8]; zero8(accF);
        mm128<false, false>(accF, TQ, TS, w, lane);
        __syncthreads();
        store_acc_tile(TK, P, w, lane);
        tile_put_frag(TS, R.sb, tid);
        const bf16* gbase = proj + (row0 + 16 * w) * INW + C_RG + h * HDIM;
        v4u gr[4];
#pragma unroll
        for (int k = 0; k < 4; ++k) { const int q = lane + 64 * k; gr[k] = *(const v4u*)(gbase + (size_t)(q >> 4) * INW + 8 * (q & 15)); }
        const int unext = unit + ustep;
        __syncthreads();
        f32x4 acc[8]; zero8(acc);
        mm128<false, false>(acc, TQ, TS, w, lane);
        const float wf = __builtin_amdgcn_exp2f(l2f * (float)(i + 1)), wb = __builtin_amdgcn_exp2f(l2b * (float)(CHUNK - i));
#pragma unroll
        for (int c = 0; c < 8; ++c) acc[c] = acc[c] * wb + accF[c] * wf;
        asm volatile("" ::: "memory");
        if (unext < nunits) retout_fetch(R, proj, st, unext, tid);
        mm128<false, true>(acc, TK, TV, w, lane);
        float ss = 0.f;
#pragma unroll
        for (int c = 0; c < 8; ++c) ss += (acc[c][0] * acc[c][0] + acc[c][1] * acc[c][1]) + (acc[c][2] * acc[c][2] + acc[c][3] * acc[c][3]);
        ss += __shfl_xor(ss, 16); ss += __shfl_xor(ss, 32);
        const float rn = rsqrtf(ss * (1.f / 128.f) + NORM_EPS);
#pragma unroll
        for (int c = 0; c < 8; ++c) acc[c] = acc[c] * rn;
        store_acc_tile(TK, acc, w, lane);
        LDS_WAIT();
        bf16* obase = mix + (row0 + 16 * w) * DM + MIX_R + h * HDIM;
#pragma unroll
        for (int k = 0; k < 4; ++k) { const int q = lane + 64 * k, r = q >> 4, ch = q & 15;
            const v4u s = *(const LAS v4u*)(TK + offb(16 * w + r, ch)), gw = gr[k];
            v4u o;
#pragma unroll
            for (int e = 0; e < 4; ++e) { const float g0 = bf_lo(gw[e]), g1 = bf_hi(gw[e]);
                o[e] = cvt_pk_bf16(g0 / (1.f + __expf(-g0)) * bf_lo(s[e]), g1 / (1.f + __expf(-g1)) * bf_hi(s[e])); }
            *(v4u*)(obase + (size_t)r * DM + 8 * ch) = o; }
        unit = unext;
    }
}

__device__ __forceinline__ void cvt_rows_bf16(const float* x, bf16* out, float* part, int gw, int ngw, int lane) {
    for (int m = gw; m < M; m += ngw) {
        const f32x4* xr = (const f32x4*)(x + (size_t)m * DM) + lane;
        v2u* o = (v2u*)(out + (size_t)m * DM) + lane;
        float ss = 0.f;
#pragma unroll
        for (int j = 0; j < 16; ++j) { const f32x4 v = xr[64 * j]; ss += (v[0] * v[0] + v[1] * v[1]) + (v[2] * v[2] + v[3] * v[3]);
            v2u ov; ov[0] = cvt_pk_bf16(v[0], v[1]); ov[1] = cvt_pk_bf16(v[2], v[3]); o[64 * j] = ov; }
        ss = wave_sum(ss);
        part[(size_t)m * 64 + lane] = (lane == 0) ? ss : 0.f;
    }
}
__device__ __forceinline__ void final_norm(const bf16* x, float* out, const float* g, const float* part, int gw, int ngw, int lane) {
    for (int m = gw; m < M; m += ngw) {
        const float rstd = 1.0f / sqrtf(wave_sum(part[(size_t)m * 64 + lane]) * (1.f / DM) + NORM_EPS);
        const v4u* xr = (const v4u*)(x + (size_t)m * DM) + lane;
        f32x4* o = (f32x4*)(out + (size_t)m * DM) + 2 * lane;
#pragma unroll
        for (int j = 0; j < 8; ++j) { const v4u v = xr[64 * j];
            const f32x4 g0 = *((const f32x4*)g + 128 * j + 2 * lane), g1 = *((const f32x4*)g + 128 * j + 2 * lane + 1);
            o[128 * j] = (f32x4){bf_lo(v[0]), bf_hi(v[0]), bf_lo(v[1]), bf_hi(v[1])} * rstd * g0;
            o[128 * j + 1] = (f32x4){bf_lo(v[2]), bf_hi(v[2]), bf_lo(v[3]), bf_hi(v[3])} * rstd * g1; }
    }
}
__device__ __forceinline__ void build_rstd(LAS float* tab, const float* part, int pm, int tid) {
    const f32x4* p = (const f32x4*)(part + ((size_t)pm * 256 + (tid >> 1)) * 64 + (tid & 1) * 32); float s = 0.f;
#pragma unroll
    for (int k = 0; k < 8; ++k) { const f32x4 v = p[k]; s += (v[0] + v[1]) + (v[2] + v[3]); }
    s += __shfl_xor(s, 1);
    if ((tid & 1) == 0) tab[tid >> 1] = 1.0f / sqrtf(s * (1.f / DM) + NORM_EPS);
    __syncthreads();
}
template <bool PERMUTE>
__device__ __forceinline__ void transpose_item(const float* W, int K, int N, bf16* WT, const float* gk, LAS float* scr, int item, int lane) {
    const int nblk = N / 32, kb = item / nblk, nb = item % nblk, k0 = 64 * kb, n0 = 32 * nb;
#pragma unroll 8
    for (int i = 0; i < 32; ++i) { const int kk = 2 * i + (lane >> 5); scr[kk * 33 + (lane & 31)] = W[(size_t)(k0 + kk) * N + n0 + (lane & 31)] * (gk ? gk[k0 + kk] : 1.0f); }
    LDS_WAIT(); asm volatile("" ::: "memory");
    const int c = lane & 7;
#pragma unroll
    for (int j = 0; j < 4; ++j) { const int n = (lane >> 3) + 8 * j; const LAS float* s = scr + (8 * c) * 33 + n;
        v4u o; o[0] = cvt_pk_bf16(s[0 * 33], s[1 * 33]); o[1] = cvt_pk_bf16(s[2 * 33], s[3 * 33]); o[2] = cvt_pk_bf16(s[4 * 33], s[5 * 33]); o[3] = cvt_pk_bf16(s[6 * 33], s[7 * 33]);
        *(v4u*)(WT + (size_t)((PERMUTE ? win_phys_col(n0) : n0) + n) * K + k0 + 8 * c) = o; }
    LDS_WAIT(); asm volatile("" ::: "memory");
}
#ifndef MK_MULTI
#define MK_MULTI 0
#endif
#ifndef GEMM_SP2
#define GEMM_SP2 true
#endif
#ifndef GEMM_ALIGN
#define GEMM_ALIGN true
#endif
#ifndef G4_AUXA
#define G4_AUXA 0
#endif
#ifndef G4_AUXB
#define G4_AUXB 0
#endif
#ifndef ORDER4K
#define ORDER4K BlockOrder
#endif
#ifndef CVT_ALL_IN_P0
#define CVT_ALL_IN_P0 0
#endif
#ifndef CVT_PER_ITEM
#define CVT_PER_ITEM 0
#endif
#ifndef CVT_STAGGER
#define CVT_STAGGER 1
#endif
__host__ __device__ constexpr int cvt_slot_lo(int s) { return s == 0 ? 0 : s == 1 ? 1440 : s == 2 ? 2880 : 4608; }
__host__ __device__ constexpr int cvt_slot_hi(int s) { return s == 0 ? 1440 : s == 1 ? 2880 : s == 2 ? 4608 : 5760; }
#define PLACE_STR2(x) #x
#define PLACE_STR(x) PLACE_STR2(x)
constexpr int NPH = 1 + 9 * DEPTH;
#ifndef PROBE_REP_GEMM
#define PROBE_REP_GEMM 0
#endif
#ifndef PROBE_ATTN_VAR
#define PROBE_ATTN_VAR 0
#endif
#ifndef MERGE_M3
#define MERGE_M3 0
#endif
#ifndef PROBE_REP_MIX
#define PROBE_REP_MIX 0
#endif
#ifndef PROBE_REP_CVT
#define PROBE_REP_CVT 0
#endif
constexpr size_t WS_DUMMY = WS_END;
struct Args { const float* in[14]; float* out; unsigned char* ws; int ph_lo, ph_hi; };
__global__ void __launch_bounds__(NWAVES * 64, 2) hybrid_fwd(Args args) {
#if defined(PLACE_SHIFT)
    for (int i_ = 0; i_ < 0; ++i_) {}
    asm volatile(".rept " PLACE_STR(PLACE_SHIFT) "\n\ts_nop 0\n\t.endr" ::: "memory");
#endif
    extern __shared__ __attribute__((aligned(16))) unsigned char lds_raw[];
    const ldsp lds = (ldsp)lds_raw;
    volatile LAS unsigned* MISC = (volatile LAS unsigned*)(lds + MISC_OFF);
    const int tid = threadIdx.x;
    const int G = gridDim.x, bx = blockIdx.x;
    const int ngw = G * NWAVES;
    unsigned char* ws = args.ws;
    unsigned* ctl = (unsigned*)(ws + WS_CTL);
    const float* x_in = args.in[0]; const float* ln_mix_g = args.in[1]; const float* w_in = args.in[2]; const float* sgu_ln_g = args.in[3]; const float* sgu_ln_b = args.in[4];
    const float* sgu_w = args.in[5]; const float* sgu_b = args.in[6]; const float* ret_ld = args.in[7]; const float* attn_sink = args.in[8]; const float* w_out = args.in[9];
    const float* ln_mlp_g = args.in[10]; const float* w_up = args.in[11]; const float* w_down = args.in[12]; const float* final_g = args.in[13];
    float* out = args.out;
    float* cosT = (float*)(ws + WS_COS); float* sinT = (float*)(ws + WS_SIN);
    bf16* WinT = (bf16*)(ws + WS_WIN); bf16* WoutT = (bf16*)(ws + WS_WOUT); bf16* WupT = (bf16*)(ws + WS_WUP); bf16* WdnT = (bf16*)(ws + WS_WDN);
    bf16* Hb = (bf16*)(ws + WS_H); bf16* PROJ = (bf16*)(ws + WS_PROJ); bf16* MIX = (bf16*)(ws + WS_MIX); bf16* HID = (bf16*)(ws + WS_HID);
    bf16* ST = (bf16*)(ws + WS_ST); float* SGUP = (float*)(ws + WS_SGUP);
    float* RSA = (float*)(ws + WS_RSA); float* RSB = (float*)(ws + WS_RSB);
    LAS float* rstd_tab = (LAS float*)(lds + RSTD_OFF);

    for (int u = tid; u < (LDS_BYTES - LDSCTL_OFF) / 4; u += NWAVES * 64) ((LAS unsigned*)(lds + LDSCTL_OFF))[u] = 0u;
    __syncthreads();
#if HW_TID
    if ((tid & 63) == 0) *(volatile LAS int*)(lds + HWTAB_OFF + 4u * hw_slot()) = tid >> 6;
    __syncthreads();
#endif
#if !MK_MULTI
    { XcdBarrier bar0 = xcd_barrier_post(ctl + CW_BAR, MISC + 8); (void)bar0; }
#if defined(PROBE_BAR2)
#define GRID_BAR() do { xcd_barrier(bar); xcd_barrier(bar); xcd_barrier(bar); } while (0)
#else
#define GRID_BAR() do { const __attribute__((address_space(4))) KArgs* ka_ = (const __attribute__((address_space(4))) KArgs*)__builtin_amdgcn_kernarg_segment_ptr(); asm volatile("" : "+s"(ka_)); \
        XcdBarrier b_; b_.bar = (unsigned*)(ka_->ws + WS_CTL) + CW_BAR; b_.x = xb_xcc_id(); b_.st = MISC + 8; xcd_barrier(b_); } while (0)
#endif
#else
#define GRID_BAR() do {} while (0)
#endif
    const int lo = args.ph_lo, hi = args.ph_hi;
#ifndef MK_ONLY
#define MK_ONLY -1
#endif
#ifndef MK_SUB
#define MK_SUB -1
#endif
#define SUB(k) (MK_SUB < 0 || MK_SUB == (k))
#define SITE(k) (MK_ONLY < 0 || MK_ONLY == (k))
#if MK_MULTI
#define IN(k) (lo <= (k) && (k) < hi)
#else
#define IN(k) true
#endif
#define CVT_SLOT(S, WHEN_ODD) do { if (CVT_STAGGER && !CVT_ALL_IN_P0 && ((bx & 1) != 0) == (WHEN_ODD)) { int tq = hw_tid(lds); asm volatile("" : "+v"(tq)); int ci_ = cvt_slot_lo(S) + bx; cvt_step(l, ci_, 1 << 30, lds, tq, cvt_slot_hi(S)); } } while (0)
#define CVT_GRP() ((((bx & 1) << 1) | ((bx >> 3) & 1)))
#define CVT_SLOT4_BEFORE(S) int ci_slot = cvt_slot_lo(S) + bx; do { int tq = hw_tid(lds); asm volatile("" : "+v"(tq)); \
        const int hi_ = cvt_slot_hi(S) < cvt_batch_items(l) ? cvt_slot_hi(S) : cvt_batch_items(l); const int nit_ = ci_slot < hi_ ? (hi_ - ci_slot + 255) / 256 : 0; \
        cvt_step(l, ci_slot, (nit_ * (3 - CVT_GRP()) + 1) / 3, lds, tq, cvt_slot_hi(S)); } while (0)
#define CVT_SLOT4_AFTER(S) do { int tq = hw_tid(lds); asm volatile("" : "+v"(tq)); cvt_step(l, ci_slot, 1 << 30, lds, tq, cvt_slot_hi(S)); } while (0)
#define FRESH_TID() int tz = hw_tid(lds); asm volatile("" : "+v"(tz)); const int lz = tz & 63, wz = __builtin_amdgcn_readfirstlane(tz >> 6), gwz = bx * NWAVES + wz; (void)lz; (void)gwz

    if (SITE(0) && IN(0)) {
        FRESH_TID();
        LAS float* scr64 = (LAS float*)(lds + wz * 16640);
        for (int wi = bx; wi < CVT_IN; wi += G) cvt_tile64<true>(w_in, DM, INW, WinT, DM, ln_mix_g, scr64, 8 * wi + wz, lz);
#if CVT_ALL_IN_P0
        { int ci0 = bx, ci1 = bx; cvt_step(0, ci0, 1 << 30, lds, tz); cvt_step(1, ci1, 1 << 30, lds, tz); }
#endif
        if (bx == 0 && tz < 64) cosT[tz] = powf(10000.0f, -(float)(2 * tz) / 128.0f) * 0.15915494309189535f;
        cvt_rows_bf16(x_in, Hb, RSA, gwz, ngw, lz);
        GRID_BAR();
    }
#if defined(PROBE_BARS)
    if (IN(0)) { for (int i = 0; i < PROBE_BARS; ++i) GRID_BAR(); }
#endif
#if defined(PROBE_EPI)
    if (IN(0)) {
        pg8::Gemm g{Hb, WinT, M, 8192, DM, DM, DM};
#ifndef PROBE_WGM
#define PROBE_WGM 8
#endif
#if PROBE_WGM == 0
        typedef pg8::SameTileOrder ProbeOrder;
#else
        typedef pg8::StaticOrderW<PROBE_WGM> ProbeOrder;
#endif
        ProbeOrder S; S.init(M, 8192, G, bx);
        { FRESH_TID(); for (int q = 0; q < 4; ++q) build_rstd(rstd_tab + 256 * q, RSA, 0, tz); }
        pg8::EpiProbe<PROBE_EPI - 1> E{HID, 8192, pg8::RowScale{rstd_tab}};
#if defined(PROBE_SPLIT)
        pg8::Gemm g1{Hb, WinT, M, 4096, DM, DM, DM}, g2{Hb, WinT + (size_t)4096 * DM, M, 4096, DM, DM, DM}; ProbeOrder S1; S1.init(M, 4096, G, bx);
        for (int rep = 0; rep < PROBE_REPS; ++rep) { pg8::gemm_phase<pg8::EpiProbe<PROBE_EPI - 1>, ProbeOrder, GEMM_ALIGN, GEMM_SP2>(lds, g1, S1, E); GRID_BAR();
                                                     pg8::gemm_phase<pg8::EpiProbe<PROBE_EPI - 1>, ProbeOrder, GEMM_ALIGN, GEMM_SP2>(lds, g2, S1, E); GRID_BAR(); }
#else
        for (int rep = 0; rep < PROBE_REPS; ++rep) { pg8::gemm_phase<pg8::EpiProbe<PROBE_EPI - 1>, ProbeOrder, GEMM_ALIGN, GEMM_SP2>(lds, g, S, E); GRID_BAR(); }
#endif
    }
#endif
    for (int l = 0; l < DEPTH; ++l) {
        const int p0 = 1 + 9 * l;
        for (int rep = 0; rep < 1 + (PROBE_REP_GEMM & 1); ++rep)
        if (SITE(1) && IN(p0 + 0)) {
#if CVT_STAGGER == 4
            CVT_SLOT4_BEFORE(0);
#else
            CVT_SLOT(0, true);
#endif
            pg8::Gemm g{Hb, WinT + (size_t)l * INW * DM, M, INW, DM, DM, DM}; pg8::StaticOrder S; S.init(M, INW, G, bx);
            { pg8::Unit u0; S.next(0, u0); FRESH_TID(); build_rstd(rstd_tab + 256 * (u0.pm >> 4), RSA, u0.pm, tz); }
            pg8::EpiIn E{PROJ, INW, pg8::RowScale{rstd_tab}, cosT, SGUP, SEQ};
            pg8::gemm_phase<pg8::EpiIn, pg8::StaticOrder, GEMM_ALIGN, GEMM_SP2>(lds, g, S, E);
#if CVT_STAGGER == 4
            CVT_SLOT4_AFTER(0);
#else
            CVT_SLOT(0, false);
#endif
            GRID_BAR();
        }
        for (int rep = 0; rep < 1 + PROBE_REP_MIX; ++rep) {
        if (SITE(2) && IN(p0 + 1)) {
            FRESH_TID();
            volatile LAS int* qslot = (volatile LAS int*)(lds + MISC_OFF + 64);
#define RUN_QUEUE(QI, NITEMS, CALL) do { unsigned* qw = ctl + CW_Q + 64 * (3 * l + (QI)) + 64 * 6 * rep; __syncthreads(); \
                if (tz == 0) *qslot = (int)__hip_atomic_fetch_add(qw, 1u, __ATOMIC_RELAXED, __HIP_MEMORY_SCOPE_AGENT); __syncthreads(); int item = *qslot; \
                while (item < (NITEMS)) { int nxt = 0; if (tz == 0) nxt = (int)__hip_atomic_fetch_add(qw, 1u, __ATOMIC_RELAXED, __HIP_MEMORY_SCOPE_AGENT); \
                    CALL; __syncthreads(); if (tz == 0) *qslot = nxt; __syncthreads(); item = *qslot; } } while (0)
#define SGU_PASS(QI) RUN_QUEUE(QI, 1024, sgu_unit(lds, PROJ, MIX, SGUP, sgu_ln_g + l * 1024, sgu_ln_b + l * 1024, sgu_w + (size_t)l * NSG * CHUNK * CHUNK, sgu_b + l * NSG * CHUNK, item, tz))
#if defined(PROBE_MIXPART)
#ifndef PROBE_MIXREPS
#define PROBE_MIXREPS 1
#endif
            for (int pr = 0; pr < PROBE_MIXREPS; ++pr) {
#if PROBE_MIXPART == 1
            RUN_QUEUE((20 - 2 * l + 4 * pr), 64, ret_chain(lds, PROJ, ST, ret_ld + l * 2 * NRH, item, tz));
#endif
#if PROBE_MIXPART == 5
            { int cix = 1 << 30; attn_queue<PROBE_ATTN_VAR>(lds, PROJ, MIX, attn_sink + l * NQH, ctl + CW_Q + 64 * (20 - 2 * l + 4 * pr), qslot, 2048, tz, l, cix, 0); }
#endif
            __syncthreads(); GRID_BAR(); }
#endif
#if MERGE_M3
            unsigned* const chains_done = ctl + CW_Q + 64 * (40 + l + 2 * rep);
            { unsigned* qw = ctl + CW_Q + 64 * (3 * l) + 64 * 6 * rep; int ndone = 0; __syncthreads();
              if (tz == 0) *qslot = (int)__hip_atomic_fetch_add(qw, 1u, __ATOMIC_RELAXED, __HIP_MEMORY_SCOPE_AGENT); __syncthreads(); int item = *qslot;
              while (item < 64) { int nxt = 0; if (tz == 0) nxt = (int)__hip_atomic_fetch_add(qw, 1u, __ATOMIC_RELAXED, __HIP_MEMORY_SCOPE_AGENT);
                  ret_chain(lds, PROJ, ST, ret_ld + l * 2 * NRH, item, tz); ++ndone; __syncthreads(); if (tz == 0) *qslot = nxt; __syncthreads(); item = *qslot; }
              if (__builtin_amdgcn_readfirstlane(ndone) != 0) {
                  asm volatile("s_waitcnt vmcnt(0)" ::: "memory"); __syncthreads();
                  if (tz == 0) { __builtin_amdgcn_fence(__ATOMIC_RELEASE, "agent"); asm volatile("s_waitcnt vmcnt(0)" ::: "memory"); (void)xb_add(chains_done, (unsigned)ndone); } } }
#else
            RUN_QUEUE(0, 64, ret_chain(lds, PROJ, ST, ret_ld + l * 2 * NRH, item, tz));
#endif


            int ci = (CVT_ALL_IN_P0 || CVT_STAGGER) ? (1 << 30) : bx;
#if ATTN_PAIR
            attn_pair_queue(lds, PROJ, MIX, attn_sink + l * NQH, ctl + CW_Q + 64 * (3 * l + 1) + 64 * 6 * rep, qslot, 1024, tz);
#else
            attn_queue(lds, PROJ, MIX, attn_sink + l * NQH, ATTN_XCDQ ? ctl + CW_Q + 64 * (64 + 16 * l + 32 * rep) : ctl + CW_Q + 64 * (3 * l + 1) + 64 * 6 * rep, qslot, 2048, tz, l, ci, CVT_PER_ITEM);
#endif
            { int tz = hw_tid(lds); asm volatile("" : "+v"(tz));
            SGU_PASS(2);
            if (!CVT_STAGGER) cvt_step(l, ci, 1 << 30, lds, tz); }
#undef SGU_PASS
#undef RUN_QUEUE
#if MERGE_M3
            __syncthreads();
            if (tz == 0) { XB_SPIN(xb_ld(chains_done) < 64u, ctl + CW_BAR); __builtin_amdgcn_fence(__ATOMIC_ACQUIRE, "agent"); asm volatile("s_waitcnt vmcnt(0)" ::: "memory"); }
            __syncthreads();
            { FRESH_TID(); retout_loop(lds, PROJ, ST, MIX, ret_ld + l * 2 * NRH, bx, G, 1024, tz); }
            __syncthreads();
#endif
            GRID_BAR();
        }
#define SGU_STATIC_PASS() do { for (int u = bx; u < 1024; u += G) sgu_unit(lds, PROJ, MIX, SGUP, sgu_ln_g + l * 1024, sgu_ln_b + l * 1024, sgu_w + (size_t)l * NSG * CHUNK * CHUNK, sgu_b + l * NSG * CHUNK, u, tz); } while (0)
#define RETOUT_PASS() retout_loop(lds, PROJ, ST, MIX, ret_ld + l * 2 * NRH, bx, G, 1024, tz)
        if (!MERGE_M3 && SITE(4) && IN(p0 + 3)) {
            FRESH_TID();
#if defined(PROBE_MIXPART) && PROBE_MIXPART == 3
            for (int pr = 0; pr < PROBE_MIXREPS; ++pr) { SGU_STATIC_PASS(); __syncthreads(); GRID_BAR(); }
#endif
#if defined(PROBE_MIXPART) && PROBE_MIXPART == 2
            for (int pr = 0; pr < PROBE_MIXREPS; ++pr) { volatile LAS int* qslot2 = (volatile LAS int*)(lds + MISC_OFF + 64); int cix = 1 << 30;
                attn_queue<PROBE_ATTN_VAR>(lds, PROJ, MIX, attn_sink + l * NQH, ctl + CW_Q + 64 * (20 - 2 * l + 4 * pr), qslot2, 2048, tz, l, cix, 0); __syncthreads(); GRID_BAR(); }
#endif
#if defined(PROBE_MIXPART) && PROBE_MIXPART == 4
            for (int pr = 0; pr <= PROBE_MIXREPS; ++pr) { RETOUT_PASS(); __syncthreads(); GRID_BAR(); }
#else
            RETOUT_PASS();
            __syncthreads();
            GRID_BAR();
#endif
        }
        }
        if (SITE(5) && IN(p0 + 4)) {
#if CVT_STAGGER == 4
            CVT_SLOT4_BEFORE(1);
#else
            CVT_SLOT(1, true);
#endif
            pg8::Gemm g{MIX, WoutT + (size_t)l * DM * DM, M, DM, DM, DM, DM}; pg8::ORDER4K S; S.init(M, DM, G, bx);
            pg8::EpiResB E{Hb, DM, RSB};
            pg8::gemm_phase<pg8::EpiResB, pg8::ORDER4K, GEMM_ALIGN, GEMM_SP2>(lds, g, S, E);
#if CVT_STAGGER == 4
            CVT_SLOT4_AFTER(1);
#else
            CVT_SLOT(1, false);
#endif
            GRID_BAR();
        }
        for (int rep = 0; rep < 1 + ((PROBE_REP_GEMM >> 1) & 1); ++rep)
        if (SITE(7) && IN(p0 + 6)) {
#if CVT_STAGGER == 4
            CVT_SLOT4_BEFORE(2);
#else
            CVT_SLOT(2, true);
#endif
            pg8::Gemm g{Hb, WupT + (size_t)l * DFF * DM, M, DFF, DM, DM, DM}; pg8::StaticOrder S; S.init(M, DFF, G, bx);
            { pg8::Unit u0; S.next(0, u0); FRESH_TID(); build_rstd(rstd_tab + 256 * (u0.pm >> 4), RSB, u0.pm, tz); }
            pg8::EpiRelu2 E{HID, DFF, pg8::RowScale{rstd_tab}};
            pg8::gemm_phase<pg8::EpiRelu2, pg8::StaticOrder, GEMM_ALIGN, GEMM_SP2>(lds, g, S, E);
#if CVT_STAGGER == 4
            CVT_SLOT4_AFTER(2);
#else
            CVT_SLOT(2, false);
#endif
            GRID_BAR();
        }
        if (SITE(8) && IN(p0 + 7)) {
#if CVT_STAGGER == 4
            CVT_SLOT4_BEFORE(3);
#else
            CVT_SLOT(3, true);
#endif
            pg8::Gemm g{HID, WdnT + (size_t)l * DM * DFF, M, DM, DFF, 64, 64}; pg8::ORDER4K S; S.init(M, DM, G, bx);
            pg8::EpiResB E{Hb, DM, RSA};
            pg8::gemm_phase<pg8::EpiResB, pg8::ORDER4K, GEMM_ALIGN, GEMM_SP2, true, true, G4_AUXA, G4_AUXB>(lds, g, S, E);
#if CVT_STAGGER == 4
            CVT_SLOT4_AFTER(3);
#else
            CVT_SLOT(3, false);
#endif
            GRID_BAR();
        }
        if (SITE(9) && IN(p0 + 8) && l + 1 == DEPTH) {
            FRESH_TID();
            final_norm(Hb, out, final_g, RSA, gwz, ngw, lz);
        }
    }
#undef IN
}

extern "C" void kernel_launch(void* const* d_in, const int* in_sizes, int n_in, void* d_out, int out_size, void* d_ws, size_t ws_size, hipStream_t stream) {
    static int grid = 0;
    if (grid == 0) {
        if (n_in != 14 || in_sizes[0] != M * DM || out_size != M * DM || ws_size < WS_END + ((PROBE_REP_GEMM) ? 256 * MiB : 0)) { fprintf(stderr, "kernel_launch: unexpected shapes (n_in %d, in0 %d, out %d, ws %zu < %zu); nothing launched\n", n_in, n_in > 0 ? in_sizes[0] : -1, out_size, ws_size, (size_t)WS_END); grid = -1; return; }
        int dev = 0, cus = 0, per_cu = 0;
        if (hipGetDevice(&dev) != hipSuccess || hipDeviceGetAttribute(&cus, hipDeviceAttributeMultiprocessorCount, dev) != hipSuccess) { grid = -1; return; }
        if (hipFuncSetAttribute((const void*)hybrid_fwd, hipFuncAttributeMaxDynamicSharedMemorySize, LDS_BYTES) != hipSuccess) { fprintf(stderr, "kernel_launch: hipFuncSetAttribute failed\n"); grid = -1; return; }
        if (hipOccupancyMaxActiveBlocksPerMultiprocessor(&per_cu, (const void*)hybrid_fwd, NWAVES * 64, LDS_BYTES) != hipSuccess || per_cu < 1)
            fprintf(stderr, "kernel_launch: note: occupancy query reports %d workgroups per CU\n", per_cu);
        (void)hipGetLastError();
        if (cus < 256) { fprintf(stderr, "kernel_launch: needs 256 CUs, found %d\n", cus); grid = -1; return; }
        grid = 256;
    }
    if (grid < 0) return;
    if (hipMemsetAsync((char*)d_ws + WS_CTL, 0, CTL_ZERO_BYTES, stream) != hipSuccess) { fprintf(stderr, "kernel_launch: memset failed\n"); return; }
    Args a{};
    for (int i = 0; i < 14; ++i) a.in[i] = (const float*)d_in[i];
    a.out = (float*)d_out; a.ws = (unsigned char*)d_ws;
#if MK_MULTI
    for (int p = 0; p < NPH; ++p) { a.ph_lo = p; a.ph_hi = p + 1; hipLaunchKernelGGL(hybrid_fwd, dim3(grid), dim3(NWAVES * 64), LDS_BYTES, stream, a); }
#else
    a.ph_lo = 0; a.ph_hi = NPH;
    hipLaunchKernelGGL(hybrid_fwd, dim3(grid), dim3(NWAVES * 64), LDS_BYTES, stream, a);
#endif
    const hipError_t le = hipPeekAtLastError();
    if (le != hipSuccess) fprintf(stderr, "kernel_launch: launch failed: %s\n", hipGetErrorName(le));
}
```

```cpp
#define HW_TID 1
#define MM_PIPE 1
#define MM_G 4
#define ATTN_PIPE 0
#define ATTN_VFIX 0
#define ATTN_BIAS 1
#define ATTN_PAIR 1
#include <hip/hip_runtime.h>
#include <cstdio>
#include <cstdint>
namespace pg8 {
#define PG8_LAS __attribute__((address_space(3)))
typedef unsigned short bf16_t;
typedef short bf16x8 __attribute__((ext_vector_type(8)));
typedef float f32x4 __attribute__((ext_vector_type(4)));
typedef unsigned u32x4 __attribute__((ext_vector_type(4)));
constexpr int BM = 256, BK = 64, HALF = 128, HTB = HALF * BK * 2  , STAGE_BYTES = 8 * HTB, NXCD = 8, WGM = 8;

__host__ __device__ __forceinline__ int lds_byte(int r, int c) { const int st = (r >> 4) * 2 + (c >> 5), rr = r & 15, cc = c & 31, ob = rr * 64 + cc * 2; return st * 1024 + (ob ^ (((ob >> 9) & 1) << 5)); }
__host__ __device__ __forceinline__ void stage_rc(int b, int& R, int& C) { const int st = b / 1024, sb = b % 1024, swz = sb ^ (((sb >> 9) & 1) << 5); R = (st >> 1) * 16 + swz / 64; C = (st & 1) * 32 + (swz % 64) / 2; }
__host__ __device__ __forceinline__ int perm32(int rho) { const int n = rho >> 4, i = rho & 15; return 8 * (i >> 2) + 4 * n + (i & 3); }

struct Unit { int pm, pn; };
struct Gemm { const bf16_t* A; const bf16_t* Bt; int M, N, K, lda, ldb; };
__host__ __device__ __forceinline__ size_t blocked_off(int row, int col, int K) { return (((size_t)(row >> 8) * (K >> 6) + (col >> 6)) * 256 + (row & 255)) * 64 + (col & 63); }

#ifndef HW_TID
#define HW_TID 0
#endif
constexpr int HWTAB_OFF = 139264 + 320 + 256;
__device__ __forceinline__ unsigned hw_slot() { return (unsigned)__builtin_amdgcn_s_getreg((5 << 11) | 4) & 63u; }
__device__ __forceinline__ int hw_lane() { int l; asm volatile("v_mbcnt_lo_u32_b32 %0, -1, 0\n\tv_mbcnt_hi_u32_b32 %0, -1, %0" : "=v"(l)); return l; }
__device__ __forceinline__ int hw_tid(__attribute__((address_space(3))) unsigned char* lds) {
#if HW_TID
    const int wv = __builtin_amdgcn_readfirstlane(*(volatile __attribute__((address_space(3))) int*)(lds + HWTAB_OFF + 4u * hw_slot()));
    return 64 * wv + hw_lane();
#else
    (void)lds; return (int)threadIdx.x;
#endif
}
struct StaticOrder {
    int nM, nN, nwg, G, c;
    __host__ __device__ void init(int M, int N, int G_, int c_) { nM = M / BM; nN = N / BM; nwg = nM * nN; G = G_; c = c_; }
    __host__ __device__ bool next(int i, Unit& u) const {
        const long L = (long)i * G + c; if (L >= nwg) return false;
        int wgid = (int)L; { const int q = nwg / NXCD, r = nwg % NXCD, xcd = wgid % NXCD, off = wgid / NXCD; wgid = (xcd < r ? xcd * (q + 1) : r * (q + 1) + (xcd - r) * q) + off; }
        const int nig = WGM * nN, gid = wgid / nig, fm = gid * WGM, gsz = (nM - fm) < WGM ? (nM - fm) : WGM;
        u.pm = fm + ((wgid % nig) % gsz); u.pn = (wgid % nig) / gsz; return true;
    }
    __device__ __forceinline__ void a_ready(const Unit&) const {}
    __device__ __forceinline__ void done(const Unit&) const {}
};

typedef float f32x2c_t __attribute__((ext_vector_type(2))); typedef __bf16 bf16x2c_t __attribute__((ext_vector_type(2)));
__device__ __forceinline__ unsigned cvt_pk_bf16(float lo, float hi) { const f32x2c_t v = {lo, hi}; return __builtin_bit_cast(unsigned, __builtin_convertvector(v, bf16x2c_t)); }
__device__ __forceinline__ float quad_sum(float x) {
    auto r = __builtin_amdgcn_permlane16_swap(__builtin_bit_cast(unsigned, x), __builtin_bit_cast(unsigned, x), false, false);
    x = __builtin_bit_cast(float, (unsigned)r[0]) + __builtin_bit_cast(float, (unsigned)r[1]);
    auto q = __builtin_amdgcn_permlane32_swap(__builtin_bit_cast(unsigned, x), __builtin_bit_cast(unsigned, x), false, false);
    return __builtin_bit_cast(float, (unsigned)q[0]) + __builtin_bit_cast(float, (unsigned)q[1]);
}
__device__ __forceinline__ float quad_max(float x) {
    auto r = __builtin_amdgcn_permlane16_swap(__builtin_bit_cast(unsigned, x), __builtin_bit_cast(unsigned, x), false, false);
    x = __builtin_fmaxf(__builtin_bit_cast(float, (unsigned)r[0]), __builtin_bit_cast(float, (unsigned)r[1]));
    auto q = __builtin_amdgcn_permlane32_swap(__builtin_bit_cast(unsigned, x), __builtin_bit_cast(unsigned, x), false, false);
    return __builtin_fmaxf(__builtin_bit_cast(float, (unsigned)q[0]), __builtin_bit_cast(float, (unsigned)q[1]));
}
typedef float f32x2 __attribute__((ext_vector_type(2)));
__device__ __forceinline__ f32x2 gelu_pk(f32x2 v) {
    const f32x2 av = __builtin_elementwise_abs(v), d = av * 0.2316418882f + 1.0f;
    f32x2 t; t.x = __builtin_amdgcn_rcpf(d.x); t.y = __builtin_amdgcn_rcpf(d.y);
    f32x2 q = t * 0.5307027145f + (-0.7265760135f); q = q * t + 0.7107068705f; q = q * t + (-0.142248368f); q = q * t + 0.127414796f; q = q * t;
    const f32x2 s = (v * v) * (-0.72134752044f);
    f32x2 e; e.x = __builtin_amdgcn_exp2f(s.x); e.y = __builtin_amdgcn_exp2f(s.y);
    const f32x2 m = v * (q * e), r = v - m;
    f32x2 o; o.x = v.x < 0.f ? m.x : r.x; o.y = v.y < 0.f ? m.y : r.y; return o;
}

#ifndef EPI_NT
#define EPI_NT 0
#endif
#if EPI_NT
#define EPI_STORE16(p, v) __builtin_nontemporal_store((v), (u32x4*)(p))
#else
#define EPI_STORE16(p, v) (*(u32x4*)(p) = (v))
#endif
struct RowScale {
    const PG8_LAS float* tab;
    __device__ __forceinline__ float get(int pm, int rl) const { return tab[((pm >> 4) << 8) + rl]; }
};
struct EpiIn {
    static constexpr bool PERM = true, AFTER_DRAIN = false;
    bf16_t* O; int ldc; RowScale rs; const float* invrev; float* sgup; int seq;
    __device__ __forceinline__ void operator()(const f32x4 (&acc)[2][2][4][2], const Unit& u, int wr, int wc, int fr, int fq) const {
        const int pn = u.pn, row0 = u.pm * BM + wr * 64 + fr;
        const bool rope = (pn >= 8 && pn < 16) || (pn >= 24 && pn < 34);
        if (rope) {
            const float qs = (pn >= 24 && pn < 32) ? 0.08838834764831845f * 1.4426950408889634f : ((pn >= 12 && pn < 16) ? 0.08838834764831845f : 1.0f);
            const int dp = 32 * (wc & 1) + 8 * fq, colr = pn * BM + 128 * (wc >> 1) + dp;
            f32x4 fr0 = *(const f32x4*)(invrev + dp), fr1 = *(const f32x4*)(invrev + dp + 4);
#pragma unroll
            for (int gi = 0; gi < 8; ++gi) { const int ai = gi >> 2, m = gi & 3;
                const int row = row0 + ai * HALF + m * 16; bf16_t* rowp = O + (size_t)row * ldc + colr;
                const float pos = (float)(row & (seq - 1));
                f32x4 c0, c1, s0, s1;
#pragma unroll
                for (int e = 0; e < 4; ++e) { const float t0 = __builtin_amdgcn_fractf(pos * fr0[e]), t1 = __builtin_amdgcn_fractf(pos * fr1[e]);
                    c0[e] = __builtin_amdgcn_cosf(t0); s0[e] = __builtin_amdgcn_sinf(t0); c1[e] = __builtin_amdgcn_cosf(t1); s1[e] = __builtin_amdgcn_sinf(t1); }
                const float rsc = rs.get(u.pm, wr * 64 + fr + ai * HALF + m * 16) * qs;
                const f32x4 l0 = acc[ai][0][m][0] * rsc, l1 = acc[ai][0][m][1] * rsc, h0 = acc[ai][1][m][0] * rsc, h1 = acc[ai][1][m][1] * rsc;
                const f32x4 ol0 = l0 * c0 - h0 * s0, ol1 = l1 * c1 - h1 * s1, oh0 = h0 * c0 + l0 * s0, oh1 = h1 * c1 + l1 * s1;
                u32x4 wl, wh;
                wl.x = cvt_pk_bf16(ol0[0], ol0[1]); wl.y = cvt_pk_bf16(ol0[2], ol0[3]); wl.z = cvt_pk_bf16(ol1[0], ol1[1]); wl.w = cvt_pk_bf16(ol1[2], ol1[3]);
                wh.x = cvt_pk_bf16(oh0[0], oh0[1]); wh.y = cvt_pk_bf16(oh0[2], oh0[3]); wh.z = cvt_pk_bf16(oh1[0], oh1[1]); wh.w = cvt_pk_bf16(oh1[2], oh1[3]);
                EPI_STORE16(rowp, wl); EPI_STORE16(rowp + 64, wh); }
        } else {
            const int col0 = pn * BM + wc * 32 + 8 * fq;
            const bool act = pn < 8, stats = pn >= 4 && pn < 8;
#pragma unroll
            for (int ai = 0; ai < 2; ++ai)
#pragma unroll
                for (int m = 0; m < 4; ++m) { const int row = row0 + ai * HALF + m * 16; bf16_t* rowp = O + (size_t)row * ldc + col0;
                    const float rsc = rs.get(u.pm, wr * 64 + fr + ai * HALF + m * 16);
                    float s = 0.f, ss = 0.f;
#pragma unroll
                    for (int bj = 0; bj < 2; ++bj) { f32x4 v0 = acc[ai][bj][m][0] * rsc, v1 = acc[ai][bj][m][1] * rsc;
                        if (act) { f32x2 a = gelu_pk((f32x2){v0[0], v0[1]}), b = gelu_pk((f32x2){v0[2], v0[3]}), c = gelu_pk((f32x2){v1[0], v1[1]}), d = gelu_pk((f32x2){v1[2], v1[3]});
                            v0 = (f32x4){a.x, a.y, b.x, b.y}; v1 = (f32x4){c.x, c.y, d.x, d.y};
                            s += ((v0[0] + v0[1]) + (v0[2] + v0[3])) + ((v1[0] + v1[1]) + (v1[2] + v1[3]));
                            ss += ((v0[0] * v0[0] + v0[1] * v0[1]) + (v0[2] * v0[2] + v0[3] * v0[3])) + ((v1[0] * v1[0] + v1[1] * v1[1]) + (v1[2] * v1[2] + v1[3] * v1[3])); }
                        u32x4 w; w.x = cvt_pk_bf16(v0[0], v0[1]); w.y = cvt_pk_bf16(v0[2], v0[3]); w.z = cvt_pk_bf16(v1[0], v1[1]); w.w = cvt_pk_bf16(v1[2], v1[3]);
                        EPI_STORE16(rowp + bj * HALF, w); }
                    if (stats) { s += __shfl_xor(s, 16); ss += __shfl_xor(ss, 16); s += __shfl_xor(s, 32); ss += __shfl_xor(ss, 32);
                        if (fq == 0) *(f32x2*)(sgup + ((size_t)row * 16 + (pn - 4) * 4 + wc) * 2) = (f32x2){s, ss}; } }
        }
    }
};
struct EpiRelu2 {
    static constexpr bool PERM = true, AFTER_DRAIN = false;
    bf16_t* O; int K2; RowScale rs;
    __device__ __forceinline__ void operator()(const f32x4 (&acc)[2][2][4][2], const Unit& u, int wr, int wc, int fr, int fq) const {
        const int rl0 = wr * 64 + fr;
        bf16_t* base = O + ((size_t)u.pm * (K2 >> 6) + 4 * u.pn + (wc >> 1)) * 16384 + rl0 * 64 + 32 * (wc & 1) + 8 * fq;
#pragma unroll
        for (int ai = 0; ai < 2; ++ai)
#pragma unroll
            for (int m = 0; m < 4; ++m) { const int rl = rl0 + ai * HALF + m * 16;
                const float rsc = rs.get(u.pm, rl);
#pragma unroll
                for (int bj = 0; bj < 2; ++bj) { f32x4 v0 = acc[ai][bj][m][0] * rsc, v1 = acc[ai][bj][m][1] * rsc;
                    v0 = __builtin_elementwise_max(v0, (f32x4){0.f, 0.f, 0.f, 0.f}); v1 = __builtin_elementwise_max(v1, (f32x4){0.f, 0.f, 0.f, 0.f}); v0 = v0 * v0; v1 = v1 * v1;
                    u32x4 w; w.x = cvt_pk_bf16(v0[0], v0[1]); w.y = cvt_pk_bf16(v0[2], v0[3]); w.z = cvt_pk_bf16(v1[0], v1[1]); w.w = cvt_pk_bf16(v1[2], v1[3]);
                    EPI_STORE16(base + 64 * (ai * HALF + m * 16) + 32768 * bj, w); } }
    }
};
struct EpiResB {
    static constexpr bool PERM = true, AFTER_DRAIN = false;
    bf16_t* X; int ldc; float* part;
    __device__ __forceinline__ void operator()(const f32x4 (&acc)[2][2][4][2], const Unit& u, int wr, int wc, int fr, int fq) const {
        const int row0 = u.pm * BM + wr * 64 + fr, col0 = u.pn * BM + wc * 32 + 8 * fq;
        u32x4 nb[2];
        { const bf16_t* rp = X + (size_t)row0 * ldc + col0; nb[0] = *(const u32x4*)(rp); nb[1] = *(const u32x4*)(rp + HALF); }
#pragma unroll
        for (int gi = 0; gi < 8; ++gi) { const int ai = gi >> 2, m = gi & 3;
            const int row = row0 + ai * HALF + m * 16; bf16_t* rowp = X + (size_t)row * ldc + col0;
            u32x4 b[2]; b[0] = nb[0]; b[1] = nb[1];
            if (gi < 7) { const bf16_t* rp = X + (size_t)(row0 + ((gi + 1) >> 2) * HALF + ((gi + 1) & 3) * 16) * ldc + col0; nb[0] = *(const u32x4*)(rp); nb[1] = *(const u32x4*)(rp + HALF); }
            float ss = 0.f;
#pragma unroll
            for (int bj = 0; bj < 2; ++bj) {
                f32x4 v0 = acc[ai][bj][m][0], v1 = acc[ai][bj][m][1];
                v0[0] += __uint_as_float(b[bj].x << 16); v0[1] += __uint_as_float(b[bj].x & 0xffff0000u); v0[2] += __uint_as_float(b[bj].y << 16); v0[3] += __uint_as_float(b[bj].y & 0xffff0000u);
                v1[0] += __uint_as_float(b[bj].z << 16); v1[1] += __uint_as_float(b[bj].z & 0xffff0000u); v1[2] += __uint_as_float(b[bj].w << 16); v1[3] += __uint_as_float(b[bj].w & 0xffff0000u);
                ss += ((v0[0] * v0[0] + v0[1] * v0[1]) + (v0[2] * v0[2] + v0[3] * v0[3])) + ((v1[0] * v1[0] + v1[1] * v1[1]) + (v1[2] * v1[2] + v1[3] * v1[3]));
                u32x4 w; w.x = cvt_pk_bf16(v0[0], v0[1]); w.y = cvt_pk_bf16(v0[2], v0[3]); w.z = cvt_pk_bf16(v1[0], v1[1]); w.w = cvt_pk_bf16(v1[2], v1[3]);
                *(u32x4*)(rowp + bj * HALF) = w; }
            ss += __shfl_xor(ss, 16); ss += __shfl_xor(ss, 32);
            if (fq == 0) part[(size_t)row * 64 + u.pn * 4 + wc] = ss; }
    }
};
struct EpiNone {
    static constexpr bool PERM = true, AFTER_DRAIN = false;
    float* sink;
    __device__ __forceinline__ void operator()(const f32x4 (&acc)[2][2][4][2], const Unit& u, int wr, int wc, int fr, int fq) const {
        f32x4 s = (f32x4){0.f, 0.f, 0.f, 0.f};
#pragma unroll
        for (int ai = 0; ai < 2; ++ai)
#pragma unroll
            for (int bj = 0; bj < 2; ++bj)
#pragma unroll
                for (int m = 0; m < 4; ++m)
#pragma unroll
                    for (int n = 0; n < 2; ++n) s += acc[ai][bj][m][n];
        if (u.pm < 0) sink[threadIdx.x] = (s[0] + s[1]) + (s[2] + s[3]);
    }
};
struct SameTileOrder : StaticOrder {
    __host__ __device__ bool next(int i, Unit& u) const { Unit t; const bool ok = StaticOrder::next(i, t);
#if defined(PROBE_G) && PROBE_G == 4
        u.pm = 0; u.pn = t.pn;
#elif defined(PROBE_G) && PROBE_G == 5
        u.pm = t.pm; u.pn = 0;
#else
        u.pm = 0; u.pn = 0;
#endif
        return ok; }
};
struct BlockOrder {
    int nN, nU, c;
    __host__ __device__ void init(int M, int N, int, int c_) { nN = N / BM; nU = (M / BM) * nN; c = c_; }
    __host__ __device__ int rp0() const { return 4 * ((c & 7) >> 1) + ((c >> 3) & 3); }
    __host__ __device__ bool next(int i, Unit& u) const {
        const int xcd = c & 7, j = c >> 3, L = 256 * i + (8 * (xcd & 1) + (j >> 2)) * 16 + 4 * (xcd >> 1) + (j & 3);
        if (L >= nU) return false;
        const int rb = L / (16 * nN), rem = L - rb * 16 * nN;
        u.pm = 16 * rb + (rem & 15); u.pn = rem >> 4; return true;
    }
    __device__ __forceinline__ void a_ready(const Unit&) const {}
    __device__ __forceinline__ void done(const Unit&) const {}
};
template <int MODE> struct EpiProbe {
    static constexpr bool PERM = true, AFTER_DRAIN = false;
    bf16_t* O; int ldc; RowScale rs;
    __device__ __forceinline__ void operator()(const f32x4 (&acc)[2][2][4][2], const Unit& u, int wr, int wc, int fr, int fq) const {
        const int row0 = u.pm * BM + wr * 64 + fr, col0 = u.pn * BM + wc * 32 + 8 * fq;
        bf16_t* cbase = O + ((size_t)(u.pm * 32 + u.pn) * 8 + (wr * 4 + wc)) * 8192 + (fq * 16 + fr) * 8;
        f32x4 keep = (f32x4){0.f, 0.f, 0.f, 0.f};
#pragma unroll
        for (int ai = 0; ai < 2; ++ai)
#pragma unroll
            for (int m = 0; m < 4; ++m) { bf16_t* rowp = O + (size_t)(row0 + ai * HALF + m * 16) * ldc + col0;
                const float rsc = rs.get(u.pm, wr * 64 + fr + ai * HALF + m * 16);
#pragma unroll
                for (int bj = 0; bj < 2; ++bj) { f32x4 v0 = acc[ai][bj][m][0] * rsc, v1 = acc[ai][bj][m][1] * rsc;
                    v0 = __builtin_elementwise_max(v0, (f32x4){0.f, 0.f, 0.f, 0.f}); v1 = __builtin_elementwise_max(v1, (f32x4){0.f, 0.f, 0.f, 0.f}); v0 = v0 * v0; v1 = v1 * v1;
                    u32x4 w; w.x = cvt_pk_bf16(v0[0], v0[1]); w.y = cvt_pk_bf16(v0[2], v0[3]); w.z = cvt_pk_bf16(v1[0], v1[1]); w.w = cvt_pk_bf16(v1[2], v1[3]);
                    if (MODE == 0) *(u32x4*)(rowp + bj * HALF) = w;
                    else if (MODE == 1) *(u32x4*)(cbase + ((ai * 4 + m) * 2 + bj) * 512) = w;
                    else keep += v0 + v1; } }
        if (MODE == 2 && u.pm < 0) *(f32x4*)(O + threadIdx.x * 8) = keep;
    }
};
template <int W> struct StaticOrderW {
    int nM, nN, nwg, G, c;
    __host__ __device__ void init(int M, int N, int G_, int c_) { nM = M / BM; nN = N / BM; nwg = nM * nN; G = G_; c = c_; }
    __host__ __device__ bool next(int i, Unit& u) const {
        const long L = (long)i * G + c; if (L >= nwg) return false;
        int wgid = (int)L; { const int q = nwg / NXCD, xcd = wgid % NXCD, off = wgid / NXCD; wgid = xcd * q + off; }
        const int nig = W * nN, gid = wgid / nig, fm = gid * W;
        u.pm = fm + ((wgid % nig) % W); u.pn = (wgid % nig) / W; return true;
    }
    __device__ __forceinline__ void a_ready(const Unit&) const {}
    __device__ __forceinline__ void done(const Unit&) const {}
};
template <class Epi, class Sched, bool ALIGN_EPI = false, bool SP2 = false, bool ABLK = false, bool BBLK = false, int AUXA = 0, int AUXB = 0>
__device__ __forceinline__ void gemm_phase(PG8_LAS unsigned char* lds, const Gemm g, const Sched& S, const Epi& E) {
    int tid = hw_tid(lds); asm volatile("" : "+v"(tid));
    const int wid = __builtin_amdgcn_readfirstlane(tid >> 6), lane = tid & 63, wr = wid >> 2, wc = wid & 3, fr = lane & 15, fq = lane >> 4;
    const int K = g.K, nt = K / BK;
    unsigned voffA[2], voffB[2];
#pragma unroll
    for (int i = 0; i < 2; ++i) { int R, C; stage_rc(tid * 16 + i * 8192, R, C); const int Rb = Epi::PERM ? ((R & ~31) + perm32(R & 31)) : R;
        voffA[i] = (unsigned)(R * (ABLK ? 64 : g.lda) + C) * 2u; voffB[i] = (unsigned)(Rb * (BBLK ? 64 : g.ldb) + C) * 2u; }
    const size_t kstepA = ABLK ? 32768 : 128, kstepB = BBLK ? 32768 : 128;
    const size_t hstepA = (size_t)HALF * (ABLK ? 64 : g.lda) * 2, hstepB = (size_t)HALF * (BBLK ? 64 : g.ldb) * 2;
    const size_t tstepA = ABLK ? (size_t)(K / 64) * 32768 : (size_t)256 * g.lda * 2, tstepB = BBLK ? (size_t)(K / 64) * 32768 : (size_t)256 * g.ldb * 2;
    const unsigned ldsw = (unsigned)wid * 1024u;
    const int aoff = lds_byte(wr * 64 + fr, fq * 8), boff = lds_byte(wc * 32 + fr, fq * 8);
#define PG8_SA(b, h) (((b) * 2 + (h)) * HTB)
#define PG8_SB(b, h) ((4 + (b) * 2 + (h)) * HTB)
#define PG8_STAGE_X(bufoff, gbase, voff, AUX) do { _Pragma("unroll") for (int _i = 0; _i < 2; ++_i) \
        __builtin_amdgcn_global_load_lds((const unsigned*)((const char*)(gbase) + (voff)[_i]), (PG8_LAS unsigned*)(lds + (bufoff) + ldsw + _i * 8192), 16, 0, AUX); } while (0)
#define PG8_STAGEA(bufoff, gbase, voff) PG8_STAGE_X(bufoff, gbase, voff, AUXA)
#define PG8_STAGEB(bufoff, gbase, voff) PG8_STAGE_X(bufoff, gbase, voff, AUXB)
#define PG8_LDA(dst, b, h) do { _Pragma("unroll") for (int m = 0; m < 4; ++m) _Pragma("unroll") for (int k = 0; k < 2; ++k) dst[m][k] = *(const PG8_LAS bf16x8*)(lds + PG8_SA(b, h) + aoff + m * 2048 + k * 1024); } while (0)
#define PG8_LDB(dst, b, h) do { _Pragma("unroll") for (int n = 0; n < 2; ++n) _Pragma("unroll") for (int k = 0; k < 2; ++k) dst[n][k] = *(const PG8_LAS bf16x8*)(lds + PG8_SB(b, h) + boff + n * 2048 + k * 1024); } while (0)
#define PG8_STR2(x) #x
#define PG8_STR(x) PG8_STR2(x)
#ifndef GEMM_RELAX
#define GEMM_RELAX 0
#endif
#ifndef GEMM_PRIO_MODE
#define GEMM_PRIO_MODE 0
#endif
#define PG8_MMA(ai, bj, At, Bt) do { if (GEMM_PRIO_MODE == 0) __builtin_amdgcn_s_setprio(1); _Pragma("unroll") for (int m = 0; m < 4; ++m) _Pragma("unroll") for (int n = 0; n < 2; ++n) _Pragma("unroll") for (int k = 0; k < 2; ++k) \
        acc[ai][bj][m][n] = __builtin_amdgcn_mfma_f32_16x16x32_bf16(Bt[n][k], At[m][k], acc[ai][bj][m][n], 0, 0, 0); if (GEMM_PRIO_MODE == 0) __builtin_amdgcn_s_setprio(0); } while (0)
#define PG8_WAIT_V(n) asm volatile("s_waitcnt vmcnt(" #n ")" ::: "memory")
#define PG8_WAIT_VR(n, nr, flag) asm volatile("s_cmp_eq_u32 %0, 0\n\ts_cbranch_scc1 .Lpg8s%=\n\ts_waitcnt vmcnt(" #nr ")\n\ts_branch .Lpg8d%=\n.Lpg8s%=:\n\ts_waitcnt vmcnt(" #n ")\n.Lpg8d%=:" :: "s"(flag) : "memory", "scc")
#define PG8_WAIT_L(n) asm volatile("s_waitcnt lgkmcnt(" #n ")" ::: "memory")
#define PG8_BAR __builtin_amdgcn_s_barrier()
#define PG8_SCHED __builtin_amdgcn_sched_barrier(0)
    Unit cur, nxt; int ui = 0;
    if (!S.next(0, cur)) return;
    if (GEMM_PRIO_MODE == 2 && wr == 1) __builtin_amdgcn_s_setprio(1);
    f32x4 acc[2][2][4][2];
#pragma unroll
    for (int a = 0; a < 2; ++a)
#pragma unroll
        for (int b = 0; b < 2; ++b)
#pragma unroll
            for (int m = 0; m < 4; ++m)
#pragma unroll
                for (int n = 0; n < 2; ++n) acc[a][b][m][n] = (f32x4){0.f, 0.f, 0.f, 0.f};
    bf16x8 At[4][2], B0[2][2], B1[2][2];
    const char* cA = (const char*)g.A + (size_t)cur.pm * tstepA; const char* cB = (const char*)g.Bt + (size_t)cur.pn * tstepB;
    S.a_ready(cur);
    if constexpr (SP2) {
        PG8_STAGEB(PG8_SB(0, 0), cB, voffB); PG8_STAGEB(PG8_SB(0, 1), cB + hstepB, voffB); PG8_STAGEA(PG8_SA(0, 0), cA, voffA); PG8_STAGEA(PG8_SA(0, 1), cA + hstepA, voffA);
        if (wr == 1) PG8_BAR;
        PG8_WAIT_V(2); PG8_BAR;
        PG8_STAGEB(PG8_SB(1, 0), cB + kstepB, voffB); PG8_STAGEA(PG8_SA(1, 0), cA + kstepA, voffA); PG8_STAGEB(PG8_SB(1, 1), cB + hstepB + kstepB, voffB);
        PG8_WAIT_V(6); PG8_BAR;
    } else {
        PG8_STAGEB(PG8_SB(0, 0), cB, voffB); PG8_STAGEA(PG8_SA(0, 0), cA, voffA); PG8_STAGEB(PG8_SB(0, 1), cB + hstepB, voffB); PG8_STAGEA(PG8_SA(0, 1), cA + hstepA, voffA);
        if (wr == 1) PG8_BAR;
        PG8_WAIT_V(4); PG8_BAR;
        PG8_STAGEB(PG8_SB(1, 0), cB + kstepB, voffB); PG8_STAGEA(PG8_SA(1, 0), cA + kstepA, voffA); PG8_STAGEB(PG8_SB(1, 1), cB + hstepB + kstepB, voffB);
        PG8_WAIT_V(6); PG8_BAR;
    }
    for (;;) {
        const bool has_next = S.next(ui + 1, nxt);
        const char* nA = has_next ? (const char*)g.A + (size_t)nxt.pm * tstepA : cA; const char* nB = has_next ? (const char*)g.Bt + (size_t)nxt.pn * tstepB : cB;
        int t0 = 0;
        if constexpr (SP2 && GEMM_RELAX == 1) { if (ui > 0) {
            const char* a1 = cA + kstepA; const char* a2 = cA + 2 * kstepA; const char* b2 = cB + 2 * kstepB; const char* a3 = a2 + kstepA; const char* b3 = b2 + kstepB;
            PG8_LDB(B0, 0, 0); PG8_LDB(B1, 0, 1); PG8_SCHED; PG8_LDA(At, 0, 0); PG8_STAGEA(PG8_SA(1, 1), a1 + hstepA, voffA);
            PG8_WAIT_V(24); PG8_WAIT_L(0); PG8_BAR; PG8_MMA(0, 0, At, B0); PG8_MMA(0, 1, At, B1); PG8_BAR; PG8_SCHED;
            PG8_LDA(At, 0, 1); PG8_STAGEB(PG8_SB(0, 0), b2, voffB); PG8_STAGEB(PG8_SB(0, 1), b2 + hstepB, voffB); PG8_STAGEA(PG8_SA(0, 0), a2, voffA);
            PG8_WAIT_V(24); PG8_WAIT_L(0); PG8_BAR; PG8_MMA(1, 0, At, B0); PG8_MMA(1, 1, At, B1); PG8_BAR; PG8_SCHED;
            PG8_LDB(B0, 1, 0); PG8_LDB(B1, 1, 1); PG8_SCHED; PG8_LDA(At, 1, 0); PG8_STAGEA(PG8_SA(0, 1), a2 + hstepA, voffA);
            PG8_WAIT_V(8); PG8_WAIT_L(0); PG8_BAR; PG8_MMA(0, 0, At, B0); PG8_MMA(0, 1, At, B1); PG8_BAR; PG8_SCHED;
            PG8_LDA(At, 1, 1); PG8_STAGEB(PG8_SB(1, 0), b3, voffB); PG8_STAGEB(PG8_SB(1, 1), b3 + hstepB, voffB); PG8_STAGEA(PG8_SA(1, 0), a3, voffA);
            PG8_WAIT_V(8); PG8_WAIT_L(0); PG8_BAR; PG8_MMA(1, 0, At, B0); PG8_MMA(1, 1, At, B1); PG8_BAR; PG8_SCHED;
            t0 = 2; } }
#if defined(GEMM_LOOP_ALIGN)
        asm volatile(".p2align " PG8_STR(GEMM_LOOP_ALIGN) ::: "memory");
#endif
        for (int t = t0; t < nt; t += 2) {
            const bool last = (t == nt - 2);
            const char* a1 = cA + (size_t)(t + 1) * kstepA;
            const char* a2 = last ? nA : cA + (size_t)(t + 2) * kstepA; const char* b2 = last ? nB : cB + (size_t)(t + 2) * kstepB;
            const char* a3 = a2 + kstepA; const char* b3 = b2 + kstepB;
            if (last && has_next) S.a_ready(nxt);
            if constexpr (SP2) {
            PG8_LDB(B0, 0, 0); PG8_LDB(B1, 0, 1); PG8_SCHED; PG8_LDA(At, 0, 0); PG8_STAGEA(PG8_SA(1, 1), a1 + hstepA, voffA);
#if GEMM_RELAX == 2
            const int relax = __builtin_amdgcn_readfirstlane((t == 0 && ui > 0) ? 1 : 0);
            PG8_WAIT_VR(8, 24, relax); PG8_WAIT_L(0); PG8_BAR; PG8_MMA(0, 0, At, B0); PG8_MMA(0, 1, At, B1); PG8_BAR; PG8_SCHED;
#else
            PG8_WAIT_V(8); PG8_WAIT_L(0); PG8_BAR; PG8_MMA(0, 0, At, B0); PG8_MMA(0, 1, At, B1); PG8_BAR; PG8_SCHED;
#endif
            PG8_LDA(At, 0, 1); PG8_STAGEB(PG8_SB(0, 0), b2, voffB); PG8_STAGEB(PG8_SB(0, 1), b2 + hstepB, voffB); PG8_STAGEA(PG8_SA(0, 0), a2, voffA);
#if GEMM_RELAX == 2
            PG8_WAIT_VR(8, 24, relax); PG8_WAIT_L(0); PG8_BAR; PG8_MMA(1, 0, At, B0); PG8_MMA(1, 1, At, B1); PG8_BAR; PG8_SCHED;
#else
            PG8_WAIT_V(8); PG8_WAIT_L(0); PG8_BAR; PG8_MMA(1, 0, At, B0); PG8_MMA(1, 1, At, B1); PG8_BAR; PG8_SCHED;
#endif
            PG8_LDB(B0, 1, 0); PG8_LDB(B1, 1, 1); PG8_SCHED; PG8_LDA(At, 1, 0); PG8_STAGEA(PG8_SA(0, 1), a2 + hstepA, voffA);
            PG8_WAIT_V(8); PG8_WAIT_L(0); PG8_BAR; PG8_MMA(0, 0, At, B0); PG8_MMA(0, 1, At, B1); PG8_BAR; PG8_SCHED;
            PG8_LDA(At, 1, 1); PG8_STAGEB(PG8_SB(1, 0), b3, voffB); PG8_STAGEB(PG8_SB(1, 1), b3 + hstepB, voffB); PG8_STAGEA(PG8_SA(1, 0), a3, voffA);
            PG8_WAIT_V(8); PG8_WAIT_L(0); PG8_BAR; PG8_MMA(1, 0, At, B0); PG8_MMA(1, 1, At, B1); PG8_BAR; PG8_SCHED;
            } else {
            PG8_LDB(B0, 0, 0); PG8_SCHED; PG8_LDA(At, 0, 0); PG8_STAGEA(PG8_SA(1, 1), a1 + hstepA, voffA);
            PG8_WAIT_L(8); PG8_BAR; PG8_WAIT_L(0); PG8_MMA(0, 0, At, B0); PG8_BAR; PG8_SCHED;
            PG8_LDB(B1, 0, 1); PG8_STAGEB(PG8_SB(0, 0), b2, voffB);
            PG8_BAR; PG8_WAIT_L(0); PG8_MMA(0, 1, At, B1); PG8_BAR;
            PG8_LDA(At, 0, 1); PG8_STAGEA(PG8_SA(0, 0), a2, voffA);
            PG8_BAR; PG8_WAIT_L(0); PG8_MMA(1, 0, At, B0); PG8_BAR; PG8_SCHED;
            PG8_STAGEB(PG8_SB(0, 1), b2 + hstepB, voffB);
            PG8_WAIT_V(6); PG8_BAR; PG8_MMA(1, 1, At, B1); PG8_BAR;
            PG8_LDB(B0, 1, 0); PG8_SCHED; PG8_LDA(At, 1, 0); PG8_STAGEA(PG8_SA(0, 1), a2 + hstepA, voffA);
            PG8_WAIT_L(8); PG8_BAR; PG8_WAIT_L(0); PG8_MMA(0, 0, At, B0); PG8_BAR; PG8_SCHED;
            PG8_LDB(B1, 1, 1); PG8_STAGEB(PG8_SB(1, 0), b3, voffB);
            PG8_BAR; PG8_WAIT_L(0); PG8_MMA(0, 1, At, B1); PG8_BAR;
            PG8_LDA(At, 1, 1); PG8_STAGEA(PG8_SA(1, 0), a3, voffA);
            PG8_BAR; PG8_WAIT_L(0); PG8_MMA(1, 0, At, B0); PG8_BAR; PG8_SCHED;
            PG8_STAGEB(PG8_SB(1, 1), b3 + hstepB, voffB);
            PG8_WAIT_V(6); PG8_BAR; PG8_MMA(1, 1, At, B1); PG8_BAR;
            }
        }
        if constexpr (ALIGN_EPI) { if (wr == 0) PG8_BAR; }
        if constexpr (!Epi::AFTER_DRAIN) { E(acc, cur, wr, wc, fr, fq); S.done(cur); }
        if (!has_next) break;
#pragma unroll
        for (int a = 0; a < 2; ++a)
#pragma unroll
            for (int b = 0; b < 2; ++b)
#pragma unroll
                for (int m = 0; m < 4; ++m)
#pragma unroll
                    for (int n = 0; n < 2; ++n) acc[a][b][m][n] = (f32x4){0.f, 0.f, 0.f, 0.f};
        cur = nxt; cA = nA; cB = nB; ++ui;
        if constexpr (ALIGN_EPI) { if (wr == 1) PG8_BAR; }
    }
    PG8_WAIT_V(0);
    if constexpr (!ALIGN_EPI) { if (wr == 0) PG8_BAR; }
    PG8_BAR;
    if (GEMM_PRIO_MODE == 2) __builtin_amdgcn_s_setprio(0);
    if constexpr (Epi::AFTER_DRAIN) { E.fused(acc, cur, wr, wc, fr, fq, lds, wid, lane); S.done(cur); }
#undef PG8_SA
#undef PG8_SB
#undef PG8_STAGE_X
#undef PG8_STAGEA
#undef PG8_STAGEB
#undef PG8_LDA
#undef PG8_LDB
#undef PG8_MMA
#undef PG8_WAIT_V
#undef PG8_WAIT_VR
#undef PG8_WAIT_L
#undef PG8_BAR
#undef PG8_SCHED
}
}
constexpr int BATCH = 4, SEQ = 4096, DM = 4096, DEPTH = 2, HDIM = 128, CHUNK = 128, NCH = SEQ / CHUNK;
constexpr int M = BATCH * SEQ;
constexpr int DFF = 4 * DM;
#ifndef PITCH_PAD
#define PITCH_PAD 64
#endif
constexpr int LDH = DFF + PITCH_PAD;
constexpr int INW = 9216;
constexpr int C_U = 0, C_V = 1024, C_RQ = 2048, C_RK = 3072, C_RV = 4096, C_RG = 5120, C_AQ = 6144, C_AK = 8192, C_AV = 8704;
constexpr int MIX_A = 0, MIX_R = 1024, MIX_C = 2048;
constexpr int NRH = 8, NQH = 16, NSG = 8;
constexpr float NORM_EPS = 1e-5f;
constexpr float QK_SCALE = 0.08838834764831845f;
constexpr float LOG2E = 1.4426950408889634f;

constexpr size_t MiB = 1u << 20;
constexpr size_t WS_CTL = 0, CTL_ZERO_BYTES = 1 * MiB;
constexpr size_t WS_COS = 1 * MiB, WS_SIN = 2 * MiB;
constexpr size_t WS_WIN = 4 * MiB;
constexpr size_t WS_WOUT = WS_WIN + 144 * MiB;
constexpr size_t WS_WUP = WS_WOUT + 64 * MiB;
constexpr size_t WS_WDN = WS_WUP + 256 * MiB;
constexpr size_t WS_H = WS_WDN + 260 * MiB;
constexpr size_t WS_PROJ = WS_H + 128 * MiB;
constexpr size_t WS_MIX = WS_PROJ + 288 * MiB;
constexpr size_t WS_HID = WS_MIX + 128 * MiB;
constexpr size_t WS_ST = WS_HID;
constexpr size_t WS_RSA = WS_HID + 520 * MiB;
constexpr size_t WS_RSB = WS_RSA + 4 * MiB;
constexpr size_t WS_SGUP = WS_RSB + 4 * MiB;
constexpr size_t WS_END = WS_SGUP + 2 * MiB;
static_assert(WS_END == 1802 * MiB && (size_t)M * LDH * 2 <= 520 * MiB && (size_t)DEPTH * DM * LDH * 2 <= 260 * MiB, "ws map");
constexpr int CW_BAR = 4096;
constexpr int CW_Q = 16384;

constexpr int RSTD_OFF = 131072;
constexpr int RING_BYTES = 139264;
constexpr int LDSCTL_OFF = RING_BYTES, MISC_OFF = LDSCTL_OFF + 320;
constexpr int LDS_BYTES = 147456;
constexpr int NWAVES = 8;

#define GAS __attribute__((address_space(1)))
#define LAS __attribute__((address_space(3)))
typedef unsigned short bf16;
typedef unsigned v4u __attribute__((ext_vector_type(4)));
typedef unsigned v2u __attribute__((ext_vector_type(2)));
typedef float f32x4 __attribute__((ext_vector_type(4)));
typedef short bf16x8 __attribute__((ext_vector_type(8)));
typedef short s16x4 __attribute__((ext_vector_type(4)));
typedef LAS unsigned char* ldsp;
#define LDS_WAIT() asm volatile("s_waitcnt lgkmcnt(0)" ::: "memory")
#define VM_WAIT() asm volatile("s_waitcnt vmcnt(0)" ::: "memory")
using pg8::cvt_pk_bf16; using pg8::hw_tid; using pg8::hw_slot; using pg8::HWTAB_OFF;
__device__ __forceinline__ float bf_lo(unsigned w) { return __uint_as_float(w << 16); }
__device__ __forceinline__ float bf_hi(unsigned w) { return __uint_as_float(w & 0xffff0000u); }

#define XB_TMO      128
#define XB_XCNT(j)  (256  + 64 * (j))
#define XB_XSUB(j)  (1280 + 64 * (j))
#define XB_XGEN(j)  (2304 + 64 * (j))
#define XB_TOP      3328
#define XB_TOPGEN   3392
#define XCD_BAR_WORDS 3456
#define XB_SPIN_CAP (1u << 18)

__device__ __forceinline__ unsigned xb_ld(unsigned* p)              { return __hip_atomic_load(p, __ATOMIC_RELAXED, __HIP_MEMORY_SCOPE_AGENT); }
__device__ __forceinline__ unsigned xb_add(unsigned* p, unsigned v) { return __hip_atomic_fetch_add(p, v, __ATOMIC_RELAXED, __HIP_MEMORY_SCOPE_AGENT); }
__device__ __forceinline__ unsigned xb_xcc_id() { return (unsigned)__builtin_amdgcn_s_getreg((3 << 11) | 20) & 0xFu; }
#define XB_SPIN(cond, bar) do { unsigned _sp = 0; while (cond) { __builtin_amdgcn_s_sleep(1); \
    if ((++_sp & 255u) == 0u) { if (xb_ld(&(bar)[XB_TMO])) break; if (_sp > XB_SPIN_CAP) { atomicAdd(&(bar)[XB_TMO], 1u); break; } } } } while (0)

#define XB_TID0(st_) (hw_tid((__attribute__((address_space(3))) unsigned char*)(st_) - (139264 + 320 + 32)) == 0)
struct XcdBarrier {
    unsigned* bar; unsigned x;
    volatile LAS unsigned* st;
};

__device__ __forceinline__ XcdBarrier xcd_barrier_post(unsigned* bar, volatile LAS unsigned* st) {
    XcdBarrier b; b.bar = bar; b.x = xb_xcc_id(); b.st = st;
    if (XB_TID0(st)) (void)xb_add(&bar[XB_XCNT(b.x)], 1u);
    return b;
}
__device__ __forceinline__ void xcd_barrier_complete(unsigned* bar, unsigned x, unsigned& nloc, unsigned& nx) {
    const unsigned G = gridDim.x * gridDim.y * gridDim.z;
    unsigned sum, cnt, mine, sp = 0u;
    for (;;) {
        sum = 0u; cnt = 0u; mine = 0u;
#pragma unroll
        for (unsigned j = 0; j < 16; ++j) { const unsigned c = xb_ld(&bar[XB_XCNT(j)]); sum += c; cnt += (c > 0u) ? 1u : 0u; mine = (j == x) ? c : mine; }
        if (sum == G) break;
        __builtin_amdgcn_s_sleep(1);
        if ((++sp & 255u) == 0u) { if (xb_ld(&bar[XB_TMO])) break; if (sp > XB_SPIN_CAP) { atomicAdd(&bar[XB_TMO], 1u); break; } }
    }
    nloc = mine > 0u ? mine : 1u; nx = cnt > 0u ? cnt : 1u;
}

__device__ __forceinline__ void xcd_barrier(const XcdBarrier& b) {
    asm volatile("s_waitcnt vmcnt(0)" ::: "memory");
    __syncthreads();
    if (XB_TID0(b.st)) {
        unsigned* bar = b.bar;
        __builtin_amdgcn_s_waitcnt(0);
        unsigned nloc = b.st[0], nx = b.st[1];
        if (nloc == 0u) { xcd_barrier_complete(bar, b.x, nloc, nx); b.st[0] = nloc; b.st[1] = nx; }
        const unsigned old = xb_add(&bar[XB_XSUB(b.x)], 1u);
        const unsigned gen = old / nloc;
        if (old + 1u == (gen + 1u) * nloc) {
            __builtin_amdgcn_fence(__ATOMIC_RELEASE, "agent");
            asm volatile("s_waitcnt vmcnt(0)" ::: "memory");
            const unsigned og = xb_add(&bar[XB_TOP], 1u);
            const unsigned tg = og / nx;
            if (og + 1u == (tg + 1u) * nx) xb_add(&bar[XB_TOPGEN], 1u);
            else XB_SPIN(xb_ld(&bar[XB_TOPGEN]) == tg, bar);
            __builtin_amdgcn_fence(__ATOMIC_ACQUIRE, "agent");
            xb_add(&bar[XB_XGEN(b.x)], 1u);
            asm volatile("s_waitcnt vmcnt(0)" ::: "memory");
        } else {
            XB_SPIN(xb_ld(&bar[XB_XGEN(b.x)]) == gen, bar);
            __builtin_amdgcn_fence(__ATOMIC_ACQUIRE, "agent");
            asm volatile("s_waitcnt vmcnt(0)" ::: "memory");
        }
    }
    __syncthreads();
}
constexpr unsigned TP = 272u, TILE_BYTES = 128u * TP;
__device__ __forceinline__ unsigned offb(unsigned row, unsigned ch) { return TP * row + 16u * ch; }
__device__ __forceinline__ bf16x8 frag_row(ldsp rb, int idx, int ks) { return *(const LAS bf16x8*)(rb + 16u * TP * idx + 64u * ks); }
__device__ __forceinline__ bf16x8 frag_tr(ldsp tb, int idx, int ks) {
    const s16x4 lo = __builtin_bit_cast(s16x4, __builtin_amdgcn_ds_read_tr16_b64_v4i16((LAS s16x4*)(tb + 32u * TP * ks + 32u * idx)));
    const s16x4 hi = __builtin_bit_cast(s16x4, __builtin_amdgcn_ds_read_tr16_b64_v4i16((LAS s16x4*)(tb + 32u * TP * ks + 4u * TP + 32u * idx)));
    return (bf16x8){lo[0], lo[1], lo[2], lo[3], hi[0], hi[1], hi[2], hi[3]};
}
__device__ __forceinline__ ldsp row_base(ldsp T, int lane) { return T + TP * (unsigned)(lane & 15) + 16u * (unsigned)(lane >> 4); }
__device__ __forceinline__ ldsp tr_base(ldsp T, int lane) { return T + TP * (8u * (unsigned)(lane >> 4) + (((unsigned)lane & 15u) >> 2)) + 8u * ((unsigned)lane & 3u); }
#ifndef ATTN_VFIX
#define ATTN_VFIX 1
#endif
constexpr unsigned TPV = 288u;
__device__ __forceinline__ unsigned offb_v(unsigned row, unsigned ch) { return TPV * row + 128u * ((row >> 3) & 1u) + 128u * (row >> 4) + 16u * ch; }
__device__ __forceinline__ ldsp tr_base_v(ldsp T, int lane) { const unsigned fq = (unsigned)lane >> 4; return T + TPV * (8u * fq + (((unsigned)lane & 15u) >> 2)) + 128u * (fq & 1u) + 128u * (fq >> 1) + 8u * ((unsigned)lane & 3u); }
__device__ __forceinline__ bf16x8 frag_tr_v(ldsp tb, int idx, int ks) {
    const s16x4 lo = __builtin_bit_cast(s16x4, __builtin_amdgcn_ds_read_tr16_b64_v4i16((LAS s16x4*)(tb + (32u * TPV + 256u) * ks + 32u * idx)));
    const s16x4 hi = __builtin_bit_cast(s16x4, __builtin_amdgcn_ds_read_tr16_b64_v4i16((LAS s16x4*)(tb + (32u * TPV + 256u) * ks + 4u * TPV + 32u * idx)));
    return (bf16x8){lo[0], lo[1], lo[2], lo[3], hi[0], hi[1], hi[2], hi[3]};
}
#ifndef MM_SETPRIO
#define MM_SETPRIO 1
#endif
#ifndef ATTN_SPRIO_OLD
#define ATTN_SPRIO_OLD 0
#endif
#ifndef ATTN_SPRIO
#define ATTN_SPRIO 0
#endif
#ifndef ATTN_FULL
#define ATTN_FULL 0
#endif
#ifndef ATTN_RG
#define ATTN_RG 0
#endif
#define ATTN_RG_SKIP (ATTN_RG == 1 || ATTN_RG == 2)
#ifndef PAIR_NOSB
#define PAIR_NOSB 0
#endif
#ifndef PAIR_EARLYKV
#define PAIR_EARLYKV 0
#endif
#ifndef SGU_EARLY
#define SGU_EARLY 0
#endif
#ifndef PAIR_QPRE
#define PAIR_QPRE 0
#endif
#ifndef CVT_DEEP
#define CVT_DEEP 0
#endif
#ifndef ATTN_BIAS
#define ATTN_BIAS 1
#endif
#ifndef ATTN_PIPE
#define ATTN_PIPE 1
#endif
#ifndef ATTN_G
#define ATTN_G 8
#endif
#ifndef MM_G
#define MM_G 8
#endif
#ifndef MM_PIPE
#define MM_PIPE 1
#endif
template <int G, int KS0, int NK, int C0, int NC, class FB, class FA>
__device__ __forceinline__ void mm_pipe(f32x4 (&acc)[8], FB fb, FA fa) {
    constexpr int NS = NK * NC, NG = NS / G;
    static_assert(NS % G == 0, "group size must divide the step count");
    bf16x8 b[2][G];
#pragma unroll
    for (int i = 0; i < G; ++i) b[0][i] = fb(C0 + i % NC, KS0 + i / NC);
    if (NG > 1) {
#pragma unroll
        for (int i = 0; i < G; ++i) b[1][i] = fb(C0 + (G + i) % NC, KS0 + (G + i) / NC); }
#pragma unroll
    for (int g = 0; g < NG; ++g) {
        __builtin_amdgcn_sched_barrier(0);
#pragma unroll
        for (int i = 0; i < G; ++i) { const int st = g * G + i, c = C0 + st % NC, ks = KS0 + st / NC;
            acc[c] = __builtin_amdgcn_mfma_f32_16x16x32_bf16(b[g & 1][i], fa(ks), acc[c], 0, 0, 0); }
        __builtin_amdgcn_sched_barrier(0);
        if (g + 2 < NG) {
#pragma unroll
            for (int i = 0; i < G; ++i) { const int st = (g + 2) * G + i; b[g & 1][i] = fb(C0 + st % NC, KS0 + st / NC); } }
    }
}
template <bool A_TR, bool B_TR>
__device__ __forceinline__ void mm128(f32x4 (&acc)[8], ldsp TA, ldsp TB, int w, int lane) {
    const ldsp ab = A_TR ? tr_base(TA, lane) + 32u * w : row_base(TA, lane) + 16u * TP * w;
    const ldsp bb = B_TR ? tr_base(TB, lane) : row_base(TB, lane);
    if (MM_SETPRIO) __builtin_amdgcn_s_setprio(1);
#if MM_PIPE
    bf16x8 a[4];
#pragma unroll
    for (int ks = 0; ks < 4; ++ks) a[ks] = A_TR ? frag_tr(ab, 0, ks) : frag_row(ab, 0, ks);
    mm_pipe<MM_G, 0, 4, 0, 8>(acc, [&](int c, int ks) { return B_TR ? frag_tr(bb, c, ks) : frag_row(bb, c, ks); }, [&](int ks) { return a[ks]; });
#else
#pragma unroll
    for (int ks = 0; ks < 4; ++ks) {
        const bf16x8 a = A_TR ? frag_tr(ab, 0, ks) : frag_row(ab, 0, ks);
#pragma unroll
        for (int c = 0; c < 8; ++c) {
            const bf16x8 b = B_TR ? frag_tr(bb, c, ks) : frag_row(bb, c, ks);
            acc[c] = __builtin_amdgcn_mfma_f32_16x16x32_bf16(b, a, acc[c], 0, 0, 0);
        }
    }
#endif
    if (MM_SETPRIO) __builtin_amdgcn_s_setprio(0);
}
__device__ __forceinline__ void zero8(f32x4 (&a)[8]) {
#pragma unroll
    for (int c = 0; c < 8; ++c) a[c] = (f32x4){0.f, 0.f, 0.f, 0.f};
}
struct TileRegs { v4u v[4]; };
__device__ __forceinline__ void tile_fetch(TileRegs& t, const bf16* src, size_t ld, int tid) {
#pragma unroll
    for (int i = 0; i < 4; ++i) { const int ck = tid + 512 * i, r = ck >> 4, ch = ck & 15; t.v[i] = *(const v4u*)(src + (size_t)r * ld + 8 * ch); }
}
__device__ __forceinline__ void tile_put(ldsp T, const TileRegs& t, int tid) {
#pragma unroll
    for (int i = 0; i < 4; ++i) { const int ck = tid + 512 * i, r = ck >> 4, ch = ck & 15; *(LAS v4u*)(T + offb(r, ch)) = t.v[i]; }
}
__device__ __forceinline__ void tile_put_v(ldsp T, const TileRegs& t, int tid) {
#pragma unroll
    for (int i = 0; i < 4; ++i) { const int ck = tid + 512 * i, r = ck >> 4, ch = ck & 15; *(LAS v4u*)(T + offb_v(r, ch)) = t.v[i]; }
}
__device__ __forceinline__ void tile_put_scaled(ldsp T, const TileRegs& t, float l2, float a0, float a1, int tid) {
#pragma unroll
    for (int i = 0; i < 4; ++i) { const int ck = tid + 512 * i, r = ck >> 4, ch = ck & 15;
        const float sc = __builtin_amdgcn_exp2f(l2 * (a0 + a1 * (float)r));
        v4u o;
#pragma unroll
        for (int k = 0; k < 4; ++k) o[k] = cvt_pk_bf16(bf_lo(t.v[i][k]) * sc, bf_hi(t.v[i][k]) * sc);
        *(LAS v4u*)(T + offb(r, ch)) = o; }
}
__device__ __forceinline__ void tile_put_frag(ldsp T, const TileRegs& t, int tid) {
#pragma unroll
    for (int i = 0; i < 4; ++i) { const int q = tid + 512 * i; *(LAS v4u*)(T + offb(16 * (q >> 8) + (q & 15), (q >> 4) & 15)) = t.v[i]; }
}
__device__ __forceinline__ void load_tile(ldsp T, const bf16* src, size_t ld, int tid) { TileRegs t; tile_fetch(t, src, ld, tid); tile_put(T, t, tid); }
__device__ __forceinline__ void store_acc_tile(ldsp T, const f32x4 (&a)[8], int w, int lane) {
    const unsigned fr = lane & 15, fq = lane >> 4, row = 16u * w + fr;
#pragma unroll
    for (int c = 0; c < 8; ++c) { v2u v; v[0] = cvt_pk_bf16(a[c][0], a[c][1]); v[1] = cvt_pk_bf16(a[c][2], a[c][3]);
        *(LAS v2u*)(T + offb(row, 2u * c + (fq >> 1)) + 8u * (fq & 1)) = v; }
}
__device__ __forceinline__ float wave_sum(float v) {
#pragma unroll
    for (int o = 1; o < 64; o <<= 1) v += __shfl_xor(v, o);
    return v;
}

__host__ __device__ __forceinline__ bool win_rope_tile(int t) { return (t >= 8 && t < 16) || (t >= 24 && t < 34); }
__host__ __device__ __forceinline__ int win_phys_col(int n) { if (!win_rope_tile(n >> 8)) return n; const int cl = n & 255; return (n & ~255) | (cl & 63) | ((cl & 64) << 1) | ((cl & 128) >> 1); }
template <bool PERMUTE, bool BLOCKED = false>
__device__ __forceinline__ void cvt_tile64(const float* W, int K, int N, bf16* WT, int ldo, const float* gk, LAS float* scr, int tile, int lane) {
    const int nblk = N >> 6, kb = tile / nblk, nb = tile - kb * nblk, k0 = 64 * kb, n0 = 64 * nb;
    const int lk = lane >> 4, ln = (lane & 15) * 4;
#if CVT_DEEP
    {
        f32x4 v[16];
#pragma unroll
        for (int i = 0; i < 16; ++i) v[i] = *(const f32x4*)(W + (size_t)(k0 + 4 * i + lk) * N + n0 + ln);
#pragma unroll
        for (int i = 0; i < 16; ++i) { const int kk = 4 * i + lk; const float g = gk ? gk[k0 + kk] : 1.0f; LAS float* d = scr + kk * 65 + ln;
            d[0] = v[i][0] * g; d[1] = v[i][1] * g; d[2] = v[i][2] * g; d[3] = v[i][3] * g; }
    }
#else
#pragma unroll
    for (int hh = 0; hh < 2; ++hh) {
        f32x4 v[8];
#pragma unroll
        for (int i = 0; i < 8; ++i) v[i] = *(const f32x4*)(W + (size_t)(k0 + 32 * hh + 4 * i + lk) * N + n0 + ln);
#pragma unroll
        for (int i = 0; i < 8; ++i) { const int kk = 32 * hh + 4 * i + lk; const float g = gk ? gk[k0 + kk] : 1.0f; LAS float* d = scr + kk * 65 + ln;
            d[0] = v[i][0] * g; d[1] = v[i][1] * g; d[2] = v[i][2] * g; d[3] = v[i][3] * g; }
    }
#endif
    LDS_WAIT(); asm volatile("" ::: "memory");
    const int kc = lane & 7, nrow0 = PERMUTE ? win_phys_col(n0) : n0;
#pragma unroll
    for (int j = 0; j < 8; ++j) { const int n = (lane >> 3) + 8 * j; const LAS float* s = scr + (8 * kc) * 65 + n;
        v4u o; o[0] = cvt_pk_bf16(s[0 * 65], s[1 * 65]); o[1] = cvt_pk_bf16(s[2 * 65], s[3 * 65]); o[2] = cvt_pk_bf16(s[4 * 65], s[5 * 65]); o[3] = cvt_pk_bf16(s[6 * 65], s[7 * 65]);
        *(v4u*)(WT + (BLOCKED ? pg8::blocked_off(nrow0 + n, k0 + 8 * kc, K) : (size_t)(nrow0 + n) * ldo + k0 + 8 * kc)) = o; }
    LDS_WAIT(); asm volatile("" ::: "memory");
}
struct CvtCtx { const float* w_in; const float* w_out; const float* w_up; const float* w_down; const float* g_mix; const float* g_mlp; bf16* WinT; bf16* WoutT; bf16* WupT; bf16* WdnT; };
constexpr int CVT_IN = (DM / 64) * (INW / 64) / 8, CVT_OUT = (DM / 64) * (DM / 64) / 8, CVT_UP = (DM / 64) * (DFF / 64) / 8, CVT_DN = (DFF / 64) * (DM / 64) / 8;
__host__ __device__ constexpr int cvt_batch_items(int batch) { return batch == 0 ? CVT_OUT + CVT_UP + CVT_DN + CVT_IN : CVT_OUT + CVT_UP + CVT_DN; }
__device__ __forceinline__ void cvt_item(const CvtCtx& c, int batch, int wi, LAS float* scr, int wave, int lane) {
    const int l = batch;
    if (wi < CVT_OUT) { cvt_tile64<false>(c.w_out + (size_t)l * DM * DM, DM, DM, c.WoutT + (size_t)l * DM * DM, DM, nullptr, scr, 8 * wi + wave, lane); return; } wi -= CVT_OUT;
    if (wi < CVT_UP) { cvt_tile64<false>(c.w_up + (size_t)l * DM * DFF, DM, DFF, c.WupT + (size_t)l * DFF * DM, DM, c.g_mlp + l * DM, scr, 8 * wi + wave, lane); return; } wi -= CVT_UP;
    if (wi < CVT_DN) { cvt_tile64<false, true>(c.w_down + (size_t)l * DFF * DM, DFF, DM, c.WdnT + (size_t)l * DM * DFF, 0, nullptr, scr, 8 * wi + wave, lane); return; } wi -= CVT_DN;
    cvt_tile64<true>(c.w_in + (size_t)1 * DM * INW, DM, INW, c.WinT + (size_t)1 * INW * DM, DM, c.g_mix + 1 * DM, scr, 8 * wi + wave, lane);
}
struct KArgs { const float* in[14]; float* out; unsigned char* ws; int ph_lo, ph_hi; };
__device__ __forceinline__ void cvt_step(int batch, int& ci, int nmax, ldsp lds, int tid, int hi = 1 << 30) {
    const int total = cvt_batch_items(batch) < hi ? cvt_batch_items(batch) : hi;
    if (nmax <= 0 || ci >= total) return;
    const int lane = tid & 63, wave = __builtin_amdgcn_readfirstlane(tid >> 6);
    LAS float* scr = (LAS float*)(lds + wave * 16640);
    const __attribute__((address_space(4))) KArgs* ka = (const __attribute__((address_space(4))) KArgs*)__builtin_amdgcn_kernarg_segment_ptr();
    asm volatile("" : "+s"(ka));
    unsigned char* ws = ka->ws;
    const CvtCtx c{ka->in[2], ka->in[9], ka->in[11], ka->in[12], ka->in[1], ka->in[10], (bf16*)(ws + WS_WIN), (bf16*)(ws + WS_WOUT), (bf16*)(ws + WS_WUP), (bf16*)(ws + WS_WDN)};
    __syncthreads();
    for (int r = 0; r < nmax && ci < total; ++r, ci += 256) cvt_item(c, batch, ci, scr, wave, lane);
    __syncthreads();
}

#ifndef ATTN_XCDQ
#define ATTN_XCDQ 0
#endif
__device__ __forceinline__ int attn_next(unsigned* qx, int& cq, int& tries) {
    for (;;) {
        if (tries >= 8) return 1 << 30;
        const unsigned k = __hip_atomic_fetch_add(qx + 64 * cq, 1u, __ATOMIC_RELAXED, __HIP_MEMORY_SCOPE_AGENT);
        if (k < 256u) return cq * 256 + (int)k;
        cq = (cq + 1) & 7; ++tries;
    }
}
struct AttnItem { int hq, n, b, kh, jb0, jb1; size_t row0; };
__device__ __forceinline__ AttnItem attn_decode(int unit) {
    AttnItem a; a.hq = unit & 15; a.n = (unit >> 4) & 31; a.b = unit >> 9; a.kh = a.hq >> 2;
    a.jb0 = a.n > 0 ? a.n - 1 : 0; a.jb1 = a.n < NCH - 1 ? a.n + 1 : NCH - 1; a.row0 = (size_t)a.b * SEQ + (size_t)a.n * CHUNK; return a;
}
template <int VAR = 0>
__device__ __forceinline__ void attn_queue(ldsp lds, const bf16* proj, bf16* mix, const float* sink, unsigned* qw, volatile LAS int* qslot, int nitems, int tid, int batch, int& ci, int cvt_per_item) {
    const int lane = tid & 63, w = __builtin_amdgcn_readfirstlane(tid >> 6), fr = lane & 15, fq = lane >> 4;
    const ldsp TK = lds, TV = ATTN_VFIX ? lds + 2 * TILE_BYTES : lds + TILE_BYTES, TPp = ATTN_VFIX ? lds + TILE_BYTES : lds + 2 * TILE_BYTES;
    const int rg = ATTN_RG ? (w < 4 ? w : 11 - w) : w;
    const int i = 16 * rg + fr;
    const ldsp kb = row_base(TK, lane), pb = row_base(TPp, lane) + 16u * TP * w, vb = ATTN_VFIX ? tr_base_v(TV, lane) : tr_base(TV, lane);
    if (ATTN_SPRIO) { if ((ATTN_SPRIO_OLD ? w < 4 : w >= 4)) __builtin_amdgcn_s_setprio(ATTN_SPRIO); else __builtin_amdgcn_s_setprio(0); }
    int cq = (int)(xb_xcc_id() & 7u), tries = 0;
    __syncthreads();
    if (tid == 0) *qslot = ATTN_XCDQ ? attn_next(qw, cq, tries) : (int)__hip_atomic_fetch_add(qw, 1u, __ATOMIC_RELAXED, __HIP_MEMORY_SCOPE_AGENT);
    __syncthreads();
    int item = *qslot;
    bf16x8 qf[4]; TileRegs rk, rv;
    if (item < nitems) { const AttnItem a = attn_decode(item);
        const bf16* qrow = proj + (a.row0 + i) * INW + C_AQ + a.hq * HDIM + 8 * fq;
#pragma unroll
        for (int ks = 0; ks < 4; ++ks) qf[ks] = *(const bf16x8*)(qrow + 32 * ks);
        const bf16* kv0 = proj + ((size_t)a.b * SEQ + (size_t)a.jb0 * CHUNK) * INW + a.kh * HDIM; tile_fetch(rk, kv0 + C_AK, INW, tid); tile_fetch(rv, kv0 + C_AV, INW, tid); }
    while (item < nitems) {
        const AttnItem a = attn_decode(item);
        int nxt = 0; if (tid == 0) nxt = ATTN_XCDQ ? attn_next(qw, cq, tries) : (int)__hip_atomic_fetch_add(qw, 1u, __ATOMIC_RELAXED, __HIP_MEMORY_SCOPE_AGENT);
        float mrun = sink[a.hq] * LOG2E, lrun = 1.0f;
        f32x4 O[8]; zero8(O);
        int item_next = nitems;
        for (int jb = a.jb0; jb <= a.jb1; ++jb) {
            __syncthreads();
            if (VAR != 4) { tile_put(TK, rk, tid); if (ATTN_VFIX) tile_put_v(TV, rv, tid); else tile_put(TV, rv, tid); }
            if (jb == a.jb1) item_next = *qslot;
            __syncthreads();
            if (VAR != 3 && jb < a.jb1) { const bf16* kv1 = proj + ((size_t)a.b * SEQ + (size_t)(jb + 1) * CHUNK) * INW + a.kh * HDIM; tile_fetch(rk, kv1 + C_AK, INW, tid); tile_fetch(rv, kv1 + C_AV, INW, tid); }
            const int rel = jb - a.n;
            const bool h0 = ATTN_FULL ? true : (rel <= 0 ? (rel == 0 || rg <= 3) : true), h1 = ATTN_FULL ? true : (rel >= 0 ? (rel == 0 || rg >= 4) : true);
            f32x4 S[8];
#if ATTN_BIAS
            { int d0 = i - 4 * fq; asm volatile("" : "+v"(d0));
              if (rel == 0) zero8(S);
              else if (rel < 0) {
#pragma unroll
                  for (int c = 0; c < 8; ++c)
#pragma unroll
                      for (int j = 0; j < 4; ++j) S[c][j] = (16 * c + j >= d0) ? 0.f : -1e30f;
              } else {
#pragma unroll
                  for (int c = 0; c < 8; ++c)
#pragma unroll
                      for (int j = 0; j < 4; ++j) S[c][j] = (16 * c + j <= d0) ? 0.f : -1e30f; } }
#else
            zero8(S);
#endif
#if ATTN_PIPE
            { auto fk = [&](int c, int ks) { return frag_row(kb, c, ks); }; auto fqq = [&](int ks) { return qf[ks]; };
              if (h0 && h1) mm_pipe<ATTN_G, 0, 4, 0, 8>(S, fk, fqq); else if (h0) mm_pipe<ATTN_G, 0, 4, 0, 4>(S, fk, fqq); else mm_pipe<ATTN_G, 0, 4, 4, 4>(S, fk, fqq); }
#elif ATTN_RG_SKIP
#if ATTN_RG == 2
#pragma unroll
            for (int qd = 0; qd < 4; ++qd) {
                if (rel == 0 || (rel < 0 ? 2 * qd + 1 >= rg : 2 * qd <= rg)) {
#pragma unroll
                    for (int ks = 0; ks < 4; ++ks) {
                        S[2 * qd] = __builtin_amdgcn_mfma_f32_16x16x32_bf16(frag_row(kb, 2 * qd, ks), qf[ks], S[2 * qd], 0, 0, 0);
                        S[2 * qd + 1] = __builtin_amdgcn_mfma_f32_16x16x32_bf16(frag_row(kb, 2 * qd + 1, ks), qf[ks], S[2 * qd + 1], 0, 0, 0); } } }
#else
#pragma unroll
            for (int c = 0; c < 8; ++c) {
                if (rel == 0 || (rel < 0 ? c >= rg : c <= rg)) {
#pragma unroll
                    for (int ks = 0; ks < 4; ++ks) S[c] = __builtin_amdgcn_mfma_f32_16x16x32_bf16(frag_row(kb, c, ks), qf[ks], S[c], 0, 0, 0); } }
#endif
#else
            if (VAR != 2 && h0) {
#pragma unroll
                for (int ks = 0; ks < 4; ++ks)
#pragma unroll
                    for (int c = 0; c < 4; ++c) S[c] = __builtin_amdgcn_mfma_f32_16x16x32_bf16(frag_row(kb, c, ks), qf[ks], S[c], 0, 0, 0); }
            if (VAR != 2 && h1) {
#pragma unroll
                for (int ks = 0; ks < 4; ++ks)
#pragma unroll
                    for (int c = 4; c < 8; ++c) S[c] = __builtin_amdgcn_mfma_f32_16x16x32_bf16(frag_row(kb, c, ks), qf[ks], S[c], 0, 0, 0); }
#endif
            if (jb == a.jb0 && tid == 0) *qslot = nxt;
            if (VAR != 3 && jb == a.jb1 && item_next < nitems) {
                const AttnItem an = attn_decode(item_next);
                const bf16* qrow = proj + (an.row0 + i) * INW + C_AQ + an.hq * HDIM + 8 * fq;
#pragma unroll
                for (int ks = 0; ks < 4; ++ks) qf[ks] = *(const bf16x8*)(qrow + 32 * ks);
                const bf16* kv0 = proj + ((size_t)an.b * SEQ + (size_t)an.jb0 * CHUNK) * INW + an.kh * HDIM; tile_fetch(rk, kv0 + C_AK, INW, tid); tile_fetch(rv, kv0 + C_AV, INW, tid); }
            if (VAR == 1) { lrun += S[0][0]; } else {
#if ATTN_BIAS && ATTN_RG_SKIP
            float mx = -1e30f;
#pragma unroll
            for (int c = 0; c < 8; ++c) mx = fmaxf(fmaxf(mx, fmaxf(S[c][0], S[c][1])), fmaxf(S[c][2], S[c][3]));
            mx = fmaxf(mx, __shfl_xor(mx, 16)); mx = fmaxf(mx, __shfl_xor(mx, 32));
            const float mnew = fmaxf(mrun, mx), alpha = __builtin_amdgcn_exp2f(mrun - mnew);
            float rs = 0.f;
#if ATTN_RG == 2
#pragma unroll
            for (int qd = 0; qd < 4; ++qd) {
                if (rel == 0 || (rel < 0 ? 2 * qd + 1 >= rg : 2 * qd <= rg)) {
#pragma unroll
                    for (int c = 2 * qd; c < 2 * qd + 2; ++c)
#pragma unroll
                        for (int j = 0; j < 4; ++j) { const float p = __builtin_amdgcn_exp2f(S[c][j] - mnew); S[c][j] = p; rs += p; }
                } else { S[2 * qd] = (f32x4){0.f, 0.f, 0.f, 0.f}; S[2 * qd + 1] = (f32x4){0.f, 0.f, 0.f, 0.f}; } }
#else
#pragma unroll
            for (int c = 0; c < 8; ++c) {
                if (rel == 0 || (rel < 0 ? c >= rg : c <= rg)) {
#pragma unroll
                    for (int j = 0; j < 4; ++j) { const float p = __builtin_amdgcn_exp2f(S[c][j] - mnew); S[c][j] = p; rs += p; }
                } else S[c] = (f32x4){0.f, 0.f, 0.f, 0.f}; }
#endif
#elif ATTN_BIAS
            float mx = -1e30f;
            if (h0) {
#pragma unroll
                for (int c = 0; c < 4; ++c) mx = fmaxf(fmaxf(mx, fmaxf(S[c][0], S[c][1])), fmaxf(S[c][2], S[c][3])); }
            if (h1) {
#pragma unroll
                for (int c = 4; c < 8; ++c) mx = fmaxf(fmaxf(mx, fmaxf(S[c][0], S[c][1])), fmaxf(S[c][2], S[c][3])); }
            mx = fmaxf(mx, __shfl_xor(mx, 16)); mx = fmaxf(mx, __shfl_xor(mx, 32));
            const float mnew = fmaxf(mrun, mx), alpha = __builtin_amdgcn_exp2f(mrun - mnew);
            float rs = 0.f;
            if (h0) {
#pragma unroll
                for (int c = 0; c < 4; ++c)
#pragma unroll
                    for (int j = 0; j < 4; ++j) { const float p = __builtin_amdgcn_exp2f(S[c][j] - mnew); S[c][j] = p; rs += p; }
            } else {
#pragma unroll
                for (int c = 0; c < 4; ++c) S[c] = (f32x4){0.f, 0.f, 0.f, 0.f}; }
            if (h1) {
#pragma unroll
                for (int c = 4; c < 8; ++c)
#pragma unroll
                    for (int j = 0; j < 4; ++j) { const float p = __builtin_amdgcn_exp2f(S[c][j] - mnew); S[c][j] = p; rs += p; }
            } else {
#pragma unroll
                for (int c = 4; c < 8; ++c) S[c] = (f32x4){0.f, 0.f, 0.f, 0.f}; }
#else
            float mx = -1e30f;
#pragma unroll
            for (int c = 0; c < 8; ++c) {
                if (rel != 0 && c == w) {
#pragma unroll
                    for (int j = 0; j < 4; ++j) { const int col = 16 * c + 4 * fq + j; const bool valid = rel < 0 ? (col >= i) : (col <= i);
                        const float s = valid ? S[c][j] : -1e30f; S[c][j] = s; mx = fmaxf(mx, s); }
                } else if (rel == 0 || (rel < 0 ? c > w : c < w)) {
                    mx = fmaxf(fmaxf(mx, fmaxf(S[c][0], S[c][1])), fmaxf(S[c][2], S[c][3])); } }
            mx = fmaxf(mx, __shfl_xor(mx, 16)); mx = fmaxf(mx, __shfl_xor(mx, 32));
            const float mnew = fmaxf(mrun, mx), alpha = __builtin_amdgcn_exp2f(mrun - mnew);
            float rs = 0.f;
#pragma unroll
            for (int c = 0; c < 8; ++c) {
                if (rel == 0 || (rel < 0 ? c >= w : c <= w)) {
#pragma unroll
                    for (int j = 0; j < 4; ++j) { const float p = __builtin_amdgcn_exp2f(S[c][j] - mnew); S[c][j] = p; rs += p; }
                } else S[c] = (f32x4){0.f, 0.f, 0.f, 0.f}; }
#endif
            rs += __shfl_xor(rs, 16); rs += __shfl_xor(rs, 32);
            lrun = lrun * alpha + rs; mrun = mnew;
#pragma unroll
            for (int c = 0; c < 8; ++c) O[c] = O[c] * alpha;
            }
            store_acc_tile(TPp, S, w, lane);
            LDS_WAIT();
#if ATTN_PIPE
            { bf16x8 pa[4]; auto fv = [&](int c, int ks) { return ATTN_VFIX ? frag_tr_v(vb, c, ks) : frag_tr(vb, c, ks); }; auto fp = [&](int ks) { return pa[ks]; };
              if (h0 && h1) {
#pragma unroll
                  for (int ks = 0; ks < 4; ++ks) pa[ks] = frag_row(pb, 0, ks);
                  mm_pipe<ATTN_G, 0, 4, 0, 8>(O, fv, fp);
              } else if (h0) { pa[0] = frag_row(pb, 0, 0); pa[1] = frag_row(pb, 0, 1); mm_pipe<ATTN_G, 0, 2, 0, 8>(O, fv, fp);
              } else { pa[2] = frag_row(pb, 0, 2); pa[3] = frag_row(pb, 0, 3); mm_pipe<ATTN_G, 2, 2, 0, 8>(O, fv, fp); } }
#elif ATTN_RG_SKIP
#pragma unroll
            for (int ks = 0; ks < 4; ++ks) {
                if (rel == 0 || (rel < 0 ? 2 * ks + 1 >= rg : 2 * ks <= rg)) { const bf16x8 pa = frag_row(pb, 0, ks);
#pragma unroll
                    for (int c = 0; c < 8; ++c) O[c] = __builtin_amdgcn_mfma_f32_16x16x32_bf16(ATTN_VFIX ? frag_tr_v(vb, c, ks) : frag_tr(vb, c, ks), pa, O[c], 0, 0, 0); } }
#else
            if (VAR != 2 && h0) {
#pragma unroll
                for (int ks = 0; ks < 2; ++ks) { const bf16x8 pa = frag_row(pb, 0, ks);
#pragma unroll
                    for (int c = 0; c < 8; ++c) O[c] = __builtin_amdgcn_mfma_f32_16x16x32_bf16(ATTN_VFIX ? frag_tr_v(vb, c, ks) : frag_tr(vb, c, ks), pa, O[c], 0, 0, 0); } }
            if (VAR != 2 && h1) {
#pragma unroll
                for (int ks = 2; ks < 4; ++ks) { const bf16x8 pa = frag_row(pb, 0, ks);
#pragma unroll
                    for (int c = 0; c < 8; ++c) O[c] = __builtin_amdgcn_mfma_f32_16x16x32_bf16(ATTN_VFIX ? frag_tr_v(vb, c, ks) : frag_tr(vb, c, ks), pa, O[c], 0, 0, 0); } }
#endif
        }
        const float inv = 1.0f / lrun;
#pragma unroll
        for (int c = 0; c < 8; ++c) O[c] = O[c] * inv;
        store_acc_tile(TPp, O, w, lane);
        LDS_WAIT();
        bf16* obase = mix + (a.row0 + 16 * rg) * DM + MIX_C + a.hq * HDIM;
#pragma unroll
        for (int k = 0; k < 4; ++k) { const int q = lane + 64 * k, r = q >> 4, ch = q & 15;
            *(v4u*)(obase + (size_t)r * DM + 8 * ch) = *(const LAS v4u*)(TPp + offb(16 * w + r, ch)); }
        item = item_next;
        cvt_step(batch, ci, cvt_per_item, lds, tid);
    }
    if (ATTN_SPRIO) __builtin_amdgcn_s_setprio(0);
}

#ifndef ATTN_PAIR
#define ATTN_PAIR 0
#endif
__device__ __forceinline__ void attn_bias_init(f32x4 (&S)[8], int rel, int d0) {
    if (rel == 0) zero8(S);
    else if (rel < 0) {
#pragma unroll
        for (int c = 0; c < 8; ++c)
#pragma unroll
            for (int j = 0; j < 4; ++j) S[c][j] = (16 * c + j >= d0) ? 0.f : -1e30f;
    } else {
#pragma unroll
        for (int c = 0; c < 8; ++c)
#pragma unroll
            for (int j = 0; j < 4; ++j) S[c][j] = (16 * c + j <= d0) ? 0.f : -1e30f; }
}
__device__ __forceinline__ void attn_softmax_bias(f32x4 (&S)[8], float& mrun, float& lrun, f32x4 (&O)[8], bool h0, bool h1) {
    float mx = -1e30f;
    if (h0) {
#pragma unroll
        for (int c = 0; c < 4; ++c) mx = fmaxf(fmaxf(mx, fmaxf(S[c][0], S[c][1])), fmaxf(S[c][2], S[c][3])); }
    if (h1) {
#pragma unroll
        for (int c = 4; c < 8; ++c) mx = fmaxf(fmaxf(mx, fmaxf(S[c][0], S[c][1])), fmaxf(S[c][2], S[c][3])); }
    mx = fmaxf(mx, __shfl_xor(mx, 16)); mx = fmaxf(mx, __shfl_xor(mx, 32));
    const float mnew = fmaxf(mrun, mx), alpha = __builtin_amdgcn_exp2f(mrun - mnew);
    float rs = 0.f;
    if (h0) {
#pragma unroll
        for (int c = 0; c < 4; ++c)
#pragma unroll
            for (int j = 0; j < 4; ++j) { const float pp = __builtin_amdgcn_exp2f(S[c][j] - mnew); S[c][j] = pp; rs += pp; }
    } else {
#pragma unroll
        for (int c = 0; c < 4; ++c) S[c] = (f32x4){0.f, 0.f, 0.f, 0.f}; }
    if (h1) {
#pragma unroll
        for (int c = 4; c < 8; ++c)
#pragma unroll
            for (int j = 0; j < 4; ++j) { const float pp = __builtin_amdgcn_exp2f(S[c][j] - mnew); S[c][j] = pp; rs += pp; }
    } else {
#pragma unroll
        for (int c = 4; c < 8; ++c) S[c] = (f32x4){0.f, 0.f, 0.f, 0.f}; }
    rs += __shfl_xor(rs, 16); rs += __shfl_xor(rs, 32);
    lrun = lrun * alpha + rs; mrun = mnew;
#pragma unroll
    for (int c = 0; c < 8; ++c) O[c] = O[c] * alpha;
}
__device__ __forceinline__ void attn_softmax_block(f32x4 (&S)[8], float& mrun, float& lrun, f32x4 (&O)[8], int rel, int w, int i, int fq) {
    float mx = -1e30f;
#pragma unroll
    for (int c = 0; c < 8; ++c) {
        if (rel != 0 && c == w) {
#pragma unroll
            for (int j = 0; j < 4; ++j) { const int col = 16 * c + 4 * fq + j; const bool valid = rel < 0 ? (col >= i) : (col <= i);
                const float s = valid ? S[c][j] : -1e30f; S[c][j] = s; mx = fmaxf(mx, s); }
        } else if (rel == 0 || (rel < 0 ? c > w : c < w)) {
            mx = fmaxf(fmaxf(mx, fmaxf(S[c][0], S[c][1])), fmaxf(S[c][2], S[c][3])); } }
    mx = fmaxf(mx, __shfl_xor(mx, 16)); mx = fmaxf(mx, __shfl_xor(mx, 32));
    const float mnew = fmaxf(mrun, mx), alpha = __builtin_amdgcn_exp2f(mrun - mnew);
    float rs = 0.f;
#pragma unroll
    for (int c = 0; c < 8; ++c) {
        if (rel == 0 || (rel < 0 ? c >= w : c <= w)) {
#pragma unroll
            for (int j = 0; j < 4; ++j) { const float pp = __builtin_amdgcn_exp2f(S[c][j] - mnew); S[c][j] = pp; rs += pp; }
        } else S[c] = (f32x4){0.f, 0.f, 0.f, 0.f}; }
    rs += __shfl_xor(rs, 16); rs += __shfl_xor(rs, 32);
    lrun = lrun * alpha + rs; mrun = mnew;
#pragma unroll
    for (int c = 0; c < 8; ++c) O[c] = O[c] * alpha;
}
struct AttnPItem { int hq0, n, b, kh, jb0, jb1; size_t row0; };
__device__ __forceinline__ AttnPItem attn_pdecode(int unit) {
    AttnPItem a; a.kh = (unit >> 1) & 3; a.hq0 = 4 * a.kh + 2 * (unit & 1); a.n = (unit >> 3) & 31; a.b = unit >> 8;
    a.jb0 = a.n > 0 ? a.n - 1 : 0; a.jb1 = a.n < NCH - 1 ? a.n + 1 : NCH - 1; a.row0 = (size_t)a.b * SEQ + (size_t)a.n * CHUNK; return a;
}
__device__ __forceinline__ void attn_pair_queue(ldsp lds, const bf16* proj, bf16* mix, const float* sink, unsigned* qw, volatile LAS int* qslot, int nitems, int tid0) {
    const ldsp TK = lds, TV = lds + TILE_BYTES, TPa = lds + 2 * TILE_BYTES, TPb = lds + 3 * TILE_BYTES;
    int tid = tid0;
    int lane = tid & 63, w = __builtin_amdgcn_readfirstlane(tid >> 6), fr = lane & 15, fq = lane >> 4, i = 16 * w + fr;
    __syncthreads();
    if (tid == 0) *qslot = (int)__hip_atomic_fetch_add(qw, 1u, __ATOMIC_RELAXED, __HIP_MEMORY_SCOPE_AGENT);
    __syncthreads();
    int item = *qslot;
    bf16x8 qfA[4], qfB[4]; TileRegs rk, rv;
    if (item < nitems) { const AttnPItem a = attn_pdecode(item);
        const bf16* qrow = proj + (a.row0 + i) * INW + C_AQ + a.hq0 * HDIM + 8 * fq;
#pragma unroll
        for (int ks = 0; ks < 4; ++ks) { qfA[ks] = *(const bf16x8*)(qrow + 32 * ks); qfB[ks] = *(const bf16x8*)(qrow + HDIM + 32 * ks); }
        const bf16* kv0 = proj + ((size_t)a.b * SEQ + (size_t)a.jb0 * CHUNK) * INW + a.kh * HDIM; tile_fetch(rk, kv0 + C_AK, INW, tid); tile_fetch(rv, kv0 + C_AV, INW, tid); }
    while (item < nitems) {
        asm volatile("" : "+v"(tid));
        lane = tid & 63; w = __builtin_amdgcn_readfirstlane(tid >> 6); fr = lane & 15; fq = lane >> 4; i = 16 * w + fr;
        const AttnPItem a = attn_pdecode(item);
#if !PAIR_QPRE
        { const bf16* qrow = proj + (a.row0 + i) * INW + C_AQ + a.hq0 * HDIM + 8 * fq;
#pragma unroll
          for (int ks = 0; ks < 4; ++ks) { qfA[ks] = *(const bf16x8*)(qrow + 32 * ks); qfB[ks] = *(const bf16x8*)(qrow + HDIM + 32 * ks); } }
#endif
        int nxt = 0; if (tid == 0) nxt = (int)__hip_atomic_fetch_add(qw, 1u, __ATOMIC_RELAXED, __HIP_MEMORY_SCOPE_AGENT);
        float mA = sink[a.hq0] * LOG2E, lA = 1.0f, mB = sink[a.hq0 + 1] * LOG2E, lB = 1.0f;
        f32x4 OA[8], OB[8]; zero8(OA); zero8(OB);
        int item_next = nitems;
        for (int jb = a.jb0; jb <= a.jb1; ++jb) {
            asm volatile("" : "+v"(tid));
            lane = tid & 63; w = __builtin_amdgcn_readfirstlane(tid >> 6); fr = lane & 15; fq = lane >> 4; i = 16 * w + fr;
            const ldsp kb = row_base(TK, lane), vb = tr_base(TV, lane), pba = row_base(TPa, lane) + 16u * TP * w, pbb = row_base(TPb, lane) + 16u * TP * w;
            __syncthreads();
            tile_put(TK, rk, tid); tile_put(TV, rv, tid);
            if (jb == a.jb1) item_next = *qslot;
            __syncthreads();
#if PAIR_EARLYKV
            if (jb < a.jb1) { const bf16* kv1 = proj + ((size_t)a.b * SEQ + (size_t)(jb + 1) * CHUNK) * INW + a.kh * HDIM; tile_fetch(rk, kv1 + C_AK, INW, tid); tile_fetch(rv, kv1 + C_AV, INW, tid); }
            else if (item_next < nitems) { const AttnPItem an = attn_pdecode(item_next);
                const bf16* kv0 = proj + ((size_t)an.b * SEQ + (size_t)an.jb0 * CHUNK) * INW + an.kh * HDIM; tile_fetch(rk, kv0 + C_AK, INW, tid); tile_fetch(rv, kv0 + C_AV, INW, tid); }
#endif
            const int rel = jb - a.n;
            const bool h0 = rel <= 0 ? (rel == 0 || w <= 3) : true, h1 = rel >= 0 ? (rel == 0 || w >= 4) : true;
            {
                f32x4 S[8]; if (ATTN_BIAS) { int d0 = i - 4 * fq; asm volatile("" : "+v"(d0)); attn_bias_init(S, rel, d0); } else zero8(S);
                if (h0) {
#pragma unroll
                    for (int ks = 0; ks < 4; ++ks) {
#pragma unroll
                        for (int c = 0; c < 4; ++c) S[c] = __builtin_amdgcn_mfma_f32_16x16x32_bf16(frag_row(kb, c, ks), qfA[ks], S[c], 0, 0, 0);
                        __builtin_amdgcn_sched_barrier(0); } }
                if (h1) {
#pragma unroll
                    for (int ks = 0; ks < 4; ++ks) {
#pragma unroll
                        for (int c = 4; c < 8; ++c) S[c] = __builtin_amdgcn_mfma_f32_16x16x32_bf16(frag_row(kb, c, ks), qfA[ks], S[c], 0, 0, 0);
                        __builtin_amdgcn_sched_barrier(0); } }
                if (jb == a.jb0 && tid == 0) *qslot = nxt;
                if (ATTN_BIAS) attn_softmax_bias(S, mA, lA, OA, h0, h1); else attn_softmax_block(S, mA, lA, OA, rel, w, i, fq);
                store_acc_tile(TPa, S, w, lane); }
            if (!PAIR_NOSB) __builtin_amdgcn_sched_barrier(0);
            {
                f32x4 S[8]; if (ATTN_BIAS) { int d0 = i - 4 * fq; asm volatile("" : "+v"(d0)); attn_bias_init(S, rel, d0); } else zero8(S);
                if (h0) {
#pragma unroll
                    for (int ks = 0; ks < 4; ++ks) {
#pragma unroll
                        for (int c = 0; c < 4; ++c) S[c] = __builtin_amdgcn_mfma_f32_16x16x32_bf16(frag_row(kb, c, ks), qfB[ks], S[c], 0, 0, 0);
                        __builtin_amdgcn_sched_barrier(0); } }
                if (h1) {
#pragma unroll
                    for (int ks = 0; ks < 4; ++ks) {
#pragma unroll
                        for (int c = 4; c < 8; ++c) S[c] = __builtin_amdgcn_mfma_f32_16x16x32_bf16(frag_row(kb, c, ks), qfB[ks], S[c], 0, 0, 0);
                        __builtin_amdgcn_sched_barrier(0); } }
                asm volatile("" ::: "memory");
                if (ATTN_BIAS) attn_softmax_bias(S, mB, lB, OB, h0, h1); else attn_softmax_block(S, mB, lB, OB, rel, w, i, fq);
                store_acc_tile(TPb, S, w, lane); }
            __builtin_amdgcn_sched_barrier(0);
#if !PAIR_EARLYKV
            if (jb < a.jb1) { const bf16* kv1 = proj + ((size_t)a.b * SEQ + (size_t)(jb + 1) * CHUNK) * INW + a.kh * HDIM; tile_fetch(rk, kv1 + C_AK, INW, tid); tile_fetch(rv, kv1 + C_AV, INW, tid); }
            else if (item_next < nitems) { const AttnPItem an = attn_pdecode(item_next);
                const bf16* kv0 = proj + ((size_t)an.b * SEQ + (size_t)an.jb0 * CHUNK) * INW + an.kh * HDIM; tile_fetch(rk, kv0 + C_AK, INW, tid); tile_fetch(rv, kv0 + C_AV, INW, tid); }
#endif
            LDS_WAIT();
            if (MM_SETPRIO) __builtin_amdgcn_s_setprio(1);
#pragma unroll
            for (int ks = 0; ks < 4; ++ks) {
                if (ks < 2 ? h0 : h1) {
                    const bf16x8 paA = frag_row(pba, 0, ks), paB = frag_row(pbb, 0, ks);
#pragma unroll
                    for (int c = 0; c < 8; ++c) { const bf16x8 vf = frag_tr(vb, c, ks);
                        OA[c] = __builtin_amdgcn_mfma_f32_16x16x32_bf16(vf, paA, OA[c], 0, 0, 0);
                        OB[c] = __builtin_amdgcn_mfma_f32_16x16x32_bf16(vf, paB, OB[c], 0, 0, 0); } }
                __builtin_amdgcn_sched_barrier(0); }
            if (MM_SETPRIO) __builtin_amdgcn_s_setprio(0);
        }
#if PAIR_QPRE
        if (item_next < nitems) { const AttnPItem an = attn_pdecode(item_next);
            const bf16* qrow = proj + (an.row0 + i) * INW + C_AQ + an.hq0 * HDIM + 8 * fq;
#pragma unroll
            for (int ks = 0; ks < 4; ++ks) { qfA[ks] = *(const bf16x8*)(qrow + 32 * ks); qfB[ks] = *(const bf16x8*)(qrow + HDIM + 32 * ks); } }
#endif
        const float invA = 1.0f / lA, invB = 1.0f / lB;
#pragma unroll
        for (int c = 0; c < 8; ++c) { OA[c] = OA[c] * invA; OB[c] = OB[c] * invB; }
        store_acc_tile(TPa, OA, w, lane); store_acc_tile(TPb, OB, w, lane);
        LDS_WAIT();
        bf16* obase = mix + (a.row0 + 16 * w) * DM + MIX_C + a.hq0 * HDIM;
#pragma unroll
        for (int k = 0; k < 4; ++k) { const int q = lane + 64 * k, r = q >> 4, ch = q & 15;
            *(v4u*)(obase + (size_t)r * DM + 8 * ch) = *(const LAS v4u*)(TPa + offb(16 * w + r, ch));
            *(v4u*)(obase + (size_t)r * DM + HDIM + 8 * ch) = *(const LAS v4u*)(TPb + offb(16 * w + r, ch)); }
        item = item_next;
    }
}

__device__ __forceinline__ void sgu_unit(ldsp lds, const bf16* proj, bf16* mix, const float* sgup, const float* ln_g, const float* ln_b, const float* w_s, const float* b_s, int unit, int tid) {
    const int lane = tid & 63, w = __builtin_amdgcn_readfirstlane(tid >> 6), fr = lane & 15, fq = lane >> 4;
    const int g = unit & 7, n = (unit >> 3) & 31, b = unit >> 8;
    const ldsp TA = lds, TB = lds + TILE_BYTES;
    LAS float* stat = (LAS float*)(lds + 3 * TILE_BYTES);
    const size_t row0 = (size_t)b * SEQ + (size_t)n * CHUNK;
#if SGU_EARLY
    TileRegs rv; tile_fetch(rv, proj + row0 * INW + C_V + g * HDIM, INW, tid);
    v4u ur[4];
    { const bf16* ub = proj + (row0 + 16 * w) * INW + C_U + g * HDIM;
#pragma unroll
      for (int k = 0; k < 4; ++k) { const int q = lane + 64 * k; ur[k] = *(const v4u*)(ub + (size_t)(q >> 4) * INW + 8 * (q & 15)); } }
    f32x4 wx[4], wy[4];
    { const float* wsp = w_s + (size_t)g * CHUNK * CHUNK;
#pragma unroll
      for (int i = 0; i < 4; ++i) { const int ck = tid + 512 * i, r = ck >> 4, ch = ck & 15; wx[i] = *(const f32x4*)(wsp + r * 128 + 8 * ch); wy[i] = *(const f32x4*)(wsp + r * 128 + 8 * ch + 4); } }
#endif
    __syncthreads();
    { const int tok = tid >> 2, q = tid & 3;
      const f32x4* p = (const f32x4*)(sgup + ((row0 + tok) * 16 + 4 * q) * 2);
      const f32x4 a = p[0], c = p[1];
      float s = (a[0] + a[2]) + (c[0] + c[2]), ss = (a[1] + a[3]) + (c[1] + c[3]);
      s += __shfl_xor(s, 1); ss += __shfl_xor(ss, 1); s += __shfl_xor(s, 2); ss += __shfl_xor(ss, 2);
      const float mean = s * (1.f / 1024.f), var = fmaxf(ss * (1.f / 1024.f) - mean * mean, 0.f);
      if (q == 0) { stat[2 * tok] = mean; stat[2 * tok + 1] = rsqrtf(var + NORM_EPS); } }
    const float* ws = w_s + (size_t)g * CHUNK * CHUNK;
#pragma unroll
    for (int i = 0; i < 4; ++i) { const int ck = tid + 512 * i, r = ck >> 4, ch = ck & 15;
#if SGU_EARLY
        const f32x4 x = wx[i], y = wy[i];
#else
        const f32x4 x = *(const f32x4*)(ws + r * 128 + 8 * ch), y = *(const f32x4*)(ws + r * 128 + 8 * ch + 4);
#endif
        v4u v; v[0] = cvt_pk_bf16(x[0], x[1]); v[1] = cvt_pk_bf16(x[2], x[3]); v[2] = cvt_pk_bf16(y[0], y[1]); v[3] = cvt_pk_bf16(y[2], y[3]);
        *(LAS v4u*)(TA + offb(r, ch)) = v; }
#if !SGU_EARLY
    TileRegs rv; tile_fetch(rv, proj + row0 * INW + C_V + g * HDIM, INW, tid);
#endif
    __syncthreads();
#pragma unroll
    for (int i = 0; i < 4; ++i) { const int ck = tid + 512 * i, r = ck >> 4, ch = ck & 15;
        const v4u v = rv.v[i];
        const float mean = stat[2 * r], rstd = stat[2 * r + 1];
        const f32x4 g0 = *(const f32x4*)(ln_g + g * HDIM + 8 * ch), g1 = *(const f32x4*)(ln_g + g * HDIM + 8 * ch + 4);
        const f32x4 b0 = *(const f32x4*)(ln_b + g * HDIM + 8 * ch), b1 = *(const f32x4*)(ln_b + g * HDIM + 8 * ch + 4);
        v4u o;
        o[0] = cvt_pk_bf16((bf_lo(v[0]) - mean) * rstd * g0[0] + b0[0], (bf_hi(v[0]) - mean) * rstd * g0[1] + b0[1]);
        o[1] = cvt_pk_bf16((bf_lo(v[1]) - mean) * rstd * g0[2] + b0[2], (bf_hi(v[1]) - mean) * rstd * g0[3] + b0[3]);
        o[2] = cvt_pk_bf16((bf_lo(v[2]) - mean) * rstd * g1[0] + b1[0], (bf_hi(v[2]) - mean) * rstd * g1[1] + b1[1]);
        o[3] = cvt_pk_bf16((bf_lo(v[3]) - mean) * rstd * g1[2] + b1[2], (bf_hi(v[3]) - mean) * rstd * g1[3] + b1[3]);
        *(LAS v4u*)(TB + offb(r, ch)) = o; }
    __syncthreads();
    f32x4 acc[8]; zero8(acc);
    mm128<false, true>(acc, TA, TB, w, lane);
    const int i = 16 * w + fr;
    const float bs = b_s[g * CHUNK + i];
#pragma unroll
    for (int c = 0; c < 8; ++c) acc[c] = acc[c] + bs;
    store_acc_tile(TA, acc, w, lane);
    LDS_WAIT();
    const bf16* ubase = proj + (row0 + 16 * w) * INW + C_U + g * HDIM;
    bf16* obase = mix + (row0 + 16 * w) * DM + MIX_A + g * HDIM;
#pragma unroll
    for (int k = 0; k < 4; ++k) { const int q = lane + 64 * k, r = q >> 4, ch = q & 15;
#if SGU_EARLY
        const v4u s = *(const LAS v4u*)(TA + offb(16 * w + r, ch)), u = ur[k];
#else
        const v4u s = *(const LAS v4u*)(TA + offb(16 * w + r, ch)), u = *(const v4u*)(ubase + (size_t)r * INW + 8 * ch);
#endif
        v4u o;
#pragma unroll
        for (int e = 0; e < 4; ++e) o[e] = cvt_pk_bf16(bf_lo(u[e]) * bf_lo(s[e]), bf_hi(u[e]) * bf_hi(s[e]));
        *(v4u*)(obase + (size_t)r * DM + 8 * ch) = o; }
}

__device__ __forceinline__ void ret_chain(ldsp lds, const bf16* proj, bf16* st, const float* ldr, int item, int tid) {
    const int lane = tid & 63, w = __builtin_amdgcn_readfirstlane(tid >> 6), fr = lane & 15, fq = lane >> 4;
    const int h = item & 7, b = (item >> 3) & 3, dir = item >> 5;
    const float l2 = -__expf(ldr[dir * NRH + h]) * LOG2E, cd = __builtin_amdgcn_exp2f(l2 * (float)CHUNK);
    const float a0 = dir ? 0.f : 127.f, a1 = dir ? 1.f : -1.f;
    const int n0 = dir ? NCH - 1 : 0, step = dir ? -1 : 1;
    const bf16* src = proj + (size_t)b * SEQ * INW + h * HDIM;
    bf16* stp = st + (((size_t)dir * BATCH + b) * NRH + h) * (size_t)NCH * (HDIM * HDIM) + (size_t)((16 * w + (fq >> 1)) * 16 + fr) * 8 + 4 * (fq & 1);
    TileRegs rvA, rkA, rvB, rkB;
    tile_fetch(rvA, src + (size_t)n0 * CHUNK * INW + C_RV, INW, tid); tile_fetch(rkA, src + (size_t)n0 * CHUNK * INW + C_RK, INW, tid);
    tile_fetch(rvB, src + (size_t)(n0 + step) * CHUNK * INW + C_RV, INW, tid); tile_fetch(rkB, src + (size_t)(n0 + step) * CHUNK * INW + C_RK, INW, tid);
    __syncthreads();
    tile_put(lds, rvA, tid); tile_put_scaled(lds + TILE_BYTES, rkA, l2, a0, a1, tid);
    __syncthreads();
    f32x4 acc[8]; zero8(acc);
#define CHAIN_STEP(T, RVF, RKF, RVW, RKW) do { const int t_ = (T), n = n0 + step * t_, cur = t_ & 1; \
        const ldsp TV = lds + (cur ? 2 * TILE_BYTES : 0), TKW = TV + TILE_BYTES, TVn = lds + (cur ? 0 : 2 * TILE_BYTES), TKWn = TVn + TILE_BYTES; \
        if (t_ + 2 < NCH) { const size_t o_ = (size_t)(n + 2 * step) * CHUNK * INW; tile_fetch(RVF, src + o_ + C_RV, INW, tid); tile_fetch(RKF, src + o_ + C_RK, INW, tid); } \
        bf16* o = stp + (size_t)n * (HDIM * HDIM); \
        _Pragma("unroll") for (int c = 0; c < 8; ++c) { v2u v; v[0] = cvt_pk_bf16(acc[c][0], acc[c][1]); v[1] = cvt_pk_bf16(acc[c][2], acc[c][3]); *(v2u*)(o + 256 * c) = v; } \
        if (t_ + 1 < NCH) { \
            _Pragma("unroll") for (int c = 0; c < 8; ++c) acc[c] = acc[c] * cd; \
            mm128<true, true>(acc, TV, TKW, w, lane); \
            tile_put(TVn, RVW, tid); tile_put_scaled(TKWn, RKW, l2, a0, a1, tid); } \
        __syncthreads(); } while (0)
    for (int t = 0; t < NCH; t += 2) {
        CHAIN_STEP(t, rvA, rkA, rvB, rkB);
        CHAIN_STEP(t + 1, rvB, rkB, rvA, rkA);
    }
#undef CHAIN_STEP
}

struct RetoutRegs { TileRegs q, k, v, sf, sb; };
__device__ __forceinline__ void retout_fetch(RetoutRegs& R, const bf16* proj, const bf16* st, int unit, int tid) {
    const int h = unit & 7, n = (unit >> 3) & 31, b = unit >> 8;
    const bf16* base = proj + ((size_t)b * SEQ + (size_t)n * CHUNK) * INW + h * HDIM;
    tile_fetch(R.q, base + C_RQ, INW, tid); tile_fetch(R.k, base + C_RK, INW, tid); tile_fetch(R.v, base + C_RV, INW, tid);
    tile_fetch(R.sf, st + ((((size_t)0 * BATCH + b) * NRH + h) * NCH + n) * (size_t)(HDIM * HDIM), HDIM, tid);
    tile_fetch(R.sb, st + ((((size_t)1 * BATCH + b) * NRH + h) * NCH + n) * (size_t)(HDIM * HDIM), HDIM, tid);
}
__device__ __forceinline__ void retout_loop(ldsp lds, const bf16* proj, const bf16* st, bf16* mix, const float* ldr, int u0, int ustep, int nunits, int tid0) {
    const ldsp TQ = lds, TK = lds + TILE_BYTES, TV = lds + 2 * TILE_BYTES, TS = lds + 3 * TILE_BYTES;
    int tid = tid0;
    RetoutRegs R;
    int unit = u0;
    if (unit < nunits) retout_fetch(R, proj, st, unit, tid);
#pragma clang loop unroll(disable)
    while (unit < nunits) {
        asm volatile("" : "+v"(tid));
        const int lane = tid & 63, w = __builtin_amdgcn_readfirstlane(tid >> 6), fr = lane & 15, fq = lane >> 4, i = 16 * w + fr;
        const int h = unit & 7, n = (unit >> 3) & 31, b = unit >> 8;
        const size_t row0 = (size_t)b * SEQ + (size_t)n * CHUNK;
        const float l2f = -__expf(ldr[h]) * LOG2E, l2b = -__expf(ldr[NRH + h]) * LOG2E;
        __syncthreads();
        tile_put(TQ, R.q, tid); tile_put(TK, R.k, tid); tile_put(TV, R.v, tid); tile_put_frag(TS, R.sf, tid);
        __syncthreads();
        f32x4 P[8]; zero8(P);
        mm128<false, false>(P, TQ, TK, w, lane);
#pragma unroll
        for (int c = 0; c < 8; ++c)
#pragma unroll
            for (int j = 0; j < 4; ++j) { const int dl = i - (16 * c + 4 * fq + j);
                P[c][j] *= __builtin_amdgcn_exp2f(dl >= 0 ? l2f * (float)dl : l2b * (float)(-dl)); }
        f32x4 accF[8]; zero8(accF);
        mm128<false, false>(accF, TQ, TS, w, lane);
        __syncthreads();
        store_acc_tile(TK, P, w, lane);
        tile_put_frag(TS, R.sb, tid);
        const bf16* gbase = proj + (row0 + 16 * w) * INW + C_RG + h * HDIM;
        v4u gr[4];
#pragma unroll
        for (int k = 0; k < 4; ++k) { const int q = lane + 64 * k; gr[k] = *(const v4u*)(gbase + (size_t)(q >> 4) * INW + 8 * (q & 15)); }
        const int unext = unit + ustep;
        __syncthreads();
        f32x4 acc[8]; zero8(acc);
        mm128<false, false>(acc, TQ, TS, w, lane);
        const float wf = __builtin_amdgcn_exp2f(l2f * (float)(i + 1)), wb = __builtin_amdgcn_exp2f(l2b * (float)(CHUNK - i));
#pragma unroll
        for (int c = 0; c < 8; ++c) acc[c] = acc[c] * wb + accF[c] * wf;
        asm volatile("" ::: "memory");
        if (unext < nunits) retout_fetch(R, proj, st, unext, tid);
        mm128<false, true>(acc, TK, TV, w, lane);
        float ss = 0.f;
#pragma unroll
        for (int c = 0; c < 8; ++c) ss += (acc[c][0] * acc[c][0] + acc[c][1] * acc[c][1]) + (acc[c][2] * acc[c][2] + acc[c][3] * acc[c][3]);
        ss += __shfl_xor(ss, 16); ss += __shfl_xor(ss, 32);
        const float rn = rsqrtf(ss * (1.f / 128.f) + NORM_EPS);
#pragma unroll
        for (int c = 0; c < 8; ++c) acc[c] = acc[c] * rn;
        store_acc_tile(TK, acc, w, lane);
        LDS_WAIT();
        bf16* obase = mix + (row0 + 16 * w) * DM + MIX_R + h * HDIM;
#pragma unroll
        for (int k = 0; k < 4; ++k) { const int q = lane + 64 * k, r = q >> 4, ch = q & 15;
            const v4u s = *(const LAS v4u*)(TK + offb(16 * w + r, ch)), gw = gr[k];
            v4u o;
#pragma unroll
            for (int e = 0; e < 4; ++e) { const float g0 = bf_lo(gw[e]), g1 = bf_hi(gw[e]);
                o[e] = cvt_pk_bf16(g0 / (1.f + __expf(-g0)) * bf_lo(s[e]), g1 / (1.f + __expf(-g1)) * bf_hi(s[e])); }
            *(v4u*)(obase + (size_t)r * DM + 8 * ch) = o; }
        unit = unext;
    }
}

__device__ __forceinline__ void cvt_rows_bf16(const float* x, bf16* out, float* part, int gw, int ngw, int lane) {
    for (int m = gw; m < M; m += ngw) {
        const f32x4* xr = (const f32x4*)(x + (size_t)m * DM) + lane;
        v2u* o = (v2u*)(out + (size_t)m * DM) + lane;
        float ss = 0.f;
#pragma unroll
        for (int j = 0; j < 16; ++j) { const f32x4 v = xr[64 * j]; ss += (v[0] * v[0] + v[1] * v[1]) + (v[2] * v[2] + v[3] * v[3]);
            v2u ov; ov[0] = cvt_pk_bf16(v[0], v[1]); ov[1] = cvt_pk_bf16(v[2], v[3]); o[64 * j] = ov; }
        ss = wave_sum(ss);
        part[(size_t)m * 64 + lane] = (lane == 0) ? ss : 0.f;
    }
}
__device__ __forceinline__ void final_norm(const bf16* x, float* out, const float* g, const float* part, int gw, int ngw, int lane) {
    for (int m = gw; m < M; m += ngw) {
        const float rstd = 1.0f / sqrtf(wave_sum(part[(size_t)m * 64 + lane]) * (1.f / DM) + NORM_EPS);
        const v4u* xr = (const v4u*)(x + (size_t)m * DM) + lane;
        f32x4* o = (f32x4*)(out + (size_t)m * DM) + 2 * lane;
#pragma unroll
        for (int j = 0; j < 8; ++j) { const v4u v = xr[64 * j];
            const f32x4 g0 = *((const f32x4*)g + 128 * j + 2 * lane), g1 = *((const f32x4*)g + 128 * j + 2 * lane + 1);
            o[128 * j] = (f32x4){bf_lo(v[0]), bf_hi(v[0]), bf_lo(v[1]), bf_hi(v[1])} * rstd * g0;
            o[128 * j + 1] = (f32x4){bf_lo(v[2]), bf_hi(v[2]), bf_lo(v[3]), bf_hi(v[3])} * rstd * g1; }
    }
}
__device__ __forceinline__ void build_rstd(LAS float* tab, const float* part, int pm, int tid) {
    const f32x4* p = (const f32x4*)(part + ((size_t)pm * 256 + (tid >> 1)) * 64 + (tid & 1) * 32); float s = 0.f;
#pragma unroll
    for (int k = 0; k < 8; ++k) { const f32x4 v = p[k]; s += (v[0] + v[1]) + (v[2] + v[3]); }
    s += __shfl_xor(s, 1);
    if ((tid & 1) == 0) tab[tid >> 1] = 1.0f / sqrtf(s * (1.f / DM) + NORM_EPS);
    __syncthreads();
}
template <bool PERMUTE>
__device__ __forceinline__ void transpose_item(const float* W, int K, int N, bf16* WT, const float* gk, LAS float* scr, int item, int lane) {
    const int nblk = N / 32, kb = item / nblk, nb = item % nblk, k0 = 64 * kb, n0 = 32 * nb;
#pragma unroll 8
    for (int i = 0; i < 32; ++i) { const int kk = 2 * i + (lane >> 5); scr[kk * 33 + (lane & 31)] = W[(size_t)(k0 + kk) * N + n0 + (lane & 31)] * (gk ? gk[k0 + kk] : 1.0f); }
    LDS_WAIT(); asm volatile("" ::: "memory");
    const int c = lane & 7;
#pragma unroll
    for (int j = 0; j < 4; ++j) { const int n = (lane >> 3) + 8 * j; const LAS float* s = scr + (8 * c) * 33 + n;
        v4u o; o[0] = cvt_pk_bf16(s[0 * 33], s[1 * 33]); o[1] = cvt_pk_bf16(s[2 * 33], s[3 * 33]); o[2] = cvt_pk_bf16(s[4 * 33], s[5 * 33]); o[3] = cvt_pk_bf16(s[6 * 33], s[7 * 33]);
        *(v4u*)(WT + (size_t)((PERMUTE ? win_phys_col(n0) : n0) + n) * K + k0 + 8 * c) = o; }
    LDS_WAIT(); asm volatile("" ::: "memory");
}
#ifndef MK_MULTI
#define MK_MULTI 0
#endif
#ifndef GEMM_SP2
#define GEMM_SP2 true
#endif
#ifndef GEMM_ALIGN
#define GEMM_ALIGN true
#endif
#ifndef G4_AUXA
#define G4_AUXA 0
#endif
#ifndef G4_AUXB
#define G4_AUXB 0
#endif
#ifndef ORDER4K
#define ORDER4K BlockOrder
#endif
#ifndef CVT_ALL_IN_P0
#define CVT_ALL_IN_P0 0
#endif
#ifndef CVT_PER_ITEM
#define CVT_PER_ITEM 0
#endif
#ifndef CVT_STAGGER
#define CVT_STAGGER 1
#endif
__host__ __device__ constexpr int cvt_slot_lo(int s) { return s == 0 ? 0 : s == 1 ? 1440 : s == 2 ? 2880 : 4608; }
__host__ __device__ constexpr int cvt_slot_hi(int s) { return s == 0 ? 1440 : s == 1 ? 2880 : s == 2 ? 4608 : 5760; }
#define PLACE_STR2(x) #x
#define PLACE_STR(x) PLACE_STR2(x)
constexpr int NPH = 1 + 9 * DEPTH;
#ifndef PROBE_REP_GEMM
#define PROBE_REP_GEMM 0
#endif
#ifndef PROBE_ATTN_VAR
#define PROBE_ATTN_VAR 0
#endif
#ifndef MERGE_M3
#define MERGE_M3 0
#endif
#ifndef PROBE_REP_MIX
#define PROBE_REP_MIX 0
#endif
#ifndef PROBE_REP_CVT
#define PROBE_REP_CVT 0
#endif
constexpr size_t WS_DUMMY = WS_END;
struct Args { const float* in[14]; float* out; unsigned char* ws; int ph_lo, ph_hi; };
__global__ void __launch_bounds__(NWAVES * 64, 2) hybrid_fwd(Args args) {
#if defined(PLACE_SHIFT)
    for (int i_ = 0; i_ < 0; ++i_) {}
    asm volatile(".rept " PLACE_STR(PLACE_SHIFT) "\n\ts_nop 0\n\t.endr" ::: "memory");
#endif
    extern __shared__ __attribute__((aligned(16))) unsigned char lds_raw[];
    const ldsp lds = (ldsp)lds_raw;
    volatile LAS unsigned* MISC = (volatile LAS unsigned*)(lds + MISC_OFF);
    const int tid = threadIdx.x;
    const int G = gridDim.x, bx = blockIdx.x;
    const int ngw = G * NWAVES;
    unsigned char* ws = args.ws;
    unsigned* ctl = (unsigned*)(ws + WS_CTL);
    const float* x_in = args.in[0]; const float* ln_mix_g = args.in[1]; const float* w_in = args.in[2]; const float* sgu_ln_g = args.in[3]; const float* sgu_ln_b = args.in[4];
    const float* sgu_w = args.in[5]; const float* sgu_b = args.in[6]; const float* ret_ld = args.in[7]; const float* attn_sink = args.in[8]; const float* w_out = args.in[9];
    const float* ln_mlp_g = args.in[10]; const float* w_up = args.in[11]; const float* w_down = args.in[12]; const float* final_g = args.in[13];
    float* out = args.out;
    float* cosT = (float*)(ws + WS_COS); float* sinT = (float*)(ws + WS_SIN);
    bf16* WinT = (bf16*)(ws + WS_WIN); bf16* WoutT = (bf16*)(ws + WS_WOUT); bf16* WupT = (bf16*)(ws + WS_WUP); bf16* WdnT = (bf16*)(ws + WS_WDN);
    bf16* Hb = (bf16*)(ws + WS_H); bf16* PROJ = (bf16*)(ws + WS_PROJ); bf16* MIX = (bf16*)(ws + WS_MIX); bf16* HID = (bf16*)(ws + WS_HID);
    bf16* ST = (bf16*)(ws + WS_ST); float* SGUP = (float*)(ws + WS_SGUP);
    float* RSA = (float*)(ws + WS_RSA); float* RSB = (float*)(ws + WS_RSB);
    LAS float* rstd_tab = (LAS float*)(lds + RSTD_OFF);

    for (int u = tid; u < (LDS_BYTES - LDSCTL_OFF) / 4; u += NWAVES * 64) ((LAS unsigned*)(lds + LDSCTL_OFF))[u] = 0u;
    __syncthreads();
#if HW_TID
    if ((tid & 63) == 0) *(volatile LAS int*)(lds + HWTAB_OFF + 4u * hw_slot()) = tid >> 6;
    __syncthreads();
#endif
#if !MK_MULTI
    { XcdBarrier bar0 = xcd_barrier_post(ctl + CW_BAR, MISC + 8); (void)bar0; }
#if defined(PROBE_BAR2)
#define GRID_BAR() do { xcd_barrier(bar); xcd_barrier(bar); xcd_barrier(bar); } while (0)
#else
#define GRID_BAR() do { const __attribute__((address_space(4))) KArgs* ka_ = (const __attribute__((address_space(4))) KArgs*)__builtin_amdgcn_kernarg_segment_ptr(); asm volatile("" : "+s"(ka_)); \
        XcdBarrier b_; b_.bar = (unsigned*)(ka_->ws + WS_CTL) + CW_BAR; b_.x = xb_xcc_id(); b_.st = MISC + 8; xcd_barrier(b_); } while (0)
#endif
#else
#define GRID_BAR() do {} while (0)
#endif
    const int lo = args.ph_lo, hi = args.ph_hi;
#ifndef MK_ONLY
#define MK_ONLY -1
#endif
#ifndef MK_SUB
#define MK_SUB -1
#endif
#define SUB(k) (MK_SUB < 0 || MK_SUB == (k))
#define SITE(k) (MK_ONLY < 0 || MK_ONLY == (k))
#if MK_MULTI
#define IN(k) (lo <= (k) && (k) < hi)
#else
#define IN(k) true
#endif
#define CVT_SLOT(S, WHEN_ODD) do { if (CVT_STAGGER && !CVT_ALL_IN_P0 && ((bx & 1) != 0) == (WHEN_ODD)) { int tq = hw_tid(lds); asm volatile("" : "+v"(tq)); int ci_ = cvt_slot_lo(S) + bx; cvt_step(l, ci_, 1 << 30, lds, tq, cvt_slot_hi(S)); } } while (0)
#define CVT_GRP() ((((bx & 1) << 1) | ((bx >> 3) & 1)))
#define CVT_SLOT4_BEFORE(S) int ci_slot = cvt_slot_lo(S) + bx; do { int tq = hw_tid(lds); asm volatile("" : "+v"(tq)); \
        const int hi_ = cvt_slot_hi(S) < cvt_batch_items(l) ? cvt_slot_hi(S) : cvt_batch_items(l); const int nit_ = ci_slot < hi_ ? (hi_ - ci_slot + 255) / 256 : 0; \
        cvt_step(l, ci_slot, (nit_ * (3 - CVT_GRP()) + 1) / 3, lds, tq, cvt_slot_hi(S)); } while (0)
#define CVT_SLOT4_AFTER(S) do { int tq = hw_tid(lds); asm volatile("" : "+v"(tq)); cvt_step(l, ci_slot, 1 << 30, lds, tq, cvt_slot_hi(S)); } while (0)
#define FRESH_TID() int tz = hw_tid(lds); asm volatile("" : "+v"(tz)); const int lz = tz & 63, wz = __builtin_amdgcn_readfirstlane(tz >> 6), gwz = bx * NWAVES + wz; (void)lz; (void)gwz

    if (SITE(0) && IN(0)) {
        FRESH_TID();
        LAS float* scr64 = (LAS float*)(lds + wz * 16640);
        for (int wi = bx; wi < CVT_IN; wi += G) cvt_tile64<true>(w_in, DM, INW, WinT, DM, ln_mix_g, scr64, 8 * wi + wz, lz);
#if CVT_ALL_IN_P0
        { int ci0 = bx, ci1 = bx; cvt_step(0, ci0, 1 << 30, lds, tz); cvt_step(1, ci1, 1 << 30, lds, tz); }
#endif
        if (bx == 0 && tz < 64) cosT[tz] = powf(10000.0f, -(float)(2 * tz) / 128.0f) * 0.15915494309189535f;
        cvt_rows_bf16(x_in, Hb, RSA, gwz, ngw, lz);
        GRID_BAR();
    }
#if defined(PROBE_BARS)
    if (IN(0)) { for (int i = 0; i < PROBE_BARS; ++i) GRID_BAR(); }
#endif
#if defined(PROBE_EPI)
    if (IN(0)) {
        pg8::Gemm g{Hb, WinT, M, 8192, DM, DM, DM};
#ifndef PROBE_WGM
#define PROBE_WGM 8
#endif
#if PROBE_WGM == 0
        typedef pg8::SameTileOrder ProbeOrder;
#else
        typedef pg8::StaticOrderW<PROBE_WGM> ProbeOrder;
#endif
        ProbeOrder S; S.init(M, 8192, G, bx);
        { FRESH_TID(); for (int q = 0; q < 4; ++q) build_rstd(rstd_tab + 256 * q, RSA, 0, tz); }
        pg8::EpiProbe<PROBE_EPI - 1> E{HID, 8192, pg8::RowScale{rstd_tab}};
#if defined(PROBE_SPLIT)
        pg8::Gemm g1{Hb, WinT, M, 4096, DM, DM, DM}, g2{Hb, WinT + (size_t)4096 * DM, M, 4096, DM, DM, DM}; ProbeOrder S1; S1.init(M, 4096, G, bx);
        for (int rep = 0; rep < PROBE_REPS; ++rep) { pg8::gemm_phase<pg8::EpiProbe<PROBE_EPI - 1>, ProbeOrder, GEMM_ALIGN, GEMM_SP2>(lds, g1, S1, E); GRID_BAR();
                                                     pg8::gemm_phase<pg8::EpiProbe<PROBE_EPI - 1>, ProbeOrder, GEMM_ALIGN, GEMM_SP2>(lds, g2, S1, E); GRID_BAR(); }
#else
        for (int rep = 0; rep < PROBE_REPS; ++rep) { pg8::gemm_phase<pg8::EpiProbe<PROBE_EPI - 1>, ProbeOrder, GEMM_ALIGN, GEMM_SP2>(lds, g, S, E); GRID_BAR(); }
#endif
    }
#endif
    for (int l = 0; l < DEPTH; ++l) {
        const int p0 = 1 + 9 * l;
        for (int rep = 0; rep < 1 + (PROBE_REP_GEMM & 1); ++rep)
        if (SITE(1) && IN(p0 + 0)) {
#if CVT_STAGGER == 4
            CVT_SLOT4_BEFORE(0);
#else
            CVT_SLOT(0, true);
#endif
            pg8::Gemm g{Hb, WinT + (size_t)l * INW * DM, M, INW, DM, DM, DM}; pg8::StaticOrder S; S.init(M, INW, G, bx);
            { pg8::Unit u0; S.next(0, u0); FRESH_TID(); build_rstd(rstd_tab + 256 * (u0.pm >> 4), RSA, u0.pm, tz); }
            pg8::EpiIn E{PROJ, INW, pg8::RowScale{rstd_tab}, cosT, SGUP, SEQ};
            pg8::gemm_phase<pg8::EpiIn, pg8::StaticOrder, GEMM_ALIGN, GEMM_SP2>(lds, g, S, E);
#if CVT_STAGGER == 4
            CVT_SLOT4_AFTER(0);
#else
            CVT_SLOT(0, false);
#endif
            GRID_BAR();
        }
        for (int rep = 0; rep < 1 + PROBE_REP_MIX; ++rep) {
        if (SITE(2) && IN(p0 + 1)) {
            FRESH_TID();
            volatile LAS int* qslot = (volatile LAS int*)(lds + MISC_OFF + 64);
#define RUN_QUEUE(QI, NITEMS, CALL) do { unsigned* qw = ctl + CW_Q + 64 * (3 * l + (QI)) + 64 * 6 * rep; __syncthreads(); \
                if (tz == 0) *qslot = (int)__hip_atomic_fetch_add(qw, 1u, __ATOMIC_RELAXED, __HIP_MEMORY_SCOPE_AGENT); __syncthreads(); int item = *qslot; \
                while (item < (NITEMS)) { int nxt = 0; if (tz == 0) nxt = (int)__hip_atomic_fetch_add(qw, 1u, __ATOMIC_RELAXED, __HIP_MEMORY_SCOPE_AGENT); \
                    CALL; __syncthreads(); if (tz == 0) *qslot = nxt; __syncthreads(); item = *qslot; } } while (0)
#define SGU_PASS(QI) RUN_QUEUE(QI, 1024, sgu_unit(lds, PROJ, MIX, SGUP, sgu_ln_g + l * 1024, sgu_ln_b + l * 1024, sgu_w + (size_t)l * NSG * CHUNK * CHUNK, sgu_b + l * NSG * CHUNK, item, tz))
#if defined(PROBE_MIXPART)
#ifndef PROBE_MIXREPS
#define PROBE_MIXREPS 1
#endif
            for (int pr = 0; pr < PROBE_MIXREPS; ++pr) {
#if PROBE_MIXPART == 1
            RUN_QUEUE((20 - 2 * l + 4 * pr), 64, ret_chain(lds, PROJ, ST, ret_ld + l * 2 * NRH, item, tz));
#endif
#if PROBE_MIXPART == 5
            { int cix = 1 << 30; attn_queue<PROBE_ATTN_VAR>(lds, PROJ, MIX, attn_sink + l * NQH, ctl + CW_Q + 64 * (20 - 2 * l + 4 * pr), qslot, 2048, tz, l, cix, 0); }
#endif
            __syncthreads(); GRID_BAR(); }
#endif
#if MERGE_M3
            unsigned* const chains_done = ctl + CW_Q + 64 * (40 + l + 2 * rep);
            { unsigned* qw = ctl + CW_Q + 64 * (3 * l) + 64 * 6 * rep; int ndone = 0; __syncthreads();
              if (tz == 0) *qslot = (int)__hip_atomic_fetch_add(qw, 1u, __ATOMIC_RELAXED, __HIP_MEMORY_SCOPE_AGENT); __syncthreads(); int item = *qslot;
              while (item < 64) { int nxt = 0; if (tz == 0) nxt = (int)__hip_atomic_fetch_add(qw, 1u, __ATOMIC_RELAXED, __HIP_MEMORY_SCOPE_AGENT);
                  ret_chain(lds, PROJ, ST, ret_ld + l * 2 * NRH, item, tz); ++ndone; __syncthreads(); if (tz == 0) *qslot = nxt; __syncthreads(); item = *qslot; }
              if (__builtin_amdgcn_readfirstlane(ndone) != 0) {
                  asm volatile("s_waitcnt vmcnt(0)" ::: "memory"); __syncthreads();
                  if (tz == 0) { __builtin_amdgcn_fence(__ATOMIC_RELEASE, "agent"); asm volatile("s_waitcnt vmcnt(0)" ::: "memory"); (void)xb_add(chains_done, (unsigned)ndone); } } }
#else
            RUN_QUEUE(0, 64, ret_chain(lds, PROJ, ST, ret_ld + l * 2 * NRH, item, tz));
#endif


            int ci = (CVT_ALL_IN_P0 || CVT_STAGGER) ? (1 << 30) : bx;
#if ATTN_PAIR
            attn_pair_queue(lds, PROJ, MIX, attn_sink + l * NQH, ctl + CW_Q + 64 * (3 * l + 1) + 64 * 6 * rep, qslot, 1024, tz);
#else
            attn_queue(lds, PROJ, MIX, attn_sink + l * NQH, ATTN_XCDQ ? ctl + CW_Q + 64 * (64 + 16 * l + 32 * rep) : ctl + CW_Q + 64 * (3 * l + 1) + 64 * 6 * rep, qslot, 2048, tz, l, ci, CVT_PER_ITEM);
#endif
            { int tz = hw_tid(lds); asm volatile("" : "+v"(tz));
            SGU_PASS(2);
            if (!CVT_STAGGER) cvt_step(l, ci, 1 << 30, lds, tz); }
#undef SGU_PASS
#undef RUN_QUEUE
#if MERGE_M3
            __syncthreads();
            if (tz == 0) { XB_SPIN(xb_ld(chains_done) < 64u, ctl + CW_BAR); __builtin_amdgcn_fence(__ATOMIC_ACQUIRE, "agent"); asm volatile("s_waitcnt vmcnt(0)" ::: "memory"); }
            __syncthreads();
            { FRESH_TID(); retout_loop(lds, PROJ, ST, MIX, ret_ld + l * 2 * NRH, bx, G, 1024, tz); }
            __syncthreads();
#endif
            GRID_BAR();
        }
#define SGU_STATIC_PASS() do { for (int u = bx; u < 1024; u += G) sgu_unit(lds, PROJ, MIX, SGUP, sgu_ln_g + l * 1024, sgu_ln_b + l * 1024, sgu_w + (size_t)l * NSG * CHUNK * CHUNK, sgu_b + l * NSG * CHUNK, u, tz); } while (0)
#define RETOUT_PASS() retout_loop(lds, PROJ, ST, MIX, ret_ld + l * 2 * NRH, bx, G, 1024, tz)
        if (!MERGE_M3 && SITE(4) && IN(p0 + 3)) {
            FRESH_TID();
#if defined(PROBE_MIXPART) && PROBE_MIXPART == 3
            for (int pr = 0; pr < PROBE_MIXREPS; ++pr) { SGU_STATIC_PASS(); __syncthreads(); GRID_BAR(); }
#endif
#if defined(PROBE_MIXPART) && PROBE_MIXPART == 2
            for (int pr = 0; pr < PROBE_MIXREPS; ++pr) { volatile LAS int* qslot2 = (volatile LAS int*)(lds + MISC_OFF + 64); int cix = 1 << 30;
                attn_queue<PROBE_ATTN_VAR>(lds, PROJ, MIX, attn_sink + l * NQH, ctl + CW_Q + 64 * (20 - 2 * l + 4 * pr), qslot2, 2048, tz, l, cix, 0); __syncthreads(); GRID_BAR(); }
#endif
#if defined(PROBE_MIXPART) && PROBE_MIXPART == 4
            for (int pr = 0; pr <= PROBE_MIXREPS; ++pr) { RETOUT_PASS(); __syncthreads(); GRID_BAR(); }
#else
            RETOUT_PASS();
            __syncthreads();
            GRID_BAR();
#endif
        }
        }
        if (SITE(5) && IN(p0 + 4)) {
#if CVT_STAGGER == 4
            CVT_SLOT4_BEFORE(1);
#else
            CVT_SLOT(1, true);
#endif
            pg8::Gemm g{MIX, WoutT + (size_t)l * DM * DM, M, DM, DM, DM, DM}; pg8::ORDER4K S; S.init(M, DM, G, bx);
            pg8::EpiResB E{Hb, DM, RSB};
            pg8::gemm_phase<pg8::EpiResB, pg8::ORDER4K, GEMM_ALIGN, GEMM_SP2>(lds, g, S, E);
#if CVT_STAGGER == 4
            CVT_SLOT4_AFTER(1);
#else
            CVT_SLOT(1, false);
#endif
            GRID_BAR();
        }
        for (int rep = 0; rep < 1 + ((PROBE_REP_GEMM >> 1) & 1); ++rep)
        if (SITE(7) && IN(p0 + 6)) {
#if CVT_STAGGER == 4
            CVT_SLOT4_BEFORE(2);
#else
            CVT_SLOT(2, true);
#endif
            pg8::Gemm g{Hb, WupT + (size_t)l * DFF * DM, M, DFF, DM, DM, DM}; pg8::StaticOrder S; S.init(M, DFF, G, bx);
            { pg8::Unit u0; S.next(0, u0); FRESH_TID(); build_rstd(rstd_tab + 256 * (u0.pm >> 4), RSB, u0.pm, tz); }
            pg8::EpiRelu2 E{HID, DFF, pg8::RowScale{rstd_tab}};
            pg8::gemm_phase<pg8::EpiRelu2, pg8::StaticOrder, GEMM_ALIGN, GEMM_SP2>(lds, g, S, E);
#if CVT_STAGGER == 4
            CVT_SLOT4_AFTER(2);
#else
            CVT_SLOT(2, false);
#endif
            GRID_BAR();
        }
        if (SITE(8) && IN(p0 + 7)) {
#if CVT_STAGGER == 4
            CVT_SLOT4_BEFORE(3);
#else
            CVT_SLOT(3, true);
#endif
            pg8::Gemm g{HID, WdnT + (size_t)l * DM * DFF, M, DM, DFF, 64, 64}; pg8::ORDER4K S; S.init(M, DM, G, bx);
            pg8::EpiResB E{Hb, DM, RSA};
            pg8::gemm_phase<pg8::EpiResB, pg8::ORDER4K, GEMM_ALIGN, GEMM_SP2, true, true, G4_AUXA, G4_AUXB>(lds, g, S, E);
#if CVT_STAGGER == 4
            CVT_SLOT4_AFTER(3);
#else
            CVT_SLOT(3, false);
#endif
            GRID_BAR();
        }
        if (SITE(9) && IN(p0 + 8) && l + 1 == DEPTH) {
            FRESH_TID();
            final_norm(Hb, out, final_g, RSA, gwz, ngw, lz);
        }
    }
#undef IN
}

extern "C" void kernel_launch(void* const* d_in, const int* in_sizes, int n_in, void* d_out, int out_size, void* d_ws, size_t ws_size, hipStream_t stream) {
    static int grid = 0;
    if (grid == 0) {
        if (n_in != 14 || in_sizes[0] != M * DM || out_size != M * DM || ws_size < WS_END + ((PROBE_REP_GEMM) ? 256 * MiB : 0)) { fprintf(stderr, "kernel_launch: unexpected shapes (n_in %d, in0 %d, out %d, ws %zu < %zu); nothing launched\n", n_in, n_in > 0 ? in_sizes[0] : -1, out_size, ws_size, (size_t)WS_END); grid = -1; return; }
        int dev = 0, cus = 0, per_cu = 0;
        if (hipGetDevice(&dev) != hipSuccess || hipDeviceGetAttribute(&cus, hipDeviceAttributeMultiprocessorCount, dev) != hipSuccess) { grid = -1; return; }
        if (hipFuncSetAttribute((const void*)hybrid_fwd, hipFuncAttributeMaxDynamicSharedMemorySize, LDS_BYTES) != hipSuccess) { fprintf(stderr, "kernel_launch: hipFuncSetAttribute failed\n"); grid = -1; return; }
        if (hipOccupancyMaxActiveBlocksPerMultiprocessor(&per_cu, (const void*)hybrid_fwd, NWAVES * 64, LDS_BYTES) != hipSuccess || per_cu < 1)
            fprintf(stderr, "kernel_launch: note: occupancy query reports %d workgroups per CU\n", per_cu);
        (void)hipGetLastError();
        if (cus < 256) { fprintf(stderr, "kernel_launch: needs 256 CUs, found %d\n", cus); grid = -1; return; }
        grid = 256;
    }
    if (grid < 0) return;
    if (hipMemsetAsync((char*)d_ws + WS_CTL, 0, CTL_ZERO_BYTES, stream) != hipSuccess) { fprintf(stderr, "kernel_launch: memset failed\n"); return; }
    Args a{};
    for (int i = 0; i < 14; ++i) a.in[i] = (const float*)d_in[i];
    a.out = (float*)d_out; a.ws = (unsigned char*)d_ws;
#if MK_MULTI
    for (int p = 0; p < NPH; ++p) { a.ph_lo = p; a.ph_hi = p + 1; hipLaunchKernelGGL(hybrid_fwd, dim3(grid), dim3(NWAVES * 64), LDS_BYTES, stream, a); }
#else
    a.ph_lo = 0; a.ph_hi = NPH;
    hipLaunchKernelGGL(hybrid_fwd, dim3(grid), dim3(NWAVES * 64), LDS_BYTES, stream, a);
#endif
    const hipError_t le = hipPeekAtLastError();
    if (le != hipSuccess) fprintf(stderr, "kernel_launch: launch failed: %s\n", hipGetErrorName(le));
}
```
